# Optimizing an MI355X kernel written in HIP

```python
import math
import jax, jax.numpy as jnp
from jax import lax
import numpy as np

D_MODEL = 1024
BATCH = 4
SEQ = 4096
DEPTH = 4

PLE_DIM = 256
N_A_LAYERS = DEPTH // 2
N_B_LAYERS = DEPTH - N_A_LAYERS
GDN_HEADS = 8
GDN_HEAD_DIM = 128
GDN_WIDTH = GDN_HEADS * GDN_HEAD_DIM
CONV_WIDTH = 4
GDN_CHUNK = 64
SB_HEADS = 8
SB_HEAD_DIM = 128
SB_WIDTH = SB_HEADS * SB_HEAD_DIM
SB_BLOCK = 128
FFN_HIDDEN = -(-8 * D_MODEL // (3 * 256)) * 256
EPS = 1e-6

kernel_name = "yoco_gdn_stickbreaking_hybrid"


def rms_norm(x, g):
    xf = x.astype(jnp.float32)
    y = xf * lax.rsqrt(jnp.mean(xf * xf, axis=-1, keepdims=True) + EPS)
    return (y * g.astype(jnp.float32)).astype(x.dtype)


def l2_norm(x):
    return x * lax.rsqrt(jnp.sum(x * x, axis=-1, keepdims=True) + EPS)


def causal_conv(x, w):
    k_w, c = w.shape
    return lax.conv_general_dilated(x, w[:, None, :], window_strides=(1,), padding=[(k_w - 1, 0)],
                                    dimension_numbers=('NWC', 'WIO', 'NWC'), feature_group_count=c)


def to_chunks(t):
    b, s, h = t.shape[:3]
    t = t.reshape((b, s // GDN_CHUNK, GDN_CHUNK, h) + t.shape[3:])
    return jnp.swapaxes(t, 2, 3)


def gated_delta_rule(q, k, v, g, beta):
    b_, s_, h_, dk = q.shape
    dv = v.shape[-1]
    c = GDN_CHUNK
    q, k, v, g, beta = to_chunks(q), to_chunks(k), to_chunks(v), to_chunks(g), to_chunks(beta)
    G = jnp.cumsum(g, axis=-1)
    causal = jnp.tril(jnp.ones((c, c), dtype=bool))
    strict = jnp.tril(jnp.ones((c, c), dtype=bool), -1)
    decay_mat = jnp.exp(jnp.where(causal, G[..., :, None] - G[..., None, :], -jnp.inf))
    kk = jnp.einsum('bnhrd,bnhsd->bnhrs', k, k)
    a_low = jnp.where(strict, beta[..., None] * kk * decay_mat, 0.0)
    eye = jnp.eye(c, dtype=q.dtype)
    rhs = jnp.concatenate([v * beta[..., None], k * (beta * jnp.exp(G))[..., None]], axis=-1)
    sol = lax.linalg.triangular_solve(a_low + eye, rhs, left_side=True, lower=True, unit_diagonal=True)
    u, w = sol[..., :dv], sol[..., dv:]
    qk = jnp.einsum('bnhrd,bnhsd->bnhrs', q, k) * decay_mat
    q_dec = q * jnp.exp(G)[..., None]
    k_dec = k * jnp.exp(G[..., -1:] - G)[..., None]
    g_last = jnp.exp(G[..., -1])

    def step(state, xs):
        q_c, k_c, qk_c, u_c, w_c, gl_c = xs
        v_new = u_c - jnp.einsum('bhcd,bhde->bhce', w_c, state)
        o = jnp.einsum('bhcd,bhde->bhce', q_c, state) + jnp.einsum('bhrs,bhse->bhre', qk_c, v_new)
        state = state * gl_c[..., None, None] + jnp.einsum('bhcd,bhce->bhde', k_c, v_new)
        return state, o

    xs = tuple(jnp.moveaxis(t, 1, 0) for t in (q_dec, k_dec, qk, u, w, g_last))
    s0 = jnp.zeros((b_, h_, dk, dv), q.dtype)
    _, o = lax.scan(step, s0, xs)
    return o.transpose(1, 0, 3, 2, 4).reshape(b_, s_, h_, dv)


def gdn_mixer(hn, w_in, w_conv, a_log, dt_bias, norm_g, w_out):
    b_, s_, _ = hn.shape
    proj = hn @ w_in
    qkv = jax.nn.silu(causal_conv(proj[..., :3 * GDN_WIDTH], w_conv))
    gate = proj[..., 3 * GDN_WIDTH:4 * GDN_WIDTH].reshape(b_, s_, GDN_HEADS, GDN_HEAD_DIM)
    a_in = proj[..., 4 * GDN_WIDTH:4 * GDN_WIDTH + GDN_HEADS].astype(jnp.float32)
    b_in = proj[..., 4 * GDN_WIDTH + GDN_HEADS:].astype(jnp.float32)
    qkv = qkv.astype(jnp.float32).reshape(b_, s_, 3, GDN_HEADS, GDN_HEAD_DIM)
    q = l2_norm(qkv[:, :, 0]) * (GDN_HEAD_DIM ** -0.5)
    k = l2_norm(qkv[:, :, 1])
    v = qkv[:, :, 2]
    beta = jax.nn.sigmoid(b_in)
    g = -jnp.exp(a_log.astype(jnp.float32)) * jax.nn.softplus(a_in + dt_bias.astype(jnp.float32))
    o = gated_delta_rule(q, k, v, g, beta).astype(hn.dtype)
    o = rms_norm(o, norm_g) * jax.nn.silu(gate)
    return o.reshape(b_, s_, GDN_WIDTH) @ w_out


def shared_kv(h, kv_norm, w_kv, k_norm):
    b_, s_, _ = h.shape
    kv = (rms_norm(h, kv_norm) @ w_kv).reshape(b_, s_, 2, SB_HEADS, SB_HEAD_DIM)
    k = rms_norm(kv[:, :, 0], k_norm).transpose(0, 2, 1, 3)
    v = kv[:, :, 1].transpose(0, 2, 1, 3)
    return k, v


def stick_breaking(q, k, v):
    s_ = q.shape[2]
    outs = []
    for blk in range(s_ // SB_BLOCK):
        t0, t1 = blk * SB_BLOCK, (blk + 1) * SB_BLOCK
        z = jnp.einsum('bhtd,bhsd->bhts', q[:, :, t0:t1], k[:, :, :t1]).astype(jnp.float32)
        t_idx = t0 + jnp.arange(SB_BLOCK)[:, None]
        s_idx = jnp.arange(t1)[None, :]
        mask = s_idx < t_idx
        log_not = jnp.where(mask, jax.nn.log_sigmoid(-z), 0.0)
        suffix = lax.cumsum(log_not, axis=3, reverse=True) - log_not
        log_w = jnp.where(mask, jax.nn.log_sigmoid(z) + suffix, -jnp.inf)
        wgt = jnp.exp(log_w).astype(v.dtype)
        outs.append(jnp.einsum('bhts,bhsd->bhtd', wgt, v[:, :, :t1]))
    return jnp.concatenate(outs, axis=2)


def sb_mixer(hn, k_sh, v_sh, w_q, q_norm, w_out):
    b_, s_, _ = hn.shape
    q = (hn @ w_q).reshape(b_, s_, SB_HEADS, SB_HEAD_DIM)
    q = (rms_norm(q, q_norm) * (SB_HEAD_DIM ** -0.5)).transpose(0, 2, 1, 3)
    o = stick_breaking(q, k_sh, v_sh)
    return o.transpose(0, 2, 1, 3).reshape(b_, s_, SB_WIDTH) @ w_out


def swiglu(hn, w_in, w_out):
    gu = hn @ w_in
    return (jax.nn.silu(gu[..., :FFN_HIDDEN]) * gu[..., FFN_HIDDEN:]) @ w_out


def setup_inputs(seed: int = 0) -> dict:
    key = jax.random.key(seed)
    ks = jax.random.split(key, 24)
    f32 = jnp.float32

    def nrm(k, shape, fan_in):
        return jax.random.normal(k, shape, f32) * (fan_in ** -0.5)

    def gain(k, shape):
        return 1.0 + 0.02 * jax.random.normal(k, shape, f32)

    dt = jnp.exp(jax.random.uniform(ks[8], (N_A_LAYERS, GDN_HEADS), f32, math.log(1e-3), math.log(1e-1)))
    return {
        "x": jax.random.normal(ks[0], (BATCH, SEQ, D_MODEL), f32),
        "p": jax.random.normal(ks[1], (DEPTH, BATCH, SEQ, PLE_DIM), f32),
        "ln_mix": gain(ks[2], (DEPTH, D_MODEL)),
        "ln_ffn": gain(ks[3], (DEPTH, D_MODEL)),
        "ln_ple": gain(ks[4], (DEPTH, D_MODEL)),
        "gdn_w_in": nrm(ks[5], (N_A_LAYERS, D_MODEL, 4 * GDN_WIDTH + 2 * GDN_HEADS), D_MODEL),
        "gdn_conv": nrm(ks[6], (N_A_LAYERS, CONV_WIDTH, 3 * GDN_WIDTH), CONV_WIDTH),
        "gdn_a_log": jnp.log(jax.random.uniform(ks[7], (N_A_LAYERS, GDN_HEADS), f32, 1.0, 16.0)),
        "gdn_dt_bias": dt + jnp.log(-jnp.expm1(-dt)),
        "gdn_norm": gain(ks[9], (N_A_LAYERS, GDN_HEAD_DIM)),
        "gdn_w_out": nrm(ks[10], (N_A_LAYERS, GDN_WIDTH, D_MODEL), GDN_WIDTH),
        "kv_norm": gain(ks[11], (D_MODEL,)),
        "w_kv": nrm(ks[12], (D_MODEL, 2 * SB_WIDTH), D_MODEL),
        "k_norm": gain(ks[13], (SB_HEAD_DIM,)),
        "sb_w_q": nrm(ks[14], (N_B_LAYERS, D_MODEL, SB_WIDTH), D_MODEL),
        "sb_q_norm": gain(ks[15], (N_B_LAYERS, SB_HEAD_DIM)),
        "sb_w_out": nrm(ks[16], (N_B_LAYERS, SB_WIDTH, D_MODEL), SB_WIDTH),
        "ffn_w_in": nrm(ks[17], (DEPTH, D_MODEL, 2 * FFN_HIDDEN), D_MODEL),
        "ffn_w_out": nrm(ks[18], (DEPTH, FFN_HIDDEN, D_MODEL), FFN_HIDDEN),
        "ple_w_proj": nrm(ks[19], (DEPTH, PLE_DIM, D_MODEL), PLE_DIM),
        "ple_w_gate": nrm(ks[20], (DEPTH, D_MODEL, D_MODEL), D_MODEL),
    }


def reference(x, p, ln_mix, ln_ffn, ln_ple, gdn_w_in, gdn_conv, gdn_a_log, gdn_dt_bias, gdn_norm,
              gdn_w_out, kv_norm, w_kv, k_norm, sb_w_q, sb_q_norm, sb_w_out, ffn_w_in, ffn_w_out,
              ple_w_proj, ple_w_gate):
    h = x
    k_sh, v_sh = None, None
    for i in range(DEPTH):
        hn = rms_norm(h, ln_mix[i])
        if i < N_A_LAYERS:
            h = h + gdn_mixer(hn, gdn_w_in[i], gdn_conv[i], gdn_a_log[i], gdn_dt_bias[i],
                              gdn_norm[i], gdn_w_out[i])
        else:
            j = i - N_A_LAYERS
            h = h + sb_mixer(hn, k_sh, v_sh, sb_w_q[j], sb_q_norm[j], sb_w_out[j])
        h = h + swiglu(rms_norm(h, ln_ffn[i]), ffn_w_in[i], ffn_w_out[i])
        h = h + (p[i] @ ple_w_proj[i]) * jax.nn.sigmoid(rms_norm(h, ln_ple[i]) @ ple_w_gate[i])
        if i == N_A_LAYERS - 1:
            k_sh, v_sh = shared_kv(h, kv_norm, w_kv, k_norm)
    return h
```

```cpp
#include <hip/hip_runtime.h>
#include <hip/hip_cooperative_groups.h>
#include <cstdio>
namespace cg = cooperative_groups;

#ifndef ONE_LAUNCH
#define ONE_LAUNCH 1
#endif
#ifndef MAXPH
#define MAXPH 1000
#endif

#define LAS __attribute__((address_space(3)))
#define GAS __attribute__((address_space(1)))
typedef const GAS char* GCP;
#define DI __device__ __forceinline__
typedef unsigned short bf16_t;
typedef short bf16x8 __attribute__((ext_vector_type(8)));
typedef float f32x4 __attribute__((ext_vector_type(4)));
typedef float f32x16 __attribute__((ext_vector_type(16)));
typedef unsigned u32x4 __attribute__((ext_vector_type(4)));
typedef unsigned u32x2 __attribute__((ext_vector_type(2)));

constexpr int T = 16384, D = 1024, SEQ = 4096, NB = 4, NH = 8, HD = 128, FF = 2816, PLE = 256;
constexpr float EPS = 1e-6f;
constexpr int NWAVES = 8, NTHR = 512;
constexpr int PLD = 4096 + 64;
constexpr int LDS_BYTES = 155648;

constexpr size_t MiB = 1u << 20;
constexpr size_t WS_SS = 0;
constexpr size_t WS_SSQ = 1 * MiB;
constexpr size_t WS_SSK = 2 * MiB;
constexpr size_t WS_GL = 2 * MiB + 512 * 1024;
constexpr size_t WS_BAR = 2 * MiB + 768 * 1024;
constexpr size_t WS_AB = 3 * MiB;
constexpr size_t WS_WIN = 4 * MiB;
constexpr size_t WS_W1 = 20 * MiB;
constexpr size_t WS_W2 = 64 * MiB;
constexpr size_t WS_WO = 86 * MiB;
constexpr size_t WS_WK = 90 * MiB;
constexpr size_t WS_WV = 92 * MiB;
constexpr size_t WS_WQ = 94 * MiB;
constexpr size_t WS_SWO = 98 * MiB;
constexpr size_t WS_WPROJ = 102 * MiB;
constexpr size_t WS_WGATE = 104 * MiB;
constexpr size_t WS_WAB = 112 * MiB;
constexpr size_t WS_R1 = 113 * MiB;
constexpr size_t WS_KB = WS_R1 + 88 * MiB;
constexpr size_t WS_VT = 4 * MiB;
constexpr size_t WS_HB0 = 243 * MiB, WS_HB1 = 275 * MiB;
constexpr size_t WS_OG = 307 * MiB;
constexpr size_t WS_PB = WS_R1 + 120 * MiB;
constexpr size_t WS_HALO = WS_OG;
constexpr size_t WS_END = 339 * MiB;

typedef __bf16 bf16v2 __attribute__((ext_vector_type(2)));
DI unsigned cvt_pk_bf16(float lo, float hi) { bf16v2 v; v[0] = (__bf16)lo; v[1] = (__bf16)hi; return __builtin_bit_cast(unsigned, v); }
DI float bf2f(unsigned short b) { return __uint_as_float(((unsigned)b) << 16); }
DI float bflo(unsigned w) { return __uint_as_float(w << 16); }
DI float bfhi(unsigned w) { return __uint_as_float(w & 0xffff0000u); }
DI float sigmoidf_(float x) { return __builtin_amdgcn_rcpf(1.0f + __expf(-x)); }
DI float siluf_(float x) { return x * __builtin_amdgcn_rcpf(1.0f + __expf(-x)); }
DI float softplusf_(float x) { return fmaxf(x, 0.f) + 0.6931471805599453f * __builtin_amdgcn_logf(1.0f + __builtin_amdgcn_exp2f(-1.4426950408889634f * fabsf(x))); }
constexpr float SS_SCALE = 2048.0f, SS_INV = 1.0f / 2048.0f, SH_SCALE = 16384.0f, SH_INV = 1.0f / 16384.0f;
DI float ss_rstd(const float* ss, int row) { return rsqrtf((float)((const unsigned*)ss)[row] * (SS_INV / 1024.0f) + 1e-6f); }
DI void ss_add(float* ss, int row, float v) { atomicAdd((unsigned*)ss + row, (unsigned)(v * SS_SCALE + 0.5f)); }
DI float wave_sum(float v) {
#pragma unroll
    for (int o = 1; o < 64; o <<= 1) v += __shfl_xor(v, o);
    return v;
}

namespace pg8 {
constexpr int BM = 256, BK = 64, HALF = 128, HTB = HALF * BK * 2, STAGE_BYTES = 8 * HTB, NXCD = 8, WGM = 8;
DI int lds_byte(int r, int c) { const int st = (r >> 4) * 2 + (c >> 5), rr = r & 15, cc = c & 31, ob = rr * 64 + cc * 2; return st * 1024 + (ob ^ (((ob >> 9) & 1) << 5)); }
DI void stage_rc(int b, int& R, int& C) { const int st = b / 1024, sb = b % 1024, swz = sb ^ (((sb >> 9) & 1) << 5); R = (st >> 1) * 16 + swz / 64; C = (st & 1) * 32 + (swz % 64) / 2; }
DI int perm32(int rho) { const int n = rho >> 4, i = rho & 15; return 8 * (i >> 2) + 4 * n + (i & 3); }
struct Unit { int pm, pn; };
struct Gemm { const bf16_t* A; const bf16_t* Bt; int M, N, K; };
struct StaticOrder {
    int nM, nN, nwg, G, c;
    DI void init(int M, int N, int G_, int c_) { nM = M / BM; nN = N / BM; nwg = nM * nN; G = G_; c = c_; }
    DI bool next(int i, Unit& u) const {
        const long L = (long)i * G + c; if (L >= nwg) return false;
        int wgid = (int)L; { const int q = nwg / NXCD, r = nwg % NXCD, xcd = wgid % NXCD, off = wgid / NXCD; wgid = (xcd < r ? xcd * (q + 1) : r * (q + 1) + (xcd - r) * q) + off; }
        const int nig = WGM * nN, gid = wgid / nig, fm = gid * WGM, gsz = (nM - fm) < WGM ? (nM - fm) : WGM;
        u.pm = fm + ((wgid % nig) % gsz); u.pn = (wgid % nig) / gsz; return true;
    }
};

template <class Epi>
DI void gemm_phase(LAS unsigned char* lds, const Gemm g, const StaticOrder& S, const Epi& E, const int tid) {
    const int wid = __builtin_amdgcn_readfirstlane(tid >> 6), lane = tid & 63, wr = wid >> 2, wc = wid & 3, fr = lane & 15, fq = lane >> 4;
    const int K = g.K, nt = K / BK;
    unsigned voffA[2], voffB[2];
#pragma unroll
    for (int i = 0; i < 2; ++i) { int R, C; stage_rc(tid * 16 + i * 8192, R, C); const int Rb = Epi::PERM ? ((R & ~31) + perm32(R & 31)) : R;
        voffA[i] = (unsigned)(R * K + C) * 2u; voffB[i] = (unsigned)(Rb * K + C) * 2u; }
    const size_t kstep = (size_t)(BK * 2);
    const size_t hstep = (size_t)HALF * K * 2;
    const size_t tstep = 2 * hstep;
    const unsigned ldsw = (unsigned)wid * 1024u;
    const int aoff = lds_byte(wr * 64 + fr, fq * 8), boff = lds_byte(wc * 32 + fr, fq * 8);
#define PG8_SA(b, h) (((b) * 2 + (h)) * HTB)
#define PG8_SB(b, h) ((4 + (b) * 2 + (h)) * HTB)
#define PG8_STAGE(bufoff, gbase, voff) do { _Pragma("unroll") for (int _i = 0; _i < 2; ++_i) \
        __builtin_amdgcn_global_load_lds((const unsigned*)((const char*)(gbase) + (voff)[_i]), (LAS unsigned*)(lds + (bufoff) + ldsw + _i * 8192), 16, 0, 0); } while (0)
#define PG8_LDA(dst, b, h) do { _Pragma("unroll") for (int m = 0; m < 4; ++m) _Pragma("unroll") for (int k = 0; k < 2; ++k) dst[m][k] = *(const LAS bf16x8*)(lds + PG8_SA(b, h) + aoff + m * 2048 + k * 1024); } while (0)
#define PG8_LDB(dst, b, h) do { _Pragma("unroll") for (int n = 0; n < 2; ++n) _Pragma("unroll") for (int k = 0; k < 2; ++k) dst[n][k] = *(const LAS bf16x8*)(lds + PG8_SB(b, h) + boff + n * 2048 + k * 1024); } while (0)
#define PG8_MMA(ai, bj, At, Bt) do { __builtin_amdgcn_s_setprio(1); _Pragma("unroll") for (int m = 0; m < 4; ++m) _Pragma("unroll") for (int n = 0; n < 2; ++n) _Pragma("unroll") for (int k = 0; k < 2; ++k) \
        acc[ai][bj][m][n] = __builtin_amdgcn_mfma_f32_16x16x32_bf16(Bt[n][k], At[m][k], acc[ai][bj][m][n], 0, 0, 0); __builtin_amdgcn_s_setprio(0); } while (0)
#define PG8_WAIT_V(n) asm volatile("s_waitcnt vmcnt(" #n ")" ::: "memory")
#define PG8_WAIT_L(n) asm volatile("s_waitcnt lgkmcnt(" #n ")" ::: "memory")
#define PG8_BAR __builtin_amdgcn_s_barrier()
#define PG8_SCHED __builtin_amdgcn_sched_barrier(0)
    Unit cur, nxt; int ui = 0;
    if (!S.next(0, cur)) return;
    f32x4 acc[2][2][4][2];
#pragma unroll
    for (int a = 0; a < 2; ++a)
#pragma unroll
        for (int b = 0; b < 2; ++b)
#pragma unroll
            for (int m = 0; m < 4; ++m)
#pragma unroll
                for (int n = 0; n < 2; ++n) acc[a][b][m][n] = (f32x4){0.f, 0.f, 0.f, 0.f};
    bf16x8 At[4][2], B0[2][2], B1[2][2];
    const char* cA = (const char*)g.A + (size_t)cur.pm * tstep; const char* cB = (const char*)g.Bt + (size_t)cur.pn * tstep;
    PG8_STAGE(PG8_SB(0, 0), cB, voffB); PG8_STAGE(PG8_SA(0, 0), cA, voffA); PG8_STAGE(PG8_SB(0, 1), cB + hstep, voffB); PG8_STAGE(PG8_SA(0, 1), cA + hstep, voffA);
    if (wr == 1) PG8_BAR;
    PG8_WAIT_V(4); PG8_BAR;
    PG8_STAGE(PG8_SB(1, 0), cB + kstep, voffB); PG8_STAGE(PG8_SA(1, 0), cA + kstep, voffA); PG8_STAGE(PG8_SB(1, 1), cB + hstep + kstep, voffB);
    PG8_WAIT_V(6); PG8_BAR;
    for (;;) {
        const bool has_next = S.next(ui + 1, nxt);
        const char* nA = has_next ? (const char*)g.A + (size_t)nxt.pm * tstep : cA; const char* nB = has_next ? (const char*)g.Bt + (size_t)nxt.pn * tstep : cB;
        for (int t = 0; t < nt; t += 2) {
            const bool last = (t == nt - 2);
            const char* a1 = cA + (size_t)(t + 1) * kstep;
            const char* a2 = last ? nA : cA + (size_t)(t + 2) * kstep; const char* b2 = last ? nB : cB + (size_t)(t + 2) * kstep;
            const char* a3 = a2 + kstep; const char* b3 = b2 + kstep;
            PG8_LDB(B0, 0, 0); PG8_SCHED; PG8_LDA(At, 0, 0); PG8_STAGE(PG8_SA(1, 1), a1 + hstep, voffA);
            PG8_WAIT_L(8); PG8_BAR; PG8_WAIT_L(0); PG8_MMA(0, 0, At, B0); PG8_BAR; PG8_SCHED;
            PG8_LDB(B1, 0, 1); PG8_STAGE(PG8_SB(0, 0), b2, voffB);
            PG8_BAR; PG8_WAIT_L(0); PG8_MMA(0, 1, At, B1); PG8_BAR;
            PG8_LDA(At, 0, 1); PG8_STAGE(PG8_SA(0, 0), a2, voffA);
            PG8_BAR; PG8_WAIT_L(0); PG8_MMA(1, 0, At, B0); PG8_BAR; PG8_SCHED;
            PG8_STAGE(PG8_SB(0, 1), b2 + hstep, voffB);
            PG8_WAIT_V(6); PG8_BAR; PG8_MMA(1, 1, At, B1); PG8_BAR;
            PG8_LDB(B0, 1, 0); PG8_SCHED; PG8_LDA(At, 1, 0); PG8_STAGE(PG8_SA(0, 1), a2 + hstep, voffA);
            PG8_WAIT_L(8); PG8_BAR; PG8_WAIT_L(0); PG8_MMA(0, 0, At, B0); PG8_BAR; PG8_SCHED;
            PG8_LDB(B1, 1, 1); PG8_STAGE(PG8_SB(1, 0), b3, voffB);
            PG8_BAR; PG8_WAIT_L(0); PG8_MMA(0, 1, At, B1); PG8_BAR;
            PG8_LDA(At, 1, 1); PG8_STAGE(PG8_SA(1, 0), a3, voffA);
            PG8_BAR; PG8_WAIT_L(0); PG8_MMA(1, 0, At, B0); PG8_BAR; PG8_SCHED;
            PG8_STAGE(PG8_SB(1, 1), b3 + hstep, voffB);
            PG8_WAIT_V(6); PG8_BAR; PG8_MMA(1, 1, At, B1); PG8_BAR;
        }
        E(acc, cur, wr, wc, fr, fq);
        if (!has_next) break;
#pragma unroll
        for (int a = 0; a < 2; ++a)
#pragma unroll
            for (int b = 0; b < 2; ++b)
#pragma unroll
                for (int m = 0; m < 4; ++m)
#pragma unroll
                    for (int n = 0; n < 2; ++n) acc[a][b][m][n] = (f32x4){0.f, 0.f, 0.f, 0.f};
        cur = nxt; cA = nA; cB = nB; ++ui;
    }
    PG8_WAIT_V(0);
    if (wr == 0) PG8_BAR;
    PG8_BAR;
#undef PG8_SA
#undef PG8_SB
#undef PG8_STAGE
#undef PG8_LDA
#undef PG8_LDB
#undef PG8_MMA
#undef PG8_WAIT_V
#undef PG8_WAIT_L
#undef PG8_BAR
#undef PG8_SCHED
}

typedef const f32x4 (&AccT)[2][2][4][2];

template <int MODE> struct EpiBf16 {
    static constexpr bool PERM = true;
    bf16_t* O; int ldc; const float* ss; bf16_t* halo; float* ssh; bool kfrag;
    DI void operator()(AccT acc, const Unit& u, int wr, int wc, int fr, int fq) const {
        const int row0 = u.pm * BM + wr * 64 + fr, col0 = u.pn * BM + wc * 32 + 8 * fq;
        float rs[8];
#pragma unroll
        for (int i = 0; i < 8; ++i) rs[i] = (MODE == 1) ? 1.0f : ss_rstd(ss, row0 + (i >> 2) * HALF + (i & 3) * 16);
#pragma unroll
        for (int ai = 0; ai < 2; ++ai)
#pragma unroll
            for (int m = 0; m < 4; ++m) {
                const int row = row0 + ai * HALF + m * 16;
                const float r = rs[ai * 4 + m];
#pragma unroll
                for (int bj = 0; bj < 2; ++bj) {
                    const f32x4 v0 = acc[ai][bj][m][0] * r, v1 = acc[ai][bj][m][1] * r;
                    u32x4 w; w.x = cvt_pk_bf16(v0[0], v0[1]); w.y = cvt_pk_bf16(v0[2], v0[3]); w.z = cvt_pk_bf16(v1[0], v1[1]); w.w = cvt_pk_bf16(v1[2], v1[3]);
                    const int col = col0 + bj * HALF;
                    if (MODE == 2 && kfrag) { const int d0 = col & 127;
                        *(u32x4*)(O + ((size_t)((((row >> 12) * NH + (col >> 7)) * (SEQ / 32) + ((row & (SEQ - 1)) >> 5)) * 8 + (d0 >> 4)) * 512) + (((d0 >> 3) & 1) * 32 + (row & 31)) * 8) = w; }
                    else *(u32x4*)(O + (size_t)row * ldc + col) = w;
                    if (MODE == 0) { if ((row & 63) >= 61 && col < 3072) *(u32x4*)(halo + ((size_t)(row >> 6) * 3 + ((row & 63) - 61)) * 3072 + col) = w; }
                    if (MODE == 2) {
                        float sq = (v0[0] * v0[0] + v0[1] * v0[1]) + (v0[2] * v0[2] + v0[3] * v0[3]) + (v1[0] * v1[0] + v1[1] * v1[1]) + (v1[2] * v1[2] + v1[3] * v1[3]);
                        sq += __shfl_xor(sq, 16); sq += __shfl_xor(sq, 32);
                        if (fq == 0) atomicAdd((unsigned*)ssh + (size_t)((row >> 12) * NH + (2 * u.pn + bj)) * SEQ + (row & (SEQ - 1)), (unsigned)(sq * SH_SCALE + 0.5f));
                    }
                }
            }
    }
};
struct EpiVT {
    static constexpr bool PERM = true;
    bf16_t* O; const float* ss;
    DI void operator()(AccT acc, const Unit& u, int wr, int wc, int fr, int fq) const {
        const int row0 = u.pm * BM + wr * 64 + fr, col0 = u.pn * BM + wc * 32 + 8 * fq;
        f32x4 rs[2][2];
#pragma unroll
        for (int bj = 0; bj < 2; ++bj)
#pragma unroll
            for (int n = 0; n < 2; ++n) { const u32x4 s4 = *(const u32x4*)(ss + col0 + bj * HALF + 4 * n);
#pragma unroll
                for (int j = 0; j < 4; ++j) rs[bj][n][j] = rsqrtf((float)s4[j] * (SS_INV / D) + EPS); }
#pragma unroll
        for (int ai = 0; ai < 2; ++ai)
#pragma unroll
            for (int m = 0; m < 4; ++m) {
                const int row = row0 + ai * HALF + m * 16;
#pragma unroll
                for (int bj = 0; bj < 2; ++bj) {
                    const f32x4 v0 = acc[ai][bj][m][0] * rs[bj][0], v1 = acc[ai][bj][m][1] * rs[bj][1];
                    u32x4 w; w.x = cvt_pk_bf16(v0[0], v0[1]); w.y = cvt_pk_bf16(v0[2], v0[3]); w.z = cvt_pk_bf16(v1[0], v1[1]); w.w = cvt_pk_bf16(v1[2], v1[3]);
                    const int tok = col0 + bj * HALF, sl_ = tok & 31;
                    bf16_t* vb_ = O + ((size_t)(((((tok >> 12) * NH + (row >> 7)) * (SEQ / 32) + ((tok & (SEQ - 1)) >> 5)) * 4 + ((row & 127) >> 5)) * 2 + ((sl_ >> 4) & 1)) * 512) + (row & 31) * 8 + ((sl_ >> 3) & 1) * 4;
                    *(u32x2*)(vb_) = (u32x2){w.x, w.y}; *(u32x2*)(vb_ + 256) = (u32x2){w.z, w.w};
                }
            }
    }
};
struct EpiSwiglu {
    static constexpr bool PERM = true;
    bf16_t* O; const float* ss; bool dry;
    DI void operator()(AccT acc, const Unit& u, int wr, int wc, int fr, int fq) const {
        if (dry) return;
        const int row0 = u.pm * BM + wr * 64 + fr, col0 = u.pn * HALF + wc * 32 + 8 * fq;
        float rs[8];
#pragma unroll
        for (int i = 0; i < 8; ++i) rs[i] = ss_rstd(ss, row0 + (i >> 2) * HALF + (i & 3) * 16);
#pragma unroll
        for (int ai = 0; ai < 2; ++ai)
#pragma unroll
            for (int m = 0; m < 4; ++m) {
                const int row = row0 + ai * HALF + m * 16;
                const float r = rs[ai * 4 + m];
                float o[8];
#pragma unroll
                for (int n = 0; n < 2; ++n)
#pragma unroll
                    for (int j = 0; j < 4; ++j) { const float gt = acc[ai][0][m][n][j] * r, up = acc[ai][1][m][n][j] * r; o[n * 4 + j] = siluf_(gt) * up; }
                u32x4 w; w.x = cvt_pk_bf16(o[0], o[1]); w.y = cvt_pk_bf16(o[2], o[3]); w.z = cvt_pk_bf16(o[4], o[5]); w.w = cvt_pk_bf16(o[6], o[7]);
                *(u32x4*)(O + (size_t)row * FF + col0) = w;
            }
    }
};
template <bool GATE> struct EpiRes {
    static constexpr bool PERM = false;
    float* h; bf16_t* hb; float* ss_out; const float* ss_in; const bf16_t* pp; const float* hin;
    DI void operator()(AccT acc, const Unit& u, int wr, int wc, int fr, int fq) const {
        const int row0 = u.pm * BM + wr * 64 + fr, col0 = u.pn * BM + wc * 32 + 4 * fq;
        float rs[8];
#pragma unroll
        for (int i = 0; i < 8; ++i) rs[i] = GATE ? ss_rstd(ss_in, row0 + (i >> 2) * HALF + (i & 3) * 16) : 1.0f;
        f32x4 hv[2][4]; u32x2 pv[2][4];
#define ER_LOAD(i_, b_) do { const size_t o_ = (size_t)(row0 + ((i_) >> 2) * HALF + ((i_) & 3) * 16) * D + col0; \
            _Pragma("unroll") for (int q = 0; q < 4; ++q) { hv[b_][q] = *(const f32x4*)(hin + o_ + (q >> 1) * HALF + (q & 1) * 16); \
                if (GATE) pv[b_][q] = *(const u32x2*)(pp + o_ + (q >> 1) * HALF + (q & 1) * 16); } } while (0)
        ER_LOAD(0, 0);
#pragma unroll
        for (int i = 0; i < 8; ++i) {
            const int ai = i >> 2, m = i & 3, bsel = i & 1;
            if (i + 1 < 8) { if (bsel) ER_LOAD(i + 1, 0); else ER_LOAD(i + 1, 1); }
            const int row = row0 + ai * HALF + m * 16; const float r = rs[i];
            float sq = 0.f;
#pragma unroll
            for (int q = 0; q < 4; ++q) {
                const int bj = q >> 1, n = q & 1;
                const size_t off = (size_t)row * D + col0 + bj * HALF + n * 16;
                f32x4 hvv = hv[bsel][q]; f32x4 a = acc[ai][bj][m][n];
                if (GATE) { const u32x2 pw = pv[bsel][q];
                    a[0] = bflo(pw.x) * sigmoidf_(a[0] * r); a[1] = bfhi(pw.x) * sigmoidf_(a[1] * r); a[2] = bflo(pw.y) * sigmoidf_(a[2] * r); a[3] = bfhi(pw.y) * sigmoidf_(a[3] * r); }
                hvv = hvv + a;
                *(f32x4*)(h + off) = hvv;
                u32x2 w; w.x = cvt_pk_bf16(hvv[0], hvv[1]); w.y = cvt_pk_bf16(hvv[2], hvv[3]);
                *(u32x2*)(hb + off) = w;
                sq += (hvv[0] * hvv[0] + hvv[1] * hvv[1]) + (hvv[2] * hvv[2] + hvv[3] * hvv[3]);
            }
            sq += __shfl_xor(sq, 16); sq += __shfl_xor(sq, 32);
            if (fq == 0) ss_add(ss_out, row, sq);
        }
#undef ER_LOAD
    }
};
}

struct Args { const float* in[21]; float* out; unsigned char* ws; int ph_lo, ph_hi, coop, pad; };
enum { I_X = 0, I_P, I_LNMIX, I_LNFFN, I_LNPLE, I_GWIN, I_GCONV, I_GALOG, I_GDT, I_GNORM, I_GWOUT, I_KVNORM, I_WKV, I_KNORM, I_SWQ, I_SQNORM, I_SWOUT, I_FWIN, I_FWOUT, I_PPROJ, I_PGATE };

DI void transpose_item(const float* W, int ldw, int col0, int K, const float* gain, bf16_t* WT, int dst_row0, int k0, int n0, LAS float* scr, int lane) {
    float v[32];
    const float* wp = W + (size_t)(k0 + (lane >> 5)) * ldw + col0 + n0 + (lane & 31);
#pragma unroll
    for (int i = 0; i < 32; ++i) v[i] = wp[(size_t)(2 * i) * ldw];
    const int c = lane & 7;
    f32x4 g0 = (f32x4){1.f, 1.f, 1.f, 1.f}, g1 = g0;
    if (gain) { g0 = *(const f32x4*)(gain + k0 + 8 * c); g1 = *(const f32x4*)(gain + k0 + 8 * c + 4); }
#pragma unroll
    for (int i = 0; i < 32; ++i) scr[(2 * i + (lane >> 5)) * 33 + (lane & 31)] = v[i];
    asm volatile("s_waitcnt lgkmcnt(0)" ::: "memory");
#pragma unroll
    for (int j = 0; j < 4; ++j) { const int n = (lane >> 3) + 8 * j; const LAS float* sp = scr + (8 * c) * 33 + n;
        u32x4 o; o.x = cvt_pk_bf16(sp[0 * 33] * g0[0], sp[1 * 33] * g0[1]); o.y = cvt_pk_bf16(sp[2 * 33] * g0[2], sp[3 * 33] * g0[3]); o.z = cvt_pk_bf16(sp[4 * 33] * g1[0], sp[5 * 33] * g1[1]); o.w = cvt_pk_bf16(sp[6 * 33] * g1[2], sp[7 * 33] * g1[3]);
        *(u32x4*)(WT + (size_t)(dst_row0 + n) * K + k0 + 8 * c) = o; }
    asm volatile("s_waitcnt lgkmcnt(0)" ::: "memory");
}
struct TJob { const float* W; int ldw, col0, K, ncols; const float* gain; bf16_t* WT; int mode; };
DI TJob get_job(int j, const Args& a) {
    TJob t; t.mode = 0; t.gain = nullptr; t.col0 = 0;
    unsigned char* ws = a.ws;
    if (j < 2) { t.W = a.in[I_GWIN] + (size_t)j * D * 4112; t.ldw = 4112; t.K = D; t.ncols = 4096; t.gain = a.in[I_LNMIX] + j * D; t.WT = (bf16_t*)(ws + WS_WIN) + (size_t)j * 4096 * D; return t; } j -= 2;
    if (j < 4) { t.W = a.in[I_FWIN] + (size_t)j * D * 5632; t.ldw = 5632; t.K = D; t.ncols = 5632; t.gain = a.in[I_LNFFN] + j * D; t.WT = (bf16_t*)(ws + WS_W1) + (size_t)j * 5632 * D; t.mode = 1; return t; } j -= 4;
    if (j < 4) { t.W = a.in[I_FWOUT] + (size_t)j * FF * D; t.ldw = D; t.K = FF; t.ncols = D; t.WT = (bf16_t*)(ws + WS_W2) + (size_t)j * D * FF; return t; } j -= 4;
    if (j < 2) { t.W = a.in[I_GWOUT] + (size_t)j * D * D; t.ldw = D; t.K = D; t.ncols = D; t.WT = (bf16_t*)(ws + WS_WO) + (size_t)j * D * D; return t; } j -= 2;
    if (j < 2) { t.W = a.in[I_WKV]; t.ldw = 2048; t.col0 = j * 1024; t.K = D; t.ncols = D; t.gain = a.in[I_KVNORM]; t.WT = (bf16_t*)(ws + (j ? WS_WV : WS_WK)); return t; } j -= 2;
    if (j < 2) { t.W = a.in[I_SWQ] + (size_t)j * D * D; t.ldw = D; t.K = D; t.ncols = D; t.gain = a.in[I_LNMIX] + (2 + j) * D; t.WT = (bf16_t*)(ws + WS_WQ) + (size_t)j * D * D; return t; } j -= 2;
    if (j < 2) { t.W = a.in[I_SWOUT] + (size_t)j * D * D; t.ldw = D; t.K = D; t.ncols = D; t.WT = (bf16_t*)(ws + WS_SWO) + (size_t)j * D * D; return t; } j -= 2;
    if (j < 4) { t.W = a.in[I_PPROJ] + (size_t)j * PLE * D; t.ldw = D; t.K = PLE; t.ncols = D; t.WT = (bf16_t*)(ws + WS_WPROJ) + (size_t)j * D * PLE; return t; } j -= 4;
    t.W = a.in[I_PGATE] + (size_t)j * D * D; t.ldw = D; t.K = D; t.ncols = D; t.gain = a.in[I_LNPLE] + j * D; t.WT = (bf16_t*)(ws + WS_WGATE) + (size_t)j * D * D; return t;
}
constexpr int NJOBS = 26;

DI void phase_prep(const Args& a, LAS unsigned char* lds, int gw, int NGW, int wave, int lane) {
    LAS float* scr = (LAS float*)(lds + wave * 16384);
    for (int j = 0; j < NJOBS; ++j) {
        const TJob t = get_job(j, a);
        const int nblk = t.ncols / 32, nitems = (t.K / 64) * nblk;
        for (int it = gw; it < nitems; it += NGW) {
            const int kb = it / nblk, nb = it % nblk, n0 = nb * 32;
            int drow = n0;
            if (t.mode == 1) { drow = (n0 < FF) ? ((n0 / 128) * 256 + (n0 % 128)) : (((n0 - FF) / 128) * 256 + 128 + ((n0 - FF) % 128)); }
            transpose_item(t.W, t.ldw, t.col0, t.K, t.gain, t.WT, drow, kb * 64, n0, scr, lane);
        }
    }
    const int gt = gw * 64 + lane, NGT = NGW * 64;
    for (int i = gt; i < 2 * 16 * D; i += NGT) { const int l = i / (16 * D), n = (i / D) % 16, k = i % D;
        const float v = a.in[I_GWIN][(size_t)l * D * 4112 + (size_t)k * 4112 + 4096 + n] * a.in[I_LNMIX][l * D + k];
        ((bf16_t*)(a.ws + WS_WAB))[i] = (bf16_t)(cvt_pk_bf16(v, 0.f) & 0xffffu); }
    { float* z = (float*)(a.ws + WS_SS) + T; for (int i = gt; i < 12 * T; i += NGT) z[i] = 0.f;
      float* z2 = (float*)(a.ws + WS_SSQ); for (int i = gt; i < (int)((WS_GL - WS_SSQ) / 4); i += NGT) z2[i] = 0.f; }
    float* ss0 = (float*)(a.ws + WS_SS); bf16_t* hb0 = (bf16_t*)(a.ws + WS_HB0);
    for (int m = gw; m < T; m += NGW) {
        const f32x4* xr = (const f32x4*)(a.in[I_X] + (size_t)m * D) + lane; u32x2* hbr = (u32x2*)(hb0 + (size_t)m * D) + lane;
        float s = 0.f;
#pragma unroll
        for (int j = 0; j < 4; ++j) { const f32x4 v = xr[64 * j]; u32x2 w; w.x = cvt_pk_bf16(v[0], v[1]); w.y = cvt_pk_bf16(v[2], v[3]); hbr[64 * j] = w; s += (v[0] * v[0] + v[1] * v[1]) + (v[2] * v[2] + v[3] * v[3]); }
        s = wave_sum(s);
        if (lane == 0) ((unsigned*)ss0)[m] = (unsigned)(s * SS_SCALE + 0.5f);
    }
}

DI void convert_p(const Args& a, int L, int gt, int NGT) {
    const f32x4* src = (const f32x4*)(a.in[I_P] + (size_t)L * T * PLE); u32x4* dst = (u32x4*)(a.ws + WS_PB);
    for (int i = gt; i < T * PLE / 8; i += NGT) { const f32x4 v0 = src[2 * i], v1 = src[2 * i + 1];
        u32x4 w; w.x = cvt_pk_bf16(v0[0], v0[1]); w.y = cvt_pk_bf16(v0[2], v0[3]); w.z = cvt_pk_bf16(v1[0], v1[1]); w.w = cvt_pk_bf16(v1[2], v1[3]); dst[i] = w; }
}

DI void ab_gemm(const bf16_t* hb, const bf16_t* wab, const float* ss, float* AB, int gw, int NGW, int lane) {
    const int fr = lane & 15, fq = lane >> 4;
    for (int tile = gw; tile < T / 16; tile += NGW) {
        f32x4 acc = (f32x4){0.f, 0.f, 0.f, 0.f};
        const bf16_t* ap = hb + (size_t)(tile * 16 + fr) * D + 8 * fq; const bf16_t* bp = wab + (size_t)fr * D + 8 * fq;
#pragma unroll 1
        for (int k8 = 0; k8 < D / 256; ++k8) {
            bf16x8 av[8], bv[8];
#pragma unroll
            for (int j = 0; j < 8; ++j) { av[j] = *(const bf16x8*)(ap + 256 * k8 + 32 * j); bv[j] = *(const bf16x8*)(bp + 256 * k8 + 32 * j); }
            asm volatile("" : "+v"(av[0]), "+v"(av[1]), "+v"(av[2]), "+v"(av[3]), "+v"(av[4]), "+v"(av[5]), "+v"(av[6]), "+v"(av[7]),
                              "+v"(bv[0]), "+v"(bv[1]), "+v"(bv[2]), "+v"(bv[3]), "+v"(bv[4]), "+v"(bv[5]), "+v"(bv[6]), "+v"(bv[7]));
#pragma unroll
            for (int j = 0; j < 8; ++j) acc = __builtin_amdgcn_mfma_f32_16x16x32_bf16(av[j], bv[j], acc, 0, 0, 0);
        }
#pragma unroll
        for (int r = 0; r < 4; ++r) { const int row = tile * 16 + 4 * fq + r; AB[(size_t)row * 16 + fr] = acc[r] * ss_rstd(ss, row); }
    }
}

constexpr int SA_QS = 0, SA_KS = 32768, SA_VS = 65536, SA_STG = 98304, SA_A = SA_STG, SA_KB = SA_A + 16384, SA_QB = SA_KB + 64 * 136 * 2, SA_BETA = SA_STG + 67 * 384 * 2, SA_G = SA_BETA + 256, SA_RQ = SA_G + 256, SA_RK = SA_RQ + 256;
static_assert(SA_QB + 64 * 136 * 2 <= SA_BETA && SA_RK + 256 <= LDS_BYTES - 16, "stage A LDS");

DI void gdn_stage_a(const Args& a, int L, LAS unsigned char* lds, int tid, int wave, int lane, const bool dry) {
    const int l = L;
    bf16_t* proj = (bf16_t*)(a.ws + WS_R1);
    const bf16_t* halo = (const bf16_t*)(a.ws + WS_HALO);
    bf16_t* wbuf = (bf16_t*)(a.ws + ((L & 1) ? WS_HB1 : WS_HB0));
    bf16_t* qkd = (bf16_t*)(a.ws + ((L & 1) ? WS_HB0 : WS_HB1));
    float* GL = (float*)(a.ws + WS_GL);
    const float* AB = (const float*)(a.ws + WS_AB);
    const float* convw = a.in[I_GCONV] + (size_t)l * 4 * 3072;
    LAS float* qs = (LAS float*)(lds + SA_QS); LAS float* ks = (LAS float*)(lds + SA_KS); LAS float* vs = (LAS float*)(lds + SA_VS); LAS float* Am = (LAS float*)(lds + SA_A); LAS bf16_t* stg = (LAS bf16_t*)(lds + SA_STG);
    LAS bf16_t* kb = (LAS bf16_t*)(lds + SA_KB); LAS bf16_t* qb = (LAS bf16_t*)(lds + SA_QB);
    LAS float* sbeta = (LAS float*)(lds + SA_BETA); LAS float* sG = (LAS float*)(lds + SA_G); LAS float* srq = (LAS float*)(lds + SA_RQ); LAS float* srk = (LAS float*)(lds + SA_RK);

    for (int item = blockIdx.x; item < NB * NH * 64; item += gridDim.x) {
        const int n = item & 63, bh = item >> 6, h = bh & 7, b = bh >> 3;
        const int t0 = b * SEQ + n * 64;
        int tidv = tid; asm volatile("" : "+v"(tidv));
        {
            u32x4 rv[7];
#pragma unroll
            for (int i = 0; i < 7; ++i) { const int id = tidv + i * NTHR; rv[i] = (u32x4){0u, 0u, 0u, 0u};
                if (id < 67 * 48) { const int row = id / 48, cc = id % 48, seg = cc >> 4, off = (cc & 15) * 8, rr = row - 3;
                    if (rr >= 0) rv[i] = *(const u32x4*)(proj + (size_t)(t0 + rr) * PLD + seg * 1024 + h * 128 + off);
                    else if (n > 0) rv[i] = *(const u32x4*)(halo + ((size_t)(b * 64 + n - 1) * 3 + row) * 3072 + seg * 1024 + h * 128 + off); } }
#pragma unroll
            for (int i = 0; i < 7; ++i) { const int id = tidv + i * NTHR;
                if (id < 67 * 48) { const int row = id / 48, cc = id % 48; *(LAS u32x4*)(stg + row * 384 + cc * 8) = rv[i]; } }
            if (tidv >= 448) {
                const int r = tidv - 448;
                const float ain = AB[(size_t)(t0 + r) * 16 + h], bin = AB[(size_t)(t0 + r) * 16 + 8 + h];
                float g = -__expf(a.in[I_GALOG][l * NH + h]) * softplusf_(ain + a.in[I_GDT][l * NH + h]);
#pragma unroll
                for (int o = 1; o < 64; o <<= 1) { const float t_ = __shfl_up(g, o); if (r >= o) g += t_; }
                sbeta[r] = sigmoidf_(bin); sG[r] = g;
                if (r == 63) GL[bh * 64 + n] = __expf(g);
            }
        }
        __syncthreads();
#pragma unroll 1
        for (int task = tidv; task < 384 * 4; task += NTHR) {
            const int col = task % 384, r0 = (task / 384) * 16, seg = col >> 7, c = col & 127, ch = seg * 1024 + h * 128 + c;
            const float w0 = convw[ch], w1 = convw[3072 + ch], w2 = convw[2 * 3072 + ch], w3 = convw[3 * 3072 + ch];
            LAS float* dst = (seg == 0 ? qs : seg == 1 ? ks : vs) + c;
            const LAS bf16_t* sp = stg + r0 * 384 + col;
            float x0 = bf2f(sp[0]), x1 = bf2f(sp[384]), x2 = bf2f(sp[2 * 384]);
#pragma unroll
            for (int r = 0; r < 16; ++r) { const float x3 = bf2f(sp[(r + 3) * 384]); dst[(r0 + r) * 128] = siluf_(w0 * x0 + w1 * x1 + w2 * x2 + w3 * x3); x0 = x1; x1 = x2; x2 = x3; }
        }
        __syncthreads();
        { const int r = tidv >> 3, l8 = tidv & 7; float sq = 0.f, sk = 0.f;
#pragma unroll
            for (int j = 0; j < 4; ++j) { const f32x4 qv = *(LAS f32x4*)(qs + r * 128 + 32 * j + 4 * l8), kv = *(LAS f32x4*)(ks + r * 128 + 32 * j + 4 * l8);
                sq += (qv[0] * qv[0] + qv[1] * qv[1]) + (qv[2] * qv[2] + qv[3] * qv[3]); sk += (kv[0] * kv[0] + kv[1] * kv[1]) + (kv[2] * kv[2] + kv[3] * kv[3]); }
            sq += __shfl_xor(sq, 1); sk += __shfl_xor(sk, 1); sq += __shfl_xor(sq, 2); sk += __shfl_xor(sk, 2); sq += __shfl_xor(sq, 4); sk += __shfl_xor(sk, 4);
            if (l8 == 0) { srq[r] = rsqrtf(sq + EPS) * 0.08838834764831845f; srk[r] = rsqrtf(sk + EPS); } }
        __syncthreads();
#pragma unroll 1
        for (int i = tidv; i < 64 * 32; i += NTHR) { const int r = i >> 5, c4 = (i & 31) * 4;
            f32x4 qv = *(LAS f32x4*)(qs + r * 128 + c4) * srq[r], kv = *(LAS f32x4*)(ks + r * 128 + c4) * srk[r];
            *(LAS f32x4*)(qs + r * 128 + c4) = qv; *(LAS f32x4*)(ks + r * 128 + c4) = kv;
            u32x2 wq, wk; wq.x = cvt_pk_bf16(qv[0], qv[1]); wq.y = cvt_pk_bf16(qv[2], qv[3]); wk.x = cvt_pk_bf16(kv[0], kv[1]); wk.y = cvt_pk_bf16(kv[2], kv[3]);
            *(LAS u32x2*)(qb + r * 136 + c4) = wq; *(LAS u32x2*)(kb + r * 136 + c4) = wk; }
        __syncthreads();
        {
            const int fr = lane & 15, fq = lane >> 4;
#pragma unroll
            for (int tt = 0; tt < 2; ++tt) { const int tile = wave * 2 + tt, rt = tile >> 2, ct = tile & 3;
                f32x4 acc = (f32x4){0.f, 0.f, 0.f, 0.f};
#pragma unroll
                for (int kk = 0; kk < 4; ++kk) { const bf16x8 av = *(LAS bf16x8*)(kb + (16 * rt + fr) * 136 + 32 * kk + 8 * fq), bv = *(LAS bf16x8*)(kb + (16 * ct + fr) * 136 + 32 * kk + 8 * fq);
                    acc = __builtin_amdgcn_mfma_f32_16x16x32_bf16(av, bv, acc, 0, 0, 0); }
                const int s = 16 * ct + fr; const float Gs = sG[s];
#pragma unroll
                for (int rg = 0; rg < 4; ++rg) { const int r = 16 * rt + 4 * fq + rg; const float v = (s < r) ? sbeta[r] * acc[rg] * __expf(sG[r] - Gs) : 0.f; Am[r * 64 + s] = v; } }
        }
        __syncthreads();
        if (tid < 256) {
            int lz; asm volatile("v_mov_b32 %0, 0" : "=v"(lz));
            LAS float* sbeta_v = sbeta + lz; LAS float* sG_v = sG + lz; LAS float* Am_v = Am + lz;
            float X[64];
            if (tid < 128) {
#pragma unroll
                for (int r = 0; r < 64; ++r) X[r] = vs[r * 128 + tid] * sbeta_v[r];
            } else {
#pragma unroll
                for (int r = 0; r < 64; ++r) X[r] = ks[r * 128 + (tid - 128)] * sbeta_v[r] * __expf(sG_v[r]);
            }
#pragma unroll
            for (int r = 1; r < 64; ++r) {
                float a0 = 0.f, a1 = 0.f, a2 = 0.f, a3 = 0.f;
#pragma unroll
                for (int s4 = 0; s4 < (r + 3) / 4; ++s4) { const f32x4 av = *(LAS f32x4*)(Am_v + r * 64 + 4 * s4);
                    a0 += av[0] * X[4 * s4]; a1 += av[1] * X[4 * s4 + 1]; a2 += av[2] * X[4 * s4 + 2]; a3 += av[3] * X[4 * s4 + 3]; }
                X[r] -= (a0 + a1) + (a2 + a3);
            }
            if (tid < 128) {
                bf16_t* vs_ = proj + (size_t)t0 * PLD + 2048 + h * 128 + (size_t)((tid >> 4) * 8) * PLD + (tid & 15) * 4;
#pragma unroll
                for (int rp = 0; rp < 8; ++rp) {
#pragma unroll
                    for (int hf = 0; hf < 2; ++hf) { const int c0 = 16 * (rp >> 1) + 4 * (2 * (rp & 1) + hf); u32x2 w; w.x = cvt_pk_bf16(X[c0], X[c0 + 1]); w.y = cvt_pk_bf16(X[c0 + 2], X[c0 + 3]);
                        if (!dry) *(u32x2*)(vs_ + hf * 64) = w; }
                    vs_ += PLD; asm volatile("" : "+v"(vs_)); }
            } else {
                const int c_ = tid - 128;
                bf16_t* wp = wbuf + (size_t)t0 * D + h * 128 + (size_t)((c_ >> 5) * 4 + ((c_ >> 3) & 3)) * D + (c_ & 7);
#pragma unroll
                for (int rt_ = 0; rt_ < 4; ++rt_) {
#pragma unroll
                    for (int fr_ = 0; fr_ < 16; ++fr_) wp[fr_ * 8] = (bf16_t)(cvt_pk_bf16(X[16 * rt_ + fr_], 0.f) & 0xffffu);
                    wp += 16 * D; asm volatile("" : "+v"(wp)); }
            }
        } else {
            const int w4 = wave - 4, fr = lane & 15, fq = lane >> 4, tt = tid - 256;
            bf16_t* qk_o = qkd + (size_t)item * 4096;
#pragma unroll
            for (int ct = 0; ct < 4; ++ct) {
                f32x4 acc = (f32x4){0.f, 0.f, 0.f, 0.f};
#pragma unroll
                for (int kk = 0; kk < 4; ++kk) { const bf16x8 av = *(LAS bf16x8*)(qb + (16 * w4 + fr) * 136 + 32 * kk + 8 * fq), bv = *(LAS bf16x8*)(kb + (16 * ct + fr) * 136 + 32 * kk + 8 * fq);
                    acc = __builtin_amdgcn_mfma_f32_16x16x32_bf16(av, bv, acc, 0, 0, 0); }
                const int s = 16 * ct + fr; const float Gs = sG[s];
#pragma unroll
                for (int rg = 0; rg < 4; ++rg) { const int r = 16 * w4 + 4 * fq + rg; const float v = (s <= r) ? acc[rg] * __expf(sG[r] - Gs) : 0.f;
                    qk_o[((r >> 4) * 2 + (s >> 5)) * 512 + (((s >> 3) & 3) * 16 + (r & 15)) * 8 + (s & 7)] = (bf16_t)(cvt_pk_bf16(v, 0.f) & 0xffffu); }
            }
#pragma unroll 1
            for (int i = tt; i < 64 * 16; i += 256) { const int blk_ = i >> 6, ln_ = i & 63, r = 16 * (blk_ >> 2) + (ln_ & 15), c8 = 32 * (blk_ & 3) + 8 * (ln_ >> 4); const float e = __expf(sG[r]);
                const f32x4 v0 = *(LAS f32x4*)(qs + r * 128 + c8) * e, v1 = *(LAS f32x4*)(qs + r * 128 + c8 + 4) * e;
                u32x4 w; w.x = cvt_pk_bf16(v0[0], v0[1]); w.y = cvt_pk_bf16(v0[2], v0[3]); w.z = cvt_pk_bf16(v1[0], v1[1]); w.w = cvt_pk_bf16(v1[2], v1[3]);
                if (!dry) *(u32x4*)(proj + (size_t)t0 * PLD + h * 128 + (size_t)((((r >> 4) * 4 + (c8 >> 5)) * 4) + ((c8 >> 3) & 3)) * PLD + (r & 15) * 8) = w; }
            const float Glast = sG[63];
#pragma unroll 1
            for (int i = tt; i < 128 * 8; i += 256) { const int blk_ = i >> 6, ln_ = i & 63, dk = 16 * (blk_ >> 1) + (ln_ & 15), c8 = 32 * (blk_ & 1) + 8 * (ln_ >> 4); float v[8];
#pragma unroll
                for (int j = 0; j < 8; ++j) v[j] = ks[(c8 + j) * 128 + dk] * __expf(Glast - sG[c8 + j]);
                u32x4 w; w.x = cvt_pk_bf16(v[0], v[1]); w.y = cvt_pk_bf16(v[2], v[3]); w.z = cvt_pk_bf16(v[4], v[5]); w.w = cvt_pk_bf16(v[6], v[7]);
                if (!dry) *(u32x4*)(proj + (size_t)t0 * PLD + 1024 + h * 128 + (size_t)((((dk >> 4) * 2 + (c8 >> 5)) * 4) + ((c8 >> 3) & 3)) * PLD + (dk & 15) * 8) = w; }
        }
        __syncthreads();
    }
}

constexpr int SB_ST = 0, SB_VT = 16 * 136 * 2;
DI void gdn_stage_b(const Args& a, int L, LAS unsigned char* lds, int wave, int lane) {
    const bf16_t* proj = (const bf16_t*)(a.ws + WS_R1);
    const bf16_t* wbuf = (const bf16_t*)(a.ws + ((L & 1) ? WS_HB1 : WS_HB0));
    const bf16_t* qkd = (const bf16_t*)(a.ws + ((L & 1) ? WS_HB0 : WS_HB1));
    const float* GL = (const float*)(a.ws + WS_GL);
    bf16_t* og = (bf16_t*)(a.ws + WS_OG);
    LAS bf16_t* sT = (LAS bf16_t*)(lds + SB_ST); LAS bf16_t* vT = (LAS bf16_t*)(lds + SB_VT);
    const int fr = lane & 15, fq = lane >> 4, rt = wave & 3;
    for (int item = blockIdx.x; item < NB * NH * 8; item += gridDim.x) {
        const int xcd_ = item & 7, idx_ = item >> 3;
        const int sl = idx_ & 7, bh = xcd_ * 4 + (idx_ >> 3), h = bh & 7, b = bh >> 3, dv0 = sl * 16;
        f32x4 Sacc = (f32x4){0.f, 0.f, 0.f, 0.f};
        __syncthreads();
        { unsigned zz; asm volatile("v_mov_b32 %0, 0" : "=v"(zz)); u32x2 z2; z2.x = zz; z2.y = zz; *(LAS u32x2*)(sT + fr * 136 + 16 * wave + 4 * fq) = z2; }
        __syncthreads();
        const size_t strideA = (wave < 4) ? (size_t)128 * D * 2 : (size_t)128 * PLD * 2, strideX = (wave < 4) ? (size_t)128 * PLD * 2 : (size_t)2 * 8192, stepA = strideA / 2, stepX = strideX / 2;
        const size_t kstepA = (wave < 4) ? (size_t)4 * D * 2 : (size_t)4 * PLD * 2;
        GCP pa0 = (wave < 4) ? (GCP)wbuf + ((size_t)(b * SEQ + 16 * rt + fq) * D + h * 128 + 8 * fr) * 2 : (GCP)proj + ((size_t)(b * SEQ + 16 * rt + fq) * PLD + h * 128 + 8 * fr) * 2;
        GCP pk0 = (GCP)proj + ((size_t)(b * SEQ) * PLD + 1024 + h * 128 + (size_t)(8 * wave + fq) * PLD + 8 * fr) * 2;
        GCP px0 = (wave < 4) ? (GCP)proj + ((size_t)(b * SEQ) * PLD + 2048 + h * 128 + (size_t)((sl * 4 + rt) * 2 + (lane >> 5)) * PLD + (lane & 31) * 4) * 2
                                     : (GCP)qkd + ((size_t)(bh * 64) * 4096 + rt * 1024 + lane * 8) * 2;
        const size_t kstepX = (wave < 4) ? (size_t)16 : (size_t)1024;
        GCP paA = pa0, paB = pa0 + stepA, paC = pa0 + 2 * stepA, paD = pa0 + 3 * stepA;
        GCP pkA = pk0, pkB = pk0 + (size_t)64 * PLD * 2, pkC = pk0 + 2 * 524288, pkD = pk0 + 3 * 524288;
        GCP pxA = px0, pxB = px0 + stepX, pxC = px0 + 2 * stepX, pxD = px0 + 3 * stepX;
#define SB_LOAD(n_, PA, PK, PX, AF, UW, QF, KF, GLV) do { \
            _Pragma("unroll") for (int kk = 0; kk < 4; ++kk) AF[kk] = *(GAS const bf16x8*)(PA + kk * kstepA); \
            KF[0] = *(GAS const bf16x8*)(PK); KF[1] = *(GAS const bf16x8*)(PK + (size_t)4 * PLD * 2); \
            QF[0] = *(GAS const bf16x8*)(PX); QF[1] = *(GAS const bf16x8*)(PX + kstepX);     \
            GLV = GL[bh * 64 + (n_)]; \
            PA += strideA; PK += (size_t)128 * PLD * 2; PX += strideX; asm volatile("" : "+v"(PA), "+v"(PK), "+v"(PX)); } while (0)
#define SB_BODY(n_, AF, UW, QF, KF, GLV) do { const int t0_ = b * SEQ + (n_) * 64; \
            f32x4 acc = (f32x4){0.f, 0.f, 0.f, 0.f}; \
            _Pragma("unroll") for (int kk = 0; kk < 4; ++kk) { const bf16x8 bv = *(LAS bf16x8*)(sT + fr * 136 + 32 * kk + 8 * fq); acc = __builtin_amdgcn_mfma_f32_16x16x32_bf16(AF[kk], bv, acc, 0, 0, 0); } \
            if (wave < 4) { \
                const u32x4 uq_ = __builtin_bit_cast(u32x4, QF[0]); f32x4 vn; vn[0] = bflo(uq_.x) - acc[0]; vn[1] = bfhi(uq_.x) - acc[1]; vn[2] = bflo(uq_.y) - acc[2]; vn[3] = bfhi(uq_.y) - acc[3]; \
                u32x2 w_; w_.x = cvt_pk_bf16(vn[0], vn[1]); w_.y = cvt_pk_bf16(vn[2], vn[3]); \
                *(LAS u32x2*)(vT + fr * 72 + 16 * rt + 4 * fq) = w_; } \
            __syncthreads(); \
            const bf16x8 vb0 = *(LAS bf16x8*)(vT + fr * 72 + 8 * fq), vb1 = *(LAS bf16x8*)(vT + fr * 72 + 32 + 8 * fq); \
            if (wave >= 4) { \
                acc = __builtin_amdgcn_mfma_f32_16x16x32_bf16(QF[0], vb0, acc, 0, 0, 0); \
                acc = __builtin_amdgcn_mfma_f32_16x16x32_bf16(QF[1], vb1, acc, 0, 0, 0); \
                bf16_t* op = og + (size_t)(t0_ + 16 * rt + 4 * fq) * D + h * 128 + dv0 + fr; \
                _Pragma("unroll") for (int rg = 0; rg < 4; ++rg) op[(size_t)rg * D] = (bf16_t)(cvt_pk_bf16(acc[rg], 0.f) & 0xffffu); } \
            Sacc = Sacc * GLV; \
            Sacc = __builtin_amdgcn_mfma_f32_16x16x32_bf16(KF[0], vb0, Sacc, 0, 0, 0); \
            Sacc = __builtin_amdgcn_mfma_f32_16x16x32_bf16(KF[1], vb1, Sacc, 0, 0, 0); \
            { u32x2 w_; w_.x = cvt_pk_bf16(Sacc[0], Sacc[1]); w_.y = cvt_pk_bf16(Sacc[2], Sacc[3]); *(LAS u32x2*)(sT + fr * 136 + 16 * wave + 4 * fq) = w_; } \
            __syncthreads(); } while (0)
        bf16x8 afA[4], afB[4], qfA[2], qfB[2], kfA[2], kfB[2]; u32x2 uwA = (u32x2){0u, 0u}, uwB = uwA; float glA, glB;
        (void)uwA; (void)uwB; (void)paC; (void)paD; (void)pkC; (void)pkD; (void)pxC; (void)pxD;
        SB_LOAD(0, paA, pkA, pxA, afA, uwA, qfA, kfA, glA);
        for (int n = 0; n < 64; n += 2) {
            SB_LOAD(n + 1, paB, pkB, pxB, afB, uwB, qfB, kfB, glB);
            SB_BODY(n, afA, uwA, qfA, kfA, glA);
            if (n + 2 < 64) SB_LOAD(n + 2, paA, pkA, pxA, afA, uwA, qfA, kfA, glA);
            SB_BODY(n + 1, afB, uwB, qfB, kfB, glB);
        }
#undef SB_LOAD
#undef SB_BODY
    }
}

DI void gdn_stage_c(const Args& a, int L, int gw, int NGW, int lane) {
    bf16_t* og = (bf16_t*)(a.ws + WS_OG); const bf16_t* proj = (const bf16_t*)(a.ws + WS_R1);
    const float* ng = a.in[I_GNORM] + L * HD + (lane & 7) * 16;
    float gn[16];
#pragma unroll
    for (int j = 0; j < 16; ++j) gn[j] = ng[j];
    for (int m = gw; m < T; m += NGW) {
        u32x4* op = (u32x4*)(og + (size_t)m * D + lane * 16); const u32x4* gp = (const u32x4*)(proj + (size_t)m * PLD + 3072 + lane * 16);
        const u32x4 o0 = op[0], o1 = op[1], g0 = gp[0], g1 = gp[1];
        float o[16], g[16];
#pragma unroll
        for (int j = 0; j < 4; ++j) { o[2 * j] = bflo(o0[j]); o[2 * j + 1] = bfhi(o0[j]); o[8 + 2 * j] = bflo(o1[j]); o[8 + 2 * j + 1] = bfhi(o1[j]);
            g[2 * j] = bflo(g0[j]); g[2 * j + 1] = bfhi(g0[j]); g[8 + 2 * j] = bflo(g1[j]); g[8 + 2 * j + 1] = bfhi(g1[j]); }
        float s = 0.f;
#pragma unroll
        for (int j = 0; j < 16; ++j) s += o[j] * o[j];
        s += __shfl_xor(s, 1); s += __shfl_xor(s, 2); s += __shfl_xor(s, 4);
        const float r = rsqrtf(s * (1.0f / HD) + EPS);
        float y[16];
#pragma unroll
        for (int j = 0; j < 16; ++j) y[j] = o[j] * r * gn[j] * siluf_(g[j]);
        u32x4 w0, w1;
#pragma unroll
        for (int j = 0; j < 4; ++j) { w0[j] = cvt_pk_bf16(y[2 * j], y[2 * j + 1]); w1[j] = cvt_pk_bf16(y[8 + 2 * j], y[8 + 2 * j + 1]); }
        op[0] = w0; op[1] = w1;
    }
}

DI void sb_attention(const Args& a, int j2, int gw, int NGW, int lane) {
    const bf16_t* qo = (const bf16_t*)(a.ws + WS_OG); bf16_t* ob = (bf16_t*)(a.ws + WS_R1); const bf16_t* kbuf = (const bf16_t*)(a.ws + WS_KB); const bf16_t* vt = (const bf16_t*)(a.ws + WS_VT);
    const float* ssq = (const float*)(a.ws + WS_SSQ) + (size_t)j2 * NB * NH * SEQ; const float* ssk = (const float*)(a.ws + WS_SSK);
    const float* qn = a.in[I_SQNORM] + j2 * HD; const float* kn = a.in[I_KNORM];
    const int tl = lane & 31, hh = lane >> 5;
    for (int item = gw; item < NB * NH * (SEQ / 32); item += NGW) {
        const int qt = (SEQ / 32 - 1) - (item & 127), bh = item >> 7, h = bh & 7, b = bh >> 3, t0 = qt * 32;
        const size_t qrow = (size_t)(b * SEQ + t0 + tl) * D + h * 128;
        bf16x8 qf[8];
        {
            const float rq = rsqrtf((float)((const unsigned*)ssq)[(size_t)bh * SEQ + t0 + tl] * (SH_INV / HD) + EPS) * 0.08838834764831845f;
#pragma unroll
            for (int ks = 0; ks < 8; ++ks) { const u32x4 raw = *(const u32x4*)(qo + qrow + 16 * ks + 8 * hh);
                const f32x4 g0 = *(const f32x4*)(qn + 16 * ks + 8 * hh) * *(const f32x4*)(kn + 16 * ks + 8 * hh), g1 = *(const f32x4*)(qn + 16 * ks + 8 * hh + 4) * *(const f32x4*)(kn + 16 * ks + 8 * hh + 4);
                u32x4 w; w.x = cvt_pk_bf16(bflo(raw.x) * rq * g0[0], bfhi(raw.x) * rq * g0[1]); w.y = cvt_pk_bf16(bflo(raw.y) * rq * g0[2], bfhi(raw.y) * rq * g0[3]);
                w.z = cvt_pk_bf16(bflo(raw.z) * rq * g1[0], bfhi(raw.z) * rq * g1[1]); w.w = cvt_pk_bf16(bflo(raw.w) * rq * g1[2], bfhi(raw.w) * rq * g1[3]);
                qf[ks] = __builtin_bit_cast(bf16x8, w); }
        }
        f32x16 o[4];
#pragma unroll
        for (int dt = 0; dt < 4; ++dt)
#pragma unroll
            for (int i = 0; i < 16; ++i) o[dt][i] = 0.f;
        float carry = 0.f;
        bf16x8 kf[8];
        { const bf16_t* kp = kbuf + ((size_t)(bh * (SEQ / 32) + qt) * 8) * 512 + lane * 8;
#pragma unroll
          for (int ks = 0; ks < 8; ++ks) kf[ks] = *(const bf16x8*)(kp + 512 * ks); }
        for (int kt = qt; kt >= 0; --kt) {
            const int s0 = kt * 32;
            f32x16 z;
#pragma unroll
            for (int i = 0; i < 16; ++i) z[i] = 0.f;
#pragma unroll
            for (int ks = 0; ks < 8; ++ks) z = __builtin_amdgcn_mfma_f32_32x32x16_bf16(kf[ks], qf[ks], z, 0, 0, 0);
            if (kt > 0) {
                const bf16_t* kp = kbuf + ((size_t)(bh * (SEQ / 32) + kt - 1) * 8) * 512 + lane * 8;
#pragma unroll
                for (int ks = 0; ks < 8; ++ks) kf[ks] = *(const bf16x8*)(kp + 512 * ks);
            }
            bf16x8 vf[4][2];
            const bf16_t* vp = vt + ((size_t)(bh * (SEQ / 32) + kt) * 8) * 512 + lane * 8;
#define ATT_VLOAD(dt) do { _Pragma("unroll") for (int kv = 0; kv < 2; ++kv) vf[dt][kv] = *(const bf16x8*)(vp + ((dt) * 2 + kv) * 512); } while (0)
            ATT_VLOAD(0); ATT_VLOAD(1);
            float ln[16], zz[16];
            const bool diag = (kt == qt);
#pragma unroll
            for (int g = 0; g < 4; ++g) { const u32x4 k4 = *(const u32x4*)(ssk + (size_t)bh * SEQ + s0 + 8 * g + 4 * hh);
#pragma unroll
                for (int i = 0; i < 4; ++i) { const float rk = rsqrtf((float)k4[i] * (SH_INV / HD) + EPS); const float zv = z[4 * g + i] * rk;
                    const bool valid = !diag || (8 * g + 4 * hh + i < tl);
                    zz[4 * g + i] = zv; ln[4 * g + i] = valid ? -softplusf_(zv) : 0.f; } }
            float gs[4], og_[4];
#pragma unroll
            for (int g = 0; g < 4; ++g) { gs[g] = (ln[4 * g] + ln[4 * g + 1]) + (ln[4 * g + 2] + ln[4 * g + 3]); og_[g] = __shfl_xor(gs[g], 32); }
            float after[4]; float run = carry;
#pragma unroll
            for (int g = 3; g >= 0; --g) { after[g] = run + (hh == 0 ? og_[g] : 0.f); run += gs[g] + og_[g]; }
            float wv[16];
#pragma unroll
            for (int g = 0; g < 4; ++g) { float suf = after[g];
#pragma unroll
                for (int i = 3; i >= 0; --i) { const int e = 4 * g + i; const bool valid = !diag || (8 * g + 4 * hh + i < tl);
                    wv[e] = valid ? __expf(zz[e] + ln[e] + suf) : 0.f; suf += ln[e]; } }
            carry = run;
            ATT_VLOAD(2); ATT_VLOAD(3);
#undef ATT_VLOAD
#pragma unroll
            for (int kv = 0; kv < 2; ++kv) { u32x4 p; p.x = cvt_pk_bf16(wv[8 * kv], wv[8 * kv + 1]); p.y = cvt_pk_bf16(wv[8 * kv + 2], wv[8 * kv + 3]); p.z = cvt_pk_bf16(wv[8 * kv + 4], wv[8 * kv + 5]); p.w = cvt_pk_bf16(wv[8 * kv + 6], wv[8 * kv + 7]);
                const bf16x8 pb = __builtin_bit_cast(bf16x8, p);
#pragma unroll
                for (int dt = 0; dt < 4; ++dt) o[dt] = __builtin_amdgcn_mfma_f32_32x32x16_bf16(vf[dt][kv], pb, o[dt], 0, 0, 0); }
            if (__ballot(carry >= -110.0f) == 0ull) break;
        }
#pragma unroll
        for (int dt = 0; dt < 4; ++dt)
#pragma unroll
            for (int g = 0; g < 4; ++g) { u32x2 w; w.x = cvt_pk_bf16(o[dt][4 * g], o[dt][4 * g + 1]); w.y = cvt_pk_bf16(o[dt][4 * g + 2], o[dt][4 * g + 3]);
                *(u32x2*)(ob + qrow + 32 * dt + 8 * g + 4 * hh) = w; }
    }
}

#define XB_TMO      128
#define XB_XCNT(j)  (256  + 64 * (j))
#define XB_XSUB(j)  (1280 + 64 * (j))
#define XB_XGEN(j)  (2304 + 64 * (j))
#define XB_TOP      3328
#define XB_TOPGEN   3392
#define XCD_BAR_WORDS 3456
#define XB_SPIN_CAP (1u << 18)
DI unsigned xb_ld(unsigned* p)              { return __hip_atomic_load(p, __ATOMIC_RELAXED, __HIP_MEMORY_SCOPE_AGENT); }
DI unsigned xb_add(unsigned* p, unsigned v) { return __hip_atomic_fetch_add(p, v, __ATOMIC_RELAXED, __HIP_MEMORY_SCOPE_AGENT); }
DI unsigned xb_xcc_id() { return (unsigned)__builtin_amdgcn_s_getreg((3 << 11) | 20) & 0xFu; }
#define XB_SPIN(cond, bar) do { unsigned _sp = 0; while (cond) { __builtin_amdgcn_s_sleep(1); \
    if ((++_sp & 255u) == 0u) { if (xb_ld(&(bar)[XB_TMO])) break; if (_sp > XB_SPIN_CAP) { atomicAdd(&(bar)[XB_TMO], 1u); break; } } } } while (0)
struct XcdBarrier { unsigned* bar; unsigned x; volatile LAS unsigned* st; };
DI XcdBarrier xcd_barrier_post(unsigned* bar, volatile LAS unsigned* st) {
    XcdBarrier b; b.bar = bar; b.x = xb_xcc_id(); b.st = st;
    if (threadIdx.x == 0) (void)xb_add(&bar[XB_XCNT(b.x)], 1u);
    return b;
}
DI void xcd_barrier_complete(unsigned* bar, unsigned x, unsigned& nloc, unsigned& nx) {
    const unsigned G = gridDim.x * gridDim.y * gridDim.z;
    unsigned sum, cnt, mine, sp = 0u;
    for (;;) {
        sum = 0u; cnt = 0u; mine = 0u;
#pragma unroll
        for (unsigned j = 0; j < 16; ++j) { const unsigned c = xb_ld(&bar[XB_XCNT(j)]); sum += c; cnt += (c > 0u) ? 1u : 0u; mine = (j == x) ? c : mine; }
        if (sum == G) break;
        __builtin_amdgcn_s_sleep(1);
        if ((++sp & 255u) == 0u) { if (xb_ld(&bar[XB_TMO])) break; if (sp > XB_SPIN_CAP) { atomicAdd(&bar[XB_TMO], 1u); break; } }
    }
    nloc = mine > 0u ? mine : 1u; nx = cnt > 0u ? cnt : 1u;
}
DI void xcd_barrier(const XcdBarrier& b) {
    asm volatile("s_waitcnt vmcnt(0)" ::: "memory");
    __syncthreads();
    if (threadIdx.x == 0) {
        unsigned* bar = b.bar;
        __builtin_amdgcn_s_waitcnt(0);
        unsigned nloc = b.st[0], nx = b.st[1];
        if (nloc == 0u) { xcd_barrier_complete(bar, b.x, nloc, nx); b.st[0] = nloc; b.st[1] = nx; }
        const unsigned old = xb_add(&bar[XB_XSUB(b.x)], 1u);
        const unsigned gen = old / nloc;
        if (old + 1u == (gen + 1u) * nloc) {
            __builtin_amdgcn_fence(__ATOMIC_RELEASE, "agent");
            asm volatile("s_waitcnt vmcnt(0)" ::: "memory");
            const unsigned og = xb_add(&bar[XB_TOP], 1u);
            const unsigned tg = og / nx;
            if (og + 1u == (tg + 1u) * nx) xb_add(&bar[XB_TOPGEN], 1u);
            else XB_SPIN(xb_ld(&bar[XB_TOPGEN]) == tg, bar);
            __builtin_amdgcn_fence(__ATOMIC_ACQUIRE, "agent");
            xb_add(&bar[XB_XGEN(b.x)], 1u);
            asm volatile("s_waitcnt vmcnt(0)" ::: "memory");
        } else {
            XB_SPIN(xb_ld(&bar[XB_XGEN(b.x)]) == gen, bar);
            __builtin_amdgcn_fence(__ATOMIC_ACQUIRE, "agent");
            asm volatile("s_waitcnt vmcnt(0)" ::: "memory");
        }
    }
    __syncthreads();
}

enum Kind { K_PREP = 0, K_GIN, K_STA, K_STB, K_STC, K_OUT, K_FUP, K_FDN, K_PP, K_GATE, K_SINQ, K_SINV, K_ATT };
constexpr int NPHASES = 1 + 9 * 2 + 9 + 7;
DI void decode_phase(int ph, int& L, int& kind, int& sub, int& sync) {
    sub = 0; sync = 1;
    if (ph == 0) { L = 0; kind = K_PREP; sync = 0; return; }
    ph -= 1;
    if (ph < 18) { L = ph / 9; const int st = ph % 9;
        kind = st == 0 ? K_GIN : st == 1 ? K_STA : st == 2 ? K_STB : st == 3 ? K_STC : st == 4 ? K_OUT : st == 5 ? K_PP : st == 6 ? K_FUP : st == 7 ? K_FDN : K_GATE;
        if (st == 6) sync = 0; return; }
    ph -= 18;
    int st;
    if (ph < 9) { L = 2; st = ph; if (st == 1) { kind = K_SINQ; sub = 1; sync = 0; return; } if (st == 2) { kind = K_SINV; sync = 0; return; } if (st > 2) st -= 2; }
    else { L = 3; st = ph - 9; }
    kind = st == 0 ? K_SINQ : st == 1 ? K_ATT : st == 2 ? K_OUT : st == 3 ? K_PP : st == 4 ? K_FUP : st == 5 ? K_FDN : K_GATE;
    if (st == 4) sync = 0;
}

__global__ void __launch_bounds__(NTHR, 2) fwd_kernel(Args a0) {
    extern __shared__ __attribute__((aligned(16))) unsigned char lds_raw[];
    LAS unsigned char* lds = (LAS unsigned char*)lds_raw;
    XcdBarrier bar; bar.bar = (unsigned*)(a0.ws + WS_BAR); bar.x = 0; bar.st = (volatile LAS unsigned*)(lds + LDS_BYTES - 16);
    if (a0.coop) {
        if (threadIdx.x < 4) ((LAS unsigned*)(lds + LDS_BYTES - 16))[threadIdx.x] = 0u;
        __syncthreads();
        bar = xcd_barrier_post((unsigned*)(a0.ws + WS_BAR), (volatile LAS unsigned*)(lds + LDS_BYTES - 16));
    }
    for (int ph = a0.ph_lo; ph < a0.ph_hi; ++ph) {
        int L, kind, sub, sync; decode_phase(ph, L, kind, sub, sync);
        if (ph > a0.ph_lo && a0.coop && sync) { if (a0.coop == 2) cg::this_grid().sync(); else xcd_barrier(bar); }
#ifdef XSYNC
        if (ph == 1) { for (int i = 0; i < XSYNC; ++i) xcd_barrier(bar); }
#endif
#ifdef REP_KIND
        for (int rep = 0; rep < ((kind == REP_KIND) ? 2 : 1); ++rep) {
        if (rep) xcd_barrier(bar);
#endif
#ifdef ONLY_KIND
        if (kind != ONLY_KIND) continue;
#endif
        size_t zo; asm volatile("s_mov_b64 %0, 0" : "=s"(zo));
        int tid = threadIdx.x; asm volatile("" : "+v"(tid));
        const int lane = tid & 63, wave = __builtin_amdgcn_readfirstlane(tid >> 6);
        const int G = gridDim.x, gw = blockIdx.x * NWAVES + wave, NGW = G * NWAVES, gt = gw * 64 + lane, NGT = NGW * 64;
        Args a;
#pragma unroll
        for (int i = 0; i < 21; ++i) a.in[i] = a0.in[i] + zo;
        a.out = a0.out + zo; a.ws = a0.ws + zo; a.ph_lo = 0; a.ph_hi = 0; a.coop = 0; a.pad = 0;
        unsigned char* ws = a.ws;
        float* SS = (float*)(ws + WS_SS);
        bf16_t* hb_cur = (bf16_t*)(ws + ((L & 1) ? WS_HB1 : WS_HB0)); bf16_t* hb_oth = (bf16_t*)(ws + ((L & 1) ? WS_HB0 : WS_HB1));
        pg8::StaticOrder S;
        switch (kind) {
        case K_PREP: phase_prep(a, lds, gw, NGW, wave, lane); break;
        case K_GIN: {
            pg8::Gemm g{hb_cur, (const bf16_t*)(ws + WS_WIN) + (size_t)L * 4096 * D, T, 4096, D}; S.init(T, 4096, G, blockIdx.x);
            pg8::EpiBf16<0> E{(bf16_t*)(ws + WS_R1), PLD, SS + 3 * L * T, (bf16_t*)(ws + WS_HALO), nullptr, false};
            pg8::gemm_phase(lds, g, S, E, tid);
            ab_gemm(hb_cur, (const bf16_t*)(ws + WS_WAB) + (size_t)L * 16 * D, SS + 3 * L * T, (float*)(ws + WS_AB), gw, NGW, lane);
        } break;
#if defined(REP_KIND)
        case K_STA: gdn_stage_a(a, L, lds, tid, wave, lane, (REP_KIND == K_STA) && rep == 0); break;
#else
        case K_STA: gdn_stage_a(a, L, lds, tid, wave, lane, false); break;
#endif
        case K_STB: gdn_stage_b(a, L, lds, wave, lane); break;
        case K_STC: gdn_stage_c(a, L, gw, NGW, lane); break;
        case K_OUT: {
            const bf16_t* W = (L < 2) ? (const bf16_t*)(ws + WS_WO) + (size_t)L * D * D : (const bf16_t*)(ws + WS_SWO) + (size_t)(L - 2) * D * D;
            pg8::Gemm g{(const bf16_t*)(ws + (L < 2 ? WS_OG : WS_R1)), W, T, D, D}; S.init(T, D, G, blockIdx.x);
            pg8::EpiRes<false> E{a.out, hb_oth, SS + (3 * L + 1) * T, nullptr, nullptr, L == 0 ? a.in[I_X] : a.out};
            pg8::gemm_phase(lds, g, S, E, tid);
            convert_p(a, L, gt, NGT);
        } break;
        case K_FUP: {
            pg8::Gemm g{hb_oth, (const bf16_t*)(ws + WS_W1) + (size_t)L * 5632 * D, T, 5632, D}; S.init(T, 5632, G, blockIdx.x);
#if defined(REP_KIND)
            pg8::EpiSwiglu E{(bf16_t*)(ws + WS_R1), SS + (3 * L + 1) * T, (REP_KIND == K_FUP) && rep == 0};
#else
            pg8::EpiSwiglu E{(bf16_t*)(ws + WS_R1), SS + (3 * L + 1) * T, false};
#endif
            pg8::gemm_phase(lds, g, S, E, tid);
        } break;
        case K_FDN: {
            pg8::Gemm g{(const bf16_t*)(ws + WS_R1), (const bf16_t*)(ws + WS_W2) + (size_t)L * D * FF, T, D, FF}; S.init(T, D, G, blockIdx.x);
            pg8::EpiRes<false> E{a.out, hb_cur, SS + (3 * L + 2) * T, nullptr, nullptr, a.out};
            pg8::gemm_phase(lds, g, S, E, tid);
        } break;
        case K_PP: {
            pg8::Gemm g2{(const bf16_t*)(ws + WS_PB), (const bf16_t*)(ws + WS_WPROJ) + (size_t)L * D * PLE, T, D, PLE};
            if (G == 256) { if (blockIdx.x < 128) break; S.init(T, D, 128, blockIdx.x - 128); } else S.init(T, D, G, blockIdx.x);
            pg8::EpiBf16<1> E2{(bf16_t*)(ws + WS_OG), D, nullptr, nullptr, nullptr, false};
            pg8::gemm_phase(lds, g2, S, E2, tid);
        } break;
        case K_GATE: {
            pg8::Gemm g{hb_cur, (const bf16_t*)(ws + WS_WGATE) + (size_t)L * D * D, T, D, D}; S.init(T, D, G, blockIdx.x);
            pg8::EpiRes<true> E{a.out, hb_oth, SS + (3 * L + 3) * T, SS + (3 * L + 2) * T, (const bf16_t*)(ws + WS_OG), a.out};
            pg8::gemm_phase(lds, g, S, E, tid);
        } break;
        case K_SINQ: {
            pg8::Gemm g{hb_cur, sub == 0 ? (const bf16_t*)(ws + WS_WQ) + (size_t)(L - 2) * D * D : (const bf16_t*)(ws + WS_WK), T, D, D}; S.init(T, D, G, blockIdx.x);
            pg8::EpiBf16<2> E{sub == 0 ? (bf16_t*)(ws + WS_OG) : (bf16_t*)(ws + WS_KB), D, SS + 3 * L * T, nullptr, sub == 0 ? (float*)(ws + WS_SSQ) + (size_t)(L - 2) * NB * NH * SEQ : (float*)(ws + WS_SSK), sub != 0};
            pg8::gemm_phase(lds, g, S, E, tid);
        } break;
        case K_SINV: {
            pg8::Gemm g{(const bf16_t*)(ws + WS_WV), hb_cur, D, T, D}; S.init(D, T, G, blockIdx.x);
            pg8::EpiVT E{(bf16_t*)(ws + WS_VT), SS + 3 * L * T};
            pg8::gemm_phase(lds, g, S, E, tid);
        } break;
        case K_ATT: sb_attention(a, L - 2, gw, NGW, lane); break;
        }
#ifdef REP_KIND
        }
#endif
    }
}

#ifdef DBG_OFF
__global__ void dbg_dump(const unsigned* src, float* dst, int n) { for (int i = blockIdx.x * blockDim.x + threadIdx.x; i < n; i += gridDim.x * blockDim.x) dst[i] = (float)(src[i] & 0xFFFFFFu); }
#endif
extern "C" void kernel_launch(void* const* d_in, const int* in_sizes, int n_in, void* d_out, int out_size, void* d_ws, size_t ws_size, hipStream_t stream) {
    static int grid = 0;
    if (grid == 0) {
        int dev = 0, cus = 0, per_cu = 0;
        hipGetDevice(&dev); hipDeviceGetAttribute(&cus, hipDeviceAttributeMultiprocessorCount, dev);
        hipFuncSetAttribute((const void*)fwd_kernel, hipFuncAttributeMaxDynamicSharedMemorySize, LDS_BYTES);
        hipOccupancyMaxActiveBlocksPerMultiprocessor(&per_cu, (const void*)fwd_kernel, NTHR, LDS_BYTES);
        (void)hipGetLastError();
        if (per_cu < 1) fprintf(stderr, "kernel_launch: occupancy query reports %d blocks per CU\n", per_cu);
        grid = cus > 0 ? cus : 256;
        if (ws_size < WS_END) fprintf(stderr, "kernel_launch: workspace too small: %zu < %zu\n", ws_size, (size_t)WS_END);
    }
    Args a{};
    for (int i = 0; i < 21; ++i) a.in[i] = (const float*)d_in[i];
    a.out = (float*)d_out; a.ws = (unsigned char*)d_ws;
#if ONE_LAUNCH
    hipMemsetAsync((char*)d_ws + WS_BAR, 0, XCD_BAR_WORDS * 4, stream);
    a.ph_lo = 0; a.ph_hi = NPHASES; a.coop = 1;
    void* args[] = {&a};
    hipError_t e = hipLaunchCooperativeKernel((const void*)fwd_kernel, dim3(grid), dim3(NTHR), args, LDS_BYTES, stream);
    if (e != hipSuccess) fprintf(stderr, "cooperative launch failed: %s (grid %d)\n", hipGetErrorString(e), grid);
#else
    for (int ph = 0; ph < NPHASES && ph < MAXPH; ++ph) {
        a.ph_lo = ph; a.ph_hi = ph + 1; a.coop = 0;
        hipLaunchKernelGGL(fwd_kernel, dim3(grid), dim3(NTHR), LDS_BYTES, stream, a);
    }
#ifdef DBG_OFF
    hipLaunchKernelGGL(dbg_dump, dim3(1024), dim3(256), 0, stream, (const unsigned*)((const char*)d_ws + (size_t)(DBG_OFF)), (float*)d_out, out_size);
#endif
#endif
}
```

```cpp
#include <hip/hip_runtime.h>
#include <hip/hip_cooperative_groups.h>
#include <cstdio>
namespace cg = cooperative_groups;

#ifndef ONE_LAUNCH
#define ONE_LAUNCH 1
#endif
#ifndef MAXPH
#define MAXPH 1000
#endif

#define LAS __attribute__((address_space(3)))
#define GAS __attribute__((address_space(1)))
typedef const GAS char* GCP;
#define DI __device__ __forceinline__
typedef unsigned short bf16_t;
typedef short bf16x8 __attribute__((ext_vector_type(8)));
typedef float f32x4 __attribute__((ext_vector_type(4)));
typedef float f32x16 __attribute__((ext_vector_type(16)));
typedef unsigned u32x4 __attribute__((ext_vector_type(4)));
typedef unsigned u32x2 __attribute__((ext_vector_type(2)));

constexpr int T = 16384, D = 1024, SEQ = 4096, NB = 4, NH = 8, HD = 128, FF = 2816, PLE = 256;
constexpr float EPS = 1e-6f;
constexpr int NWAVES = 8, NTHR = 512;
constexpr int PLD = 4096 + 64;
constexpr int LDS_BYTES = 155648;

constexpr size_t MiB = 1u << 20;
constexpr size_t WS_SS = 0;
constexpr size_t WS_SSQ = 1 * MiB;
constexpr size_t WS_SSK = 2 * MiB;
constexpr size_t WS_GL = 2 * MiB + 512 * 1024;
constexpr size_t WS_BAR = 2 * MiB + 768 * 1024;
constexpr size_t WS_AB = 3 * MiB;
constexpr size_t WS_WIN = 4 * MiB;
constexpr size_t WS_W1 = 20 * MiB;
constexpr size_t WS_W2 = 64 * MiB;
constexpr size_t WS_WO = 86 * MiB;
constexpr size_t WS_WK = 90 * MiB;
constexpr size_t WS_WV = 92 * MiB;
constexpr size_t WS_WQ = 94 * MiB;
constexpr size_t WS_SWO = 98 * MiB;
constexpr size_t WS_WPROJ = 102 * MiB;
constexpr size_t WS_WGATE = 104 * MiB;
constexpr size_t WS_WAB = 112 * MiB;
constexpr size_t WS_R1 = 113 * MiB;
constexpr size_t WS_KB = WS_R1 + 88 * MiB;
constexpr size_t WS_VT = 4 * MiB;
constexpr size_t WS_HB0 = 243 * MiB, WS_HB1 = 275 * MiB;
constexpr size_t WS_OG = 307 * MiB;
constexpr size_t WS_PB = WS_R1 + 120 * MiB;
constexpr size_t WS_HALO = WS_OG;
constexpr size_t WS_END = 339 * MiB;

typedef __bf16 bf16v2 __attribute__((ext_vector_type(2)));
DI unsigned cvt_pk_bf16(float lo, float hi) { bf16v2 v; v[0] = (__bf16)lo; v[1] = (__bf16)hi; return __builtin_bit_cast(unsigned, v); }
DI float bf2f(unsigned short b) { return __uint_as_float(((unsigned)b) << 16); }
DI float bflo(unsigned w) { return __uint_as_float(w << 16); }
DI float bfhi(unsigned w) { return __uint_as_float(w & 0xffff0000u); }
DI float sigmoidf_(float x) { return __builtin_amdgcn_rcpf(1.0f + __expf(-x)); }
DI float siluf_(float x) { return x * __builtin_amdgcn_rcpf(1.0f + __expf(-x)); }
DI float softplusf_(float x) { return fmaxf(x, 0.f) + 0.6931471805599453f * __builtin_amdgcn_logf(1.0f + __builtin_amdgcn_exp2f(-1.4426950408889634f * fabsf(x))); }
constexpr float SS_SCALE = 2048.0f, SS_INV = 1.0f / 2048.0f, SH_SCALE = 16384.0f, SH_INV = 1.0f / 16384.0f;
DI float ss_rstd(const float* ss, int row) { return rsqrtf((float)((const unsigned*)ss)[row] * (SS_INV / 1024.0f) + 1e-6f); }
DI void ss_add(float* ss, int row, float v) { atomicAdd((unsigned*)ss + row, (unsigned)(v * SS_SCALE + 0.5f)); }
DI float wave_sum(float v) {
#pragma unroll
    for (int o = 1; o < 64; o <<= 1) v += __shfl_xor(v, o);
    return v;
}

namespace pg8 {
constexpr int BM = 256, BK = 64, HALF = 128, HTB = HALF * BK * 2, STAGE_BYTES = 8 * HTB, NXCD = 8, WGM = 8;
DI int lds_byte(int r, int c) { const int st = (r >> 4) * 2 + (c >> 5), rr = r & 15, cc = c & 31, ob = rr * 64 + cc * 2; return st * 1024 + (ob ^ (((ob >> 9) & 1) << 5)); }
DI void stage_rc(int b, int& R, int& C) { const int st = b / 1024, sb = b % 1024, swz = sb ^ (((sb >> 9) & 1) << 5); R = (st >> 1) * 16 + swz / 64; C = (st & 1) * 32 + (swz % 64) / 2; }
DI int perm32(int rho) { const int n = rho >> 4, i = rho & 15; return 8 * (i >> 2) + 4 * n + (i & 3); }
struct Unit { int pm, pn; };
struct Gemm { const bf16_t* A; const bf16_t* Bt; int M, N, K; };
struct StaticOrder {
    int nM, nN, nwg, G, c;
    DI void init(int M, int N, int G_, int c_) { nM = M / BM; nN = N / BM; nwg = nM * nN; G = G_; c = c_; }
    DI bool next(int i, Unit& u) const {
        const long L = (long)i * G + c; if (L >= nwg) return false;
        int wgid = (int)L; { const int q = nwg / NXCD, r = nwg % NXCD, xcd = wgid % NXCD, off = wgid / NXCD; wgid = (xcd < r ? xcd * (q + 1) : r * (q + 1) + (xcd - r) * q) + off; }
        const int nig = WGM * nN, gid = wgid / nig, fm = gid * WGM, gsz = (nM - fm) < WGM ? (nM - fm) : WGM;
        u.pm = fm + ((wgid % nig) % gsz); u.pn = (wgid % nig) / gsz; return true;
    }
};

template <class Epi>
DI void gemm_phase(LAS unsigned char* lds, const Gemm g, const StaticOrder& S, const Epi& E, const int tid) {
    const int wid = __builtin_amdgcn_readfirstlane(tid >> 6), lane = tid & 63, wr = wid >> 2, wc = wid & 3, fr = lane & 15, fq = lane >> 4;
    const int K = g.K, nt = K / BK;
    unsigned voffA[2], voffB[2];
#pragma unroll
    for (int i = 0; i < 2; ++i) { int R, C; stage_rc(tid * 16 + i * 8192, R, C); const int Rb = Epi::PERM ? ((R & ~31) + perm32(R & 31)) : R;
        voffA[i] = (unsigned)(R * K + C) * 2u; voffB[i] = (unsigned)(Rb * K + C) * 2u; }
    const size_t kstep = (size_t)(BK * 2);
    const size_t hstep = (size_t)HALF * K * 2;
    const size_t tstep = 2 * hstep;
    const unsigned ldsw = (unsigned)wid * 1024u;
    const int aoff = lds_byte(wr * 64 + fr, fq * 8), boff = lds_byte(wc * 32 + fr, fq * 8);
#define PG8_SA(b, h) (((b) * 2 + (h)) * HTB)
#define PG8_SB(b, h) ((4 + (b) * 2 + (h)) * HTB)
#define PG8_STAGE(bufoff, gbase, voff) do { _Pragma("unroll") for (int _i = 0; _i < 2; ++_i) \
        __builtin_amdgcn_global_load_lds((const unsigned*)((const char*)(gbase) + (voff)[_i]), (LAS unsigned*)(lds + (bufoff) + ldsw + _i * 8192), 16, 0, 0); } while (0)
#define PG8_LDA(dst, b, h) do { _Pragma("unroll") for (int m = 0; m < 4; ++m) _Pragma("unroll") for (int k = 0; k < 2; ++k) dst[m][k] = *(const LAS bf16x8*)(lds + PG8_SA(b, h) + aoff + m * 2048 + k * 1024); } while (0)
#define PG8_LDB(dst, b, h) do { _Pragma("unroll") for (int n = 0; n < 2; ++n) _Pragma("unroll") for (int k = 0; k < 2; ++k) dst[n][k] = *(const LAS bf16x8*)(lds + PG8_SB(b, h) + boff + n * 2048 + k * 1024); } while (0)
#define PG8_MMA(ai, bj, At, Bt) do { __builtin_amdgcn_s_setprio(1); _Pragma("unroll") for (int m = 0; m < 4; ++m) _Pragma("unroll") for (int n = 0; n < 2; ++n) _Pragma("unroll") for (int k = 0; k < 2; ++k) \
        acc[ai][bj][m][n] = __builtin_amdgcn_mfma_f32_16x16x32_bf16(Bt[n][k], At[m][k], acc[ai][bj][m][n], 0, 0, 0); __builtin_amdgcn_s_setprio(0); } while (0)
#define PG8_WAIT_V(n) asm volatile("s_waitcnt vmcnt(" #n ")" ::: "memory")
#define PG8_WAIT_L(n) asm volatile("s_waitcnt lgkmcnt(" #n ")" ::: "memory")
#define PG8_BAR __builtin_amdgcn_s_barrier()
#define PG8_SCHED __builtin_amdgcn_sched_barrier(0)
    Unit cur, nxt; int ui = 0;
    if (!S.next(0, cur)) return;
    f32x4 acc[2][2][4][2];
#pragma unroll
    for (int a = 0; a < 2; ++a)
#pragma unroll
        for (int b = 0; b < 2; ++b)
#pragma unroll
            for (int m = 0; m < 4; ++m)
#pragma unroll
                for (int n = 0; n < 2; ++n) acc[a][b][m][n] = (f32x4){0.f, 0.f, 0.f, 0.f};
    bf16x8 At[4][2], B0[2][2], B1[2][2];
    const char* cA = (const char*)g.A + (size_t)cur.pm * tstep; const char* cB = (const char*)g.Bt + (size_t)cur.pn * tstep;
    PG8_STAGE(PG8_SB(0, 0), cB, voffB); PG8_STAGE(PG8_SA(0, 0), cA, voffA); PG8_STAGE(PG8_SB(0, 1), cB + hstep, voffB); PG8_STAGE(PG8_SA(0, 1), cA + hstep, voffA);
    if (wr == 1) PG8_BAR;
    PG8_WAIT_V(4); PG8_BAR;
    PG8_STAGE(PG8_SB(1, 0), cB + kstep, voffB); PG8_STAGE(PG8_SA(1, 0), cA + kstep, voffA); PG8_STAGE(PG8_SB(1, 1), cB + hstep + kstep, voffB);
    PG8_WAIT_V(6); PG8_BAR;
    for (;;) {
        const bool has_next = S.next(ui + 1, nxt);
        const char* nA = has_next ? (const char*)g.A + (size_t)nxt.pm * tstep : cA; const char* nB = has_next ? (const char*)g.Bt + (size_t)nxt.pn * tstep : cB;
        for (int t = 0; t < nt; t += 2) {
            const bool last = (t == nt - 2);
            const char* a1 = cA + (size_t)(t + 1) * kstep;
            const char* a2 = last ? nA : cA + (size_t)(t + 2) * kstep; const char* b2 = last ? nB : cB + (size_t)(t + 2) * kstep;
            const char* a3 = a2 + kstep; const char* b3 = b2 + kstep;
            PG8_LDB(B0, 0, 0); PG8_SCHED; PG8_LDA(At, 0, 0); PG8_STAGE(PG8_SA(1, 1), a1 + hstep, voffA);
            PG8_WAIT_L(8); PG8_BAR; PG8_WAIT_L(0); PG8_MMA(0, 0, At, B0); PG8_BAR; PG8_SCHED;
            PG8_LDB(B1, 0, 1); PG8_STAGE(PG8_SB(0, 0), b2, voffB);
            PG8_BAR; PG8_WAIT_L(0); PG8_MMA(0, 1, At, B1); PG8_BAR;
            PG8_LDA(At, 0, 1); PG8_STAGE(PG8_SA(0, 0), a2, voffA);
            PG8_BAR; PG8_WAIT_L(0); PG8_MMA(1, 0, At, B0); PG8_BAR; PG8_SCHED;
            PG8_STAGE(PG8_SB(0, 1), b2 + hstep, voffB);
            PG8_WAIT_V(6); PG8_BAR; PG8_MMA(1, 1, At, B1); PG8_BAR;
            PG8_LDB(B0, 1, 0); PG8_SCHED; PG8_LDA(At, 1, 0); PG8_STAGE(PG8_SA(0, 1), a2 + hstep, voffA);
            PG8_WAIT_L(8); PG8_BAR; PG8_WAIT_L(0); PG8_MMA(0, 0, At, B0); PG8_BAR; PG8_SCHED;
            PG8_LDB(B1, 1, 1); PG8_STAGE(PG8_SB(1, 0), b3, voffB);
            PG8_BAR; PG8_WAIT_L(0); PG8_MMA(0, 1, At, B1); PG8_BAR;
            PG8_LDA(At, 1, 1); PG8_STAGE(PG8_SA(1, 0), a3, voffA);
            PG8_BAR; PG8_WAIT_L(0); PG8_MMA(1, 0, At, B0); PG8_BAR; PG8_SCHED;
            PG8_STAGE(PG8_SB(1, 1), b3 + hstep, voffB);
            PG8_WAIT_V(6); PG8_BAR; PG8_MMA(1, 1, At, B1); PG8_BAR;
        }
        E(acc, cur, wr, wc, fr, fq);
        if (!has_next) break;
#pragma unroll
        for (int a = 0; a < 2; ++a)
#pragma unroll
            for (int b = 0; b < 2; ++b)
#pragma unroll
                for (int m = 0; m < 4; ++m)
#pragma unroll
                    for (int n = 0; n < 2; ++n) acc[a][b][m][n] = (f32x4){0.f, 0.f, 0.f, 0.f};
        cur = nxt; cA = nA; cB = nB; ++ui;
    }
    PG8_WAIT_V(0);
    if (wr == 0) PG8_BAR;
    PG8_BAR;
#undef PG8_SA
#undef PG8_SB
#undef PG8_STAGE
#undef PG8_LDA
#undef PG8_LDB
#undef PG8_MMA
#undef PG8_WAIT_V
#undef PG8_WAIT_L
#undef PG8_BAR
#undef PG8_SCHED
}

typedef const f32x4 (&AccT)[2][2][4][2];

template <int MODE> struct EpiBf16 {
    static constexpr bool PERM = true;
    bf16_t* O; int ldc; const float* ss; bf16_t* halo; float* ssh; bool kfrag;
    DI void operator()(AccT acc, const Unit& u, int wr, int wc, int fr, int fq) const {
        const int row0 = u.pm * BM + wr * 64 + fr, col0 = u.pn * BM + wc * 32 + 8 * fq;
        float rs[8];
#pragma unroll
        for (int i = 0; i < 8; ++i) rs[i] = (MODE == 1) ? 1.0f : ss_rstd(ss, row0 + (i >> 2) * HALF + (i & 3) * 16);
#pragma unroll
        for (int ai = 0; ai < 2; ++ai)
#pragma unroll
            for (int m = 0; m < 4; ++m) {
                const int row = row0 + ai * HALF + m * 16;
                const float r = rs[ai * 4 + m];
#pragma unroll
                for (int bj = 0; bj < 2; ++bj) {
                    const f32x4 v0 = acc[ai][bj][m][0] * r, v1 = acc[ai][bj][m][1] * r;
                    u32x4 w; w.x = cvt_pk_bf16(v0[0], v0[1]); w.y = cvt_pk_bf16(v0[2], v0[3]); w.z = cvt_pk_bf16(v1[0], v1[1]); w.w = cvt_pk_bf16(v1[2], v1[3]);
                    const int col = col0 + bj * HALF;
                    if (MODE == 2 && kfrag) { const int d0 = col & 127;
                        *(u32x4*)(O + ((size_t)((((row >> 12) * NH + (col >> 7)) * (SEQ / 32) + ((row & (SEQ - 1)) >> 5)) * 8 + (d0 >> 4)) * 512) + (((d0 >> 3) & 1) * 32 + (row & 31)) * 8) = w; }
                    else *(u32x4*)(O + (size_t)row * ldc + col) = w;
                    if (MODE == 0) { if ((row & 63) >= 61 && col < 3072) *(u32x4*)(halo + ((size_t)(row >> 6) * 3 + ((row & 63) - 61)) * 3072 + col) = w; }
                    if (MODE == 2) {
                        float sq = (v0[0] * v0[0] + v0[1] * v0[1]) + (v0[2] * v0[2] + v0[3] * v0[3]) + (v1[0] * v1[0] + v1[1] * v1[1]) + (v1[2] * v1[2] + v1[3] * v1[3]);
                        sq += __shfl_xor(sq, 16); sq += __shfl_xor(sq, 32);
                        if (fq == 0) atomicAdd((unsigned*)ssh + (size_t)((row >> 12) * NH + (2 * u.pn + bj)) * SEQ + (row & (SEQ - 1)), (unsigned)(sq * SH_SCALE + 0.5f));
                    }
                }
            }
    }
};
struct EpiVT {
    static constexpr bool PERM = true;
    bf16_t* O; const float* ss;
    DI void operator()(AccT acc, const Unit& u, int wr, int wc, int fr, int fq) const {
        const int row0 = u.pm * BM + wr * 64 + fr, col0 = u.pn * BM + wc * 32 + 8 * fq;
        f32x4 rs[2][2];
#pragma unroll
        for (int bj = 0; bj < 2; ++bj)
#pragma unroll
            for (int n = 0; n < 2; ++n) { const u32x4 s4 = *(const u32x4*)(ss + col0 + bj * HALF + 4 * n);
#pragma unroll
                for (int j = 0; j < 4; ++j) rs[bj][n][j] = rsqrtf((float)s4[j] * (SS_INV / D) + EPS); }
#pragma unroll
        for (int ai = 0; ai < 2; ++ai)
#pragma unroll
            for (int m = 0; m < 4; ++m) {
                const int row = row0 + ai * HALF + m * 16;
#pragma unroll
                for (int bj = 0; bj < 2; ++bj) {
                    const f32x4 v0 = acc[ai][bj][m][0] * rs[bj][0], v1 = acc[ai][bj][m][1] * rs[bj][1];
                    u32x4 w; w.x = cvt_pk_bf16(v0[0], v0[1]); w.y = cvt_pk_bf16(v0[2], v0[3]); w.z = cvt_pk_bf16(v1[0], v1[1]); w.w = cvt_pk_bf16(v1[2], v1[3]);
                    const int tok = col0 + bj * HALF, sl_ = tok & 31;
                    bf16_t* vb_ = O + ((size_t)(((((tok >> 12) * NH + (row >> 7)) * (SEQ / 32) + ((tok & (SEQ - 1)) >> 5)) * 4 + ((row & 127) >> 5)) * 2 + ((sl_ >> 4) & 1)) * 512) + (row & 31) * 8 + ((sl_ >> 3) & 1) * 4;
                    *(u32x2*)(vb_) = (u32x2){w.x, w.y}; *(u32x2*)(vb_ + 256) = (u32x2){w.z, w.w};
                }
            }
    }
};
struct EpiSwiglu {
    static constexpr bool PERM = true;
    bf16_t* O; const float* ss; bool dry;
    DI void operator()(AccT acc, const Unit& u, int wr, int wc, int fr, int fq) const {
        if (dry) return;
        const int row0 = u.pm * BM + wr * 64 + fr, col0 = u.pn * HALF + wc * 32 + 8 * fq;
        float rs[8];
#pragma unroll
        for (int i = 0; i < 8; ++i) rs[i] = ss_rstd(ss, row0 + (i >> 2) * HALF + (i & 3) * 16);
#pragma unroll
        for (int ai = 0; ai < 2; ++ai)
#pragma unroll
            for (int m = 0; m < 4; ++m) {
                const int row = row0 + ai * HALF + m * 16;
                const float r = rs[ai * 4 + m];
                float o[8];
#pragma unroll
                for (int n = 0; n < 2; ++n)
#pragma unroll
                    for (int j = 0; j < 4; ++j) { const float gt = acc[ai][0][m][n][j] * r, up = acc[ai][1][m][n][j] * r; o[n * 4 + j] = siluf_(gt) * up; }
                u32x4 w; w.x = cvt_pk_bf16(o[0], o[1]); w.y = cvt_pk_bf16(o[2], o[3]); w.z = cvt_pk_bf16(o[4], o[5]); w.w = cvt_pk_bf16(o[6], o[7]);
                *(u32x4*)(O + (size_t)row * FF + col0) = w;
            }
    }
};
template <bool GATE> struct EpiRes {
    static constexpr bool PERM = false;
    float* h; bf16_t* hb; float* ss_out; const float* ss_in; const bf16_t* pp; const float* hin;
    DI void operator()(AccT acc, const Unit& u, int wr, int wc, int fr, int fq) const {
        const int row0 = u.pm * BM + wr * 64 + fr, col0 = u.pn * BM + wc * 32 + 4 * fq;
        float rs[8];
#pragma unroll
        for (int i = 0; i < 8; ++i) rs[i] = GATE ? ss_rstd(ss_in, row0 + (i >> 2) * HALF + (i & 3) * 16) : 1.0f;
        f32x4 hv[2][4]; u32x2 pv[2][4];
#define ER_LOAD(i_, b_) do { const size_t o_ = (size_t)(row0 + ((i_) >> 2) * HALF + ((i_) & 3) * 16) * D + col0; \
            _Pragma("unroll") for (int q = 0; q < 4; ++q) { hv[b_][q] = *(const f32x4*)(hin + o_ + (q >> 1) * HALF + (q & 1) * 16); \
                if (GATE) pv[b_][q] = *(const u32x2*)(pp + o_ + (q >> 1) * HALF + (q & 1) * 16); } } while (0)
        ER_LOAD(0, 0);
#pragma unroll
        for (int i = 0; i < 8; ++i) {
            const int ai = i >> 2, m = i & 3, bsel = i & 1;
            if (i + 1 < 8) { if (bsel) ER_LOAD(i + 1, 0); else ER_LOAD(i + 1, 1); }
            const int row = row0 + ai * HALF + m * 16; const float r = rs[i];
            float sq = 0.f;
#pragma unroll
            for (int q = 0; q < 4; ++q) {
                const int bj = q >> 1, n = q & 1;
                const size_t off = (size_t)row * D + col0 + bj * HALF + n * 16;
                f32x4 hvv = hv[bsel][q]; f32x4 a = acc[ai][bj][m][n];
                if (GATE) { const u32x2 pw = pv[bsel][q];
                    a[0] = bflo(pw.x) * sigmoidf_(a[0] * r); a[1] = bfhi(pw.x) * sigmoidf_(a[1] * r); a[2] = bflo(pw.y) * sigmoidf_(a[2] * r); a[3] = bfhi(pw.y) * sigmoidf_(a[3] * r); }
                hvv = hvv + a;
                *(f32x4*)(h + off) = hvv;
                u32x2 w; w.x = cvt_pk_bf16(hvv[0], hvv[1]); w.y = cvt_pk_bf16(hvv[2], hvv[3]);
                *(u32x2*)(hb + off) = w;
                sq += (hvv[0] * hvv[0] + hvv[1] * hvv[1]) + (hvv[2] * hvv[2] + hvv[3] * hvv[3]);
            }
            sq += __shfl_xor(sq, 16); sq += __shfl_xor(sq, 32);
            if (fq == 0) ss_add(ss_out, row, sq);
        }
#undef ER_LOAD
    }
};
}

struct Args { const float* in[21]; float* out; unsigned char* ws; int ph_lo, ph_hi, coop, pad; };
enum { I_X = 0, I_P, I_LNMIX, I_LNFFN, I_LNPLE, I_GWIN, I_GCONV, I_GALOG, I_GDT, I_GNORM, I_GWOUT, I_KVNORM, I_WKV, I_KNORM, I_SWQ, I_SQNORM, I_SWOUT, I_FWIN, I_FWOUT, I_PPROJ, I_PGATE };

DI void transpose_item(const float* W, int ldw, int col0, int K, const float* gain, bf16_t* WT, int dst_row0, int k0, int n0, LAS float* scr, int lane) {
    float v[32];
    const float* wp = W + (size_t)(k0 + (lane >> 5)) * ldw + col0 + n0 + (lane & 31);
#pragma unroll
    for (int i = 0; i < 32; ++i) v[i] = wp[(size_t)(2 * i) * ldw];
    const int c = lane & 7;
    f32x4 g0 = (f32x4){1.f, 1.f, 1.f, 1.f}, g1 = g0;
    if (gain) { g0 = *(const f32x4*)(gain + k0 + 8 * c); g1 = *(const f32x4*)(gain + k0 + 8 * c + 4); }
#pragma unroll
    for (int i = 0; i < 32; ++i) scr[(2 * i + (lane >> 5)) * 33 + (lane & 31)] = v[i];
    asm volatile("s_waitcnt lgkmcnt(0)" ::: "memory");
#pragma unroll
    for (int j = 0; j < 4; ++j) { const int n = (lane >> 3) + 8 * j; const LAS float* sp = scr + (8 * c) * 33 + n;
        u32x4 o; o.x = cvt_pk_bf16(sp[0 * 33] * g0[0], sp[1 * 33] * g0[1]); o.y = cvt_pk_bf16(sp[2 * 33] * g0[2], sp[3 * 33] * g0[3]); o.z = cvt_pk_bf16(sp[4 * 33] * g1[0], sp[5 * 33] * g1[1]); o.w = cvt_pk_bf16(sp[6 * 33] * g1[2], sp[7 * 33] * g1[3]);
        *(u32x4*)(WT + (size_t)(dst_row0 + n) * K + k0 + 8 * c) = o; }
    asm volatile("s_waitcnt lgkmcnt(0)" ::: "memory");
}
struct TJob { const float* W; int ldw, col0, K, ncols; const float* gain; bf16_t* WT; int mode; };
DI TJob get_job(int j, const Args& a) {
    TJob t; t.mode = 0; t.gain = nullptr; t.col0 = 0;
    unsigned char* ws = a.ws;
    if (j < 2) { t.W = a.in[I_GWIN] + (size_t)j * D * 4112; t.ldw = 4112; t.K = D; t.ncols = 4096; t.gain = a.in[I_LNMIX] + j * D; t.WT = (bf16_t*)(ws + WS_WIN) + (size_t)j * 4096 * D; return t; } j -= 2;
    if (j < 4) { t.W = a.in[I_FWIN] + (size_t)j * D * 5632; t.ldw = 5632; t.K = D; t.ncols = 5632; t.gain = a.in[I_LNFFN] + j * D; t.WT = (bf16_t*)(ws + WS_W1) + (size_t)j * 5632 * D; t.mode = 1; return t; } j -= 4;
    if (j < 4) { t.W = a.in[I_FWOUT] + (size_t)j * FF * D; t.ldw = D; t.K = FF; t.ncols = D; t.WT = (bf16_t*)(ws + WS_W2) + (size_t)j * D * FF; return t; } j -= 4;
    if (j < 2) { t.W = a.in[I_GWOUT] + (size_t)j * D * D; t.ldw = D; t.K = D; t.ncols = D; t.WT = (bf16_t*)(ws + WS_WO) + (size_t)j * D * D; return t; } j -= 2;
    if (j < 2) { t.W = a.in[I_WKV]; t.ldw = 2048; t.col0 = j * 1024; t.K = D; t.ncols = D; t.gain = a.in[I_KVNORM]; t.WT = (bf16_t*)(ws + (j ? WS_WV : WS_WK)); return t; } j -= 2;
    if (j < 2) { t.W = a.in[I_SWQ] + (size_t)j * D * D; t.ldw = D; t.K = D; t.ncols = D; t.gain = a.in[I_LNMIX] + (2 + j) * D; t.WT = (bf16_t*)(ws + WS_WQ) + (size_t)j * D * D; return t; } j -= 2;
    if (j < 2) { t.W = a.in[I_SWOUT] + (size_t)j * D * D; t.ldw = D; t.K = D; t.ncols = D; t.WT = (bf16_t*)(ws + WS_SWO) + (size_t)j * D * D; return t; } j -= 2;
    if (j < 4) { t.W = a.in[I_PPROJ] + (size_t)j * PLE * D; t.ldw = D; t.K = PLE; t.ncols = D; t.WT = (bf16_t*)(ws + WS_WPROJ) + (size_t)j * D * PLE; return t; } j -= 4;
    t.W = a.in[I_PGATE] + (size_t)j * D * D; t.ldw = D; t.K = D; t.ncols = D; t.gain = a.in[I_LNPLE] + j * D; t.WT = (bf16_t*)(ws + WS_WGATE) + (size_t)j * D * D; return t;
}
constexpr int NJOBS = 26;

struct TItem { const float* wp; const float* gp; bf16_t* wt; int ldw, K, valid; };
DI TItem decode_titem(int g, const Args& a, int lane) {
    TItem r; r.wp = nullptr; r.gp = nullptr; r.wt = nullptr; r.ldw = 0; r.K = 0; r.valid = 0;
    for (int j = 0; j < NJOBS; ++j) {
        const TJob t = get_job(j, a);
        const int nblk = t.ncols / 32, nitems = (t.K / 64) * nblk;
        if (g < nitems) {
            const int kb = g / nblk, nb = g % nblk, n0 = nb * 32, k0 = kb * 64;
            int drow = n0;
            if (t.mode == 1) { drow = (n0 < FF) ? ((n0 / 128) * 256 + (n0 % 128)) : (((n0 - FF) / 128) * 256 + 128 + ((n0 - FF) % 128)); }
            r.wp = t.W + (size_t)(k0 + (lane >> 5)) * t.ldw + t.col0 + n0 + (lane & 31);
            r.gp = t.gain ? t.gain + k0 + 8 * (lane & 7) : nullptr;
            r.wt = t.WT + (size_t)(drow + (lane >> 3)) * t.K + k0 + 8 * (lane & 7);
            r.ldw = t.ldw; r.K = t.K; r.valid = 1; return r;
        }
        g -= nitems;
    }
    return r;
}
constexpr int TR_TOTAL = 2 * 2048 + 4 * 2816 + 4 * 1408 + 2 * 512 + 2 * 512 + 2 * 512 + 2 * 512 + 4 * 128 + 4 * 512;
DI void phase_prep(const Args& a, LAS unsigned char* lds, int gw, int NGW, int wave, int lane) {
    LAS float* scr = (LAS float*)(lds + wave * 16384);
    {
        float v[32]; f32x4 g0 = (f32x4){1.f, 1.f, 1.f, 1.f}, g1 = g0;
        TItem cur = decode_titem(gw, a, lane);
        if (cur.valid) {
#pragma unroll
            for (int i = 0; i < 32; ++i) v[i] = cur.wp[(size_t)(2 * i) * cur.ldw];
            if (cur.gp) { g0 = *(const f32x4*)(cur.gp); g1 = *(const f32x4*)(cur.gp + 4); }
        }
        for (int g = gw; g < TR_TOTAL; g += NGW) {
#pragma unroll
            for (int i = 0; i < 32; ++i) scr[(2 * i + (lane >> 5)) * 33 + (lane & 31)] = v[i];
            const f32x4 h0 = g0, h1 = g1; bf16_t* wt = cur.wt; const int K = cur.K;
            cur = decode_titem(g + NGW, a, lane);
            g0 = (f32x4){1.f, 1.f, 1.f, 1.f}; g1 = g0;
            if (cur.valid) {
#pragma unroll
                for (int i = 0; i < 32; ++i) v[i] = cur.wp[(size_t)(2 * i) * cur.ldw];
                if (cur.gp) { g0 = *(const f32x4*)(cur.gp); g1 = *(const f32x4*)(cur.gp + 4); }
            }
            asm volatile("s_waitcnt lgkmcnt(0)" ::: "memory");
            const int c = lane & 7;
#pragma unroll
            for (int j = 0; j < 4; ++j) { const int n = (lane >> 3) + 8 * j; const LAS float* sp = scr + (8 * c) * 33 + n;
                u32x4 o; o.x = cvt_pk_bf16(sp[0 * 33] * h0[0], sp[1 * 33] * h0[1]); o.y = cvt_pk_bf16(sp[2 * 33] * h0[2], sp[3 * 33] * h0[3]); o.z = cvt_pk_bf16(sp[4 * 33] * h1[0], sp[5 * 33] * h1[1]); o.w = cvt_pk_bf16(sp[6 * 33] * h1[2], sp[7 * 33] * h1[3]);
                *(u32x4*)(wt + (size_t)(8 * j) * K) = o; }
            asm volatile("s_waitcnt lgkmcnt(0)" ::: "memory");
        }
    }
    const int gt = gw * 64 + lane, NGT = NGW * 64;
    for (int i = gt; i < 2 * 16 * D; i += NGT) { const int l = i / (16 * D), n = (i / D) % 16, k = i % D;
        const float v = a.in[I_GWIN][(size_t)l * D * 4112 + (size_t)k * 4112 + 4096 + n] * a.in[I_LNMIX][l * D + k];
        ((bf16_t*)(a.ws + WS_WAB))[i] = (bf16_t)(cvt_pk_bf16(v, 0.f) & 0xffffu); }
    { float* z = (float*)(a.ws + WS_SS) + T; for (int i = gt; i < 12 * T; i += NGT) z[i] = 0.f;
      float* z2 = (float*)(a.ws + WS_SSQ); for (int i = gt; i < (int)((WS_GL - WS_SSQ) / 4); i += NGT) z2[i] = 0.f; }
    float* ss0 = (float*)(a.ws + WS_SS); bf16_t* hb0 = (bf16_t*)(a.ws + WS_HB0);
    for (int m = gw; m < T; m += NGW) {
        const f32x4* xr = (const f32x4*)(a.in[I_X] + (size_t)m * D) + lane; u32x2* hbr = (u32x2*)(hb0 + (size_t)m * D) + lane;
        float s = 0.f;
#pragma unroll
        for (int j = 0; j < 4; ++j) { const f32x4 v = xr[64 * j]; u32x2 w; w.x = cvt_pk_bf16(v[0], v[1]); w.y = cvt_pk_bf16(v[2], v[3]); hbr[64 * j] = w; s += (v[0] * v[0] + v[1] * v[1]) + (v[2] * v[2] + v[3] * v[3]); }
        s = wave_sum(s);
        if (lane == 0) ((unsigned*)ss0)[m] = (unsigned)(s * SS_SCALE + 0.5f);
    }
}

DI void convert_p(const Args& a, int L, int gt, int NGT) {
    const f32x4* src = (const f32x4*)(a.in[I_P] + (size_t)L * T * PLE); u32x4* dst = (u32x4*)(a.ws + WS_PB);
    for (int i = gt; i < T * PLE / 8; i += NGT) { const f32x4 v0 = src[2 * i], v1 = src[2 * i + 1];
        u32x4 w; w.x = cvt_pk_bf16(v0[0], v0[1]); w.y = cvt_pk_bf16(v0[2], v0[3]); w.z = cvt_pk_bf16(v1[0], v1[1]); w.w = cvt_pk_bf16(v1[2], v1[3]); dst[i] = w; }
}

DI void ab_gemm(const bf16_t* hb, const bf16_t* wab, const float* ss, float* AB, int gw, int NGW, int lane) {
    const int fr = lane & 15, fq = lane >> 4;
    for (int tile = gw; tile < T / 16; tile += NGW) {
        f32x4 acc = (f32x4){0.f, 0.f, 0.f, 0.f};
        const bf16_t* ap = hb + (size_t)(tile * 16 + fr) * D + 8 * fq; const bf16_t* bp = wab + (size_t)fr * D + 8 * fq;
#pragma unroll 1
        for (int k8 = 0; k8 < D / 256; ++k8) {
            bf16x8 av[8], bv[8];
#pragma unroll
            for (int j = 0; j < 8; ++j) { av[j] = *(const bf16x8*)(ap + 256 * k8 + 32 * j); bv[j] = *(const bf16x8*)(bp + 256 * k8 + 32 * j); }
            asm volatile("" : "+v"(av[0]), "+v"(av[1]), "+v"(av[2]), "+v"(av[3]), "+v"(av[4]), "+v"(av[5]), "+v"(av[6]), "+v"(av[7]),
                              "+v"(bv[0]), "+v"(bv[1]), "+v"(bv[2]), "+v"(bv[3]), "+v"(bv[4]), "+v"(bv[5]), "+v"(bv[6]), "+v"(bv[7]));
#pragma unroll
            for (int j = 0; j < 8; ++j) acc = __builtin_amdgcn_mfma_f32_16x16x32_bf16(av[j], bv[j], acc, 0, 0, 0);
        }
#pragma unroll
        for (int r = 0; r < 4; ++r) { const int row = tile * 16 + 4 * fq + r; AB[(size_t)row * 16 + fr] = acc[r] * ss_rstd(ss, row); }
    }
}

constexpr int SA_QS = 0, SA_KS = 32768, SA_VS = 65536, SA_STG = 98304, SA_A = SA_STG, SA_KB = SA_A + 16384, SA_QB = SA_KB + 64 * 136 * 2, SA_BETA = SA_STG + 67 * 384 * 2, SA_G = SA_BETA + 256, SA_RQ = SA_G + 256, SA_RK = SA_RQ + 256;
static_assert(SA_QB + 64 * 136 * 2 <= SA_BETA && SA_RK + 256 <= LDS_BYTES - 16, "stage A LDS");

DI void gdn_stage_a(const Args& a, int L, LAS unsigned char* lds, int tid, int wave, int lane, const bool dry) {
    const int l = L;
    bf16_t* proj = (bf16_t*)(a.ws + WS_R1);
    const bf16_t* halo = (const bf16_t*)(a.ws + WS_HALO);
    bf16_t* wbuf = (bf16_t*)(a.ws + ((L & 1) ? WS_HB1 : WS_HB0));
    bf16_t* qkd = (bf16_t*)(a.ws + ((L & 1) ? WS_HB0 : WS_HB1));
    float* GL = (float*)(a.ws + WS_GL);
    const float* AB = (const float*)(a.ws + WS_AB);
    const float* convw = a.in[I_GCONV] + (size_t)l * 4 * 3072;
    LAS float* qs = (LAS float*)(lds + SA_QS); LAS float* ks = (LAS float*)(lds + SA_KS); LAS float* vs = (LAS float*)(lds + SA_VS); LAS float* Am = (LAS float*)(lds + SA_A); LAS bf16_t* stg = (LAS bf16_t*)(lds + SA_STG);
    LAS bf16_t* kb = (LAS bf16_t*)(lds + SA_KB); LAS bf16_t* qb = (LAS bf16_t*)(lds + SA_QB);
    LAS float* sbeta = (LAS float*)(lds + SA_BETA); LAS float* sG = (LAS float*)(lds + SA_G); LAS float* srq = (LAS float*)(lds + SA_RQ); LAS float* srk = (LAS float*)(lds + SA_RK);

    for (int item = blockIdx.x; item < NB * NH * 64; item += gridDim.x) {
        const int n = item & 63, bh = item >> 6, h = bh & 7, b = bh >> 3;
        const int t0 = b * SEQ + n * 64;
        int tidv = tid; asm volatile("" : "+v"(tidv));
        {
            u32x4 rv[7];
#pragma unroll
            for (int i = 0; i < 7; ++i) { const int id = tidv + i * NTHR; rv[i] = (u32x4){0u, 0u, 0u, 0u};
                if (id < 67 * 48) { const int row = id / 48, cc = id % 48, seg = cc >> 4, off = (cc & 15) * 8, rr = row - 3;
                    if (rr >= 0) rv[i] = *(const u32x4*)(proj + (size_t)(t0 + rr) * PLD + seg * 1024 + h * 128 + off);
                    else if (n > 0) rv[i] = *(const u32x4*)(halo + ((size_t)(b * 64 + n - 1) * 3 + row) * 3072 + seg * 1024 + h * 128 + off); } }
#pragma unroll
            for (int i = 0; i < 7; ++i) { const int id = tidv + i * NTHR;
                if (id < 67 * 48) { const int row = id / 48, cc = id % 48; *(LAS u32x4*)(stg + row * 384 + cc * 8) = rv[i]; } }
            if (tidv >= 448) {
                const int r = tidv - 448;
                const float ain = AB[(size_t)(t0 + r) * 16 + h], bin = AB[(size_t)(t0 + r) * 16 + 8 + h];
                float g = -__expf(a.in[I_GALOG][l * NH + h]) * softplusf_(ain + a.in[I_GDT][l * NH + h]);
#pragma unroll
                for (int o = 1; o < 64; o <<= 1) { const float t_ = __shfl_up(g, o); if (r >= o) g += t_; }
                sbeta[r] = sigmoidf_(bin); sG[r] = g;
                if (r == 63) GL[bh * 64 + n] = __expf(g);
            }
        }
        __syncthreads();
#pragma unroll 1
        for (int task = tidv; task < 384 * 4; task += NTHR) {
            const int col = task % 384, r0 = (task / 384) * 16, seg = col >> 7, c = col & 127, ch = seg * 1024 + h * 128 + c;
            const float w0 = convw[ch], w1 = convw[3072 + ch], w2 = convw[2 * 3072 + ch], w3 = convw[3 * 3072 + ch];
            LAS float* dst = (seg == 0 ? qs : seg == 1 ? ks : vs) + c;
            const LAS bf16_t* sp = stg + r0 * 384 + col;
            float x0 = bf2f(sp[0]), x1 = bf2f(sp[384]), x2 = bf2f(sp[2 * 384]);
#pragma unroll
            for (int r = 0; r < 16; ++r) { const float x3 = bf2f(sp[(r + 3) * 384]); dst[(r0 + r) * 128] = siluf_(w0 * x0 + w1 * x1 + w2 * x2 + w3 * x3); x0 = x1; x1 = x2; x2 = x3; }
        }
        __syncthreads();
        { const int r = tidv >> 3, l8 = tidv & 7; float sq = 0.f, sk = 0.f;
#pragma unroll
            for (int j = 0; j < 4; ++j) { const f32x4 qv = *(LAS f32x4*)(qs + r * 128 + 32 * j + 4 * l8), kv = *(LAS f32x4*)(ks + r * 128 + 32 * j + 4 * l8);
                sq += (qv[0] * qv[0] + qv[1] * qv[1]) + (qv[2] * qv[2] + qv[3] * qv[3]); sk += (kv[0] * kv[0] + kv[1] * kv[1]) + (kv[2] * kv[2] + kv[3] * kv[3]); }
            sq += __shfl_xor(sq, 1); sk += __shfl_xor(sk, 1); sq += __shfl_xor(sq, 2); sk += __shfl_xor(sk, 2); sq += __shfl_xor(sq, 4); sk += __shfl_xor(sk, 4);
            if (l8 == 0) { srq[r] = rsqrtf(sq + EPS) * 0.08838834764831845f; srk[r] = rsqrtf(sk + EPS); } }
        __syncthreads();
#pragma unroll 1
        for (int i = tidv; i < 64 * 32; i += NTHR) { const int r = i >> 5, c4 = (i & 31) * 4;
            f32x4 qv = *(LAS f32x4*)(qs + r * 128 + c4) * srq[r], kv = *(LAS f32x4*)(ks + r * 128 + c4) * srk[r];
            *(LAS f32x4*)(qs + r * 128 + c4) = qv; *(LAS f32x4*)(ks + r * 128 + c4) = kv;
            u32x2 wq, wk; wq.x = cvt_pk_bf16(qv[0], qv[1]); wq.y = cvt_pk_bf16(qv[2], qv[3]); wk.x = cvt_pk_bf16(kv[0], kv[1]); wk.y = cvt_pk_bf16(kv[2], kv[3]);
            *(LAS u32x2*)(qb + r * 136 + c4) = wq; *(LAS u32x2*)(kb + r * 136 + c4) = wk; }
        __syncthreads();
        {
            const int fr = lane & 15, fq = lane >> 4;
#pragma unroll
            for (int tt = 0; tt < 2; ++tt) { const int tile = wave * 2 + tt, rt = tile >> 2, ct = tile & 3;
                f32x4 acc = (f32x4){0.f, 0.f, 0.f, 0.f};
#pragma unroll
                for (int kk = 0; kk < 4; ++kk) { const bf16x8 av = *(LAS bf16x8*)(kb + (16 * rt + fr) * 136 + 32 * kk + 8 * fq), bv = *(LAS bf16x8*)(kb + (16 * ct + fr) * 136 + 32 * kk + 8 * fq);
                    acc = __builtin_amdgcn_mfma_f32_16x16x32_bf16(av, bv, acc, 0, 0, 0); }
                const int s = 16 * ct + fr; const float Gs = sG[s];
#pragma unroll
                for (int rg = 0; rg < 4; ++rg) { const int r = 16 * rt + 4 * fq + rg; const float v = (s < r) ? sbeta[r] * acc[rg] * __expf(sG[r] - Gs) : 0.f; Am[r * 64 + s] = v; } }
        }
        __syncthreads();
        if (tid < 256) {
            int lz; asm volatile("v_mov_b32 %0, 0" : "=v"(lz));
            LAS float* sbeta_v = sbeta + lz; LAS float* sG_v = sG + lz; LAS float* Am_v = Am + lz;
            float X[64];
            if (tid < 128) {
#pragma unroll
                for (int r = 0; r < 64; ++r) X[r] = vs[r * 128 + tid] * sbeta_v[r];
            } else {
#pragma unroll
                for (int r = 0; r < 64; ++r) X[r] = ks[r * 128 + (tid - 128)] * sbeta_v[r] * __expf(sG_v[r]);
            }
#pragma unroll
            for (int r = 1; r < 64; ++r) {
                float a0 = 0.f, a1 = 0.f, a2 = 0.f, a3 = 0.f;
#pragma unroll
                for (int s4 = 0; s4 < (r + 3) / 4; ++s4) { const f32x4 av = *(LAS f32x4*)(Am_v + r * 64 + 4 * s4);
                    a0 += av[0] * X[4 * s4]; a1 += av[1] * X[4 * s4 + 1]; a2 += av[2] * X[4 * s4 + 2]; a3 += av[3] * X[4 * s4 + 3]; }
                X[r] -= (a0 + a1) + (a2 + a3);
            }
            if (tid < 128) {
                bf16_t* vs_ = proj + (size_t)t0 * PLD + 2048 + h * 128 + (size_t)((tid >> 4) * 8) * PLD + (tid & 15) * 4;
#pragma unroll
                for (int rp = 0; rp < 8; ++rp) {
#pragma unroll
                    for (int hf = 0; hf < 2; ++hf) { const int c0 = 16 * (rp >> 1) + 4 * (2 * (rp & 1) + hf); u32x2 w; w.x = cvt_pk_bf16(X[c0], X[c0 + 1]); w.y = cvt_pk_bf16(X[c0 + 2], X[c0 + 3]);
                        if (!dry) *(u32x2*)(vs_ + hf * 64) = w; }
                    vs_ += PLD; asm volatile("" : "+v"(vs_)); }
            } else {
                const int c_ = tid - 128;
                bf16_t* wp = wbuf + (size_t)t0 * D + h * 128 + (size_t)((c_ >> 5) * 4 + ((c_ >> 3) & 3)) * D + (c_ & 7);
#pragma unroll
                for (int rt_ = 0; rt_ < 4; ++rt_) {
#pragma unroll
                    for (int fr_ = 0; fr_ < 16; ++fr_) wp[fr_ * 8] = (bf16_t)(cvt_pk_bf16(X[16 * rt_ + fr_], 0.f) & 0xffffu);
                    wp += 16 * D; asm volatile("" : "+v"(wp)); }
            }
        } else {
            const int w4 = wave - 4, fr = lane & 15, fq = lane >> 4, tt = tid - 256;
            bf16_t* qk_o = qkd + (size_t)item * 4096;
#pragma unroll
            for (int ct = 0; ct < 4; ++ct) {
                f32x4 acc = (f32x4){0.f, 0.f, 0.f, 0.f};
#pragma unroll
                for (int kk = 0; kk < 4; ++kk) { const bf16x8 av = *(LAS bf16x8*)(qb + (16 * w4 + fr) * 136 + 32 * kk + 8 * fq), bv = *(LAS bf16x8*)(kb + (16 * ct + fr) * 136 + 32 * kk + 8 * fq);
                    acc = __builtin_amdgcn_mfma_f32_16x16x32_bf16(av, bv, acc, 0, 0, 0); }
                const int s = 16 * ct + fr; const float Gs = sG[s];
#pragma unroll
                for (int rg = 0; rg < 4; ++rg) { const int r = 16 * w4 + 4 * fq + rg; const float v = (s <= r) ? acc[rg] * __expf(sG[r] - Gs) : 0.f;
                    qk_o[((r >> 4) * 2 + (s >> 5)) * 512 + (((s >> 3) & 3) * 16 + (r & 15)) * 8 + (s & 7)] = (bf16_t)(cvt_pk_bf16(v, 0.f) & 0xffffu); }
            }
#pragma unroll 1
            for (int i = tt; i < 64 * 16; i += 256) { const int blk_ = i >> 6, ln_ = i & 63, r = 16 * (blk_ >> 2) + (ln_ & 15), c8 = 32 * (blk_ & 3) + 8 * (ln_ >> 4); const float e = __expf(sG[r]);
                const f32x4 v0 = *(LAS f32x4*)(qs + r * 128 + c8) * e, v1 = *(LAS f32x4*)(qs + r * 128 + c8 + 4) * e;
                u32x4 w; w.x = cvt_pk_bf16(v0[0], v0[1]); w.y = cvt_pk_bf16(v0[2], v0[3]); w.z = cvt_pk_bf16(v1[0], v1[1]); w.w = cvt_pk_bf16(v1[2], v1[3]);
                if (!dry) *(u32x4*)(proj + (size_t)t0 * PLD + h * 128 + (size_t)((((r >> 4) * 4 + (c8 >> 5)) * 4) + ((c8 >> 3) & 3)) * PLD + (r & 15) * 8) = w; }
            const float Glast = sG[63];
#pragma unroll 1
            for (int i = tt; i < 128 * 8; i += 256) { const int blk_ = i >> 6, ln_ = i & 63, dk = 16 * (blk_ >> 1) + (ln_ & 15), c8 = 32 * (blk_ & 1) + 8 * (ln_ >> 4); float v[8];
#pragma unroll
                for (int j = 0; j < 8; ++j) v[j] = ks[(c8 + j) * 128 + dk] * __expf(Glast - sG[c8 + j]);
                u32x4 w; w.x = cvt_pk_bf16(v[0], v[1]); w.y = cvt_pk_bf16(v[2], v[3]); w.z = cvt_pk_bf16(v[4], v[5]); w.w = cvt_pk_bf16(v[6], v[7]);
                if (!dry) *(u32x4*)(proj + (size_t)t0 * PLD + 1024 + h * 128 + (size_t)((((dk >> 4) * 2 + (c8 >> 5)) * 4) + ((c8 >> 3) & 3)) * PLD + (dk & 15) * 8) = w; }
        }
        __syncthreads();
    }
}

constexpr int SB_ST = 0, SB_VT = 16 * 136 * 2;
DI void gdn_stage_b(const Args& a, int L, LAS unsigned char* lds, int wave, int lane) {
    const bf16_t* proj = (const bf16_t*)(a.ws + WS_R1);
    const bf16_t* wbuf = (const bf16_t*)(a.ws + ((L & 1) ? WS_HB1 : WS_HB0));
    const bf16_t* qkd = (const bf16_t*)(a.ws + ((L & 1) ? WS_HB0 : WS_HB1));
    const float* GL = (const float*)(a.ws + WS_GL);
    bf16_t* og = (bf16_t*)(a.ws + WS_OG);
    LAS bf16_t* sT = (LAS bf16_t*)(lds + SB_ST); LAS bf16_t* vT = (LAS bf16_t*)(lds + SB_VT);
    const int fr = lane & 15, fq = lane >> 4, rt = wave & 3;
    for (int item = blockIdx.x; item < NB * NH * 8; item += gridDim.x) {
        const int xcd_ = item & 7, idx_ = item >> 3;
        const int sl = idx_ & 7, bh = xcd_ * 4 + (idx_ >> 3), h = bh & 7, b = bh >> 3, dv0 = sl * 16;
        f32x4 Sacc = (f32x4){0.f, 0.f, 0.f, 0.f};
        __syncthreads();
        { unsigned zz; asm volatile("v_mov_b32 %0, 0" : "=v"(zz)); u32x2 z2; z2.x = zz; z2.y = zz; *(LAS u32x2*)(sT + fr * 136 + 16 * wave + 4 * fq) = z2; }
        __syncthreads();
        const size_t strideA = (wave < 4) ? (size_t)128 * D * 2 : (size_t)128 * PLD * 2, strideX = (wave < 4) ? (size_t)128 * PLD * 2 : (size_t)2 * 8192, stepA = strideA / 2, stepX = strideX / 2;
        const size_t kstepA = (wave < 4) ? (size_t)4 * D * 2 : (size_t)4 * PLD * 2;
        GCP pa0 = (wave < 4) ? (GCP)wbuf + ((size_t)(b * SEQ + 16 * rt + fq) * D + h * 128 + 8 * fr) * 2 : (GCP)proj + ((size_t)(b * SEQ + 16 * rt + fq) * PLD + h * 128 + 8 * fr) * 2;
        GCP pk0 = (GCP)proj + ((size_t)(b * SEQ) * PLD + 1024 + h * 128 + (size_t)(8 * wave + fq) * PLD + 8 * fr) * 2;
        GCP px0 = (wave < 4) ? (GCP)proj + ((size_t)(b * SEQ) * PLD + 2048 + h * 128 + (size_t)((sl * 4 + rt) * 2 + (lane >> 5)) * PLD + (lane & 31) * 4) * 2
                                     : (GCP)qkd + ((size_t)(bh * 64) * 4096 + rt * 1024 + lane * 8) * 2;
        const size_t kstepX = (wave < 4) ? (size_t)16 : (size_t)1024;
        GCP paA = pa0, paB = pa0 + stepA, paC = pa0 + 2 * stepA, paD = pa0 + 3 * stepA;
        GCP pkA = pk0, pkB = pk0 + (size_t)64 * PLD * 2, pkC = pk0 + 2 * 524288, pkD = pk0 + 3 * 524288;
        GCP pxA = px0, pxB = px0 + stepX, pxC = px0 + 2 * stepX, pxD = px0 + 3 * stepX;
#define SB_LOAD(n_, PA, PK, PX, AF, UW, QF, KF, GLV) do { \
            _Pragma("unroll") for (int kk = 0; kk < 4; ++kk) AF[kk] = *(GAS const bf16x8*)(PA + kk * kstepA); \
            KF[0] = *(GAS const bf16x8*)(PK); KF[1] = *(GAS const bf16x8*)(PK + (size_t)4 * PLD * 2); \
            QF[0] = *(GAS const bf16x8*)(PX); QF[1] = *(GAS const bf16x8*)(PX + kstepX);     \
            GLV = GL[bh * 64 + (n_)]; \
            PA += strideA; PK += (size_t)128 * PLD * 2; PX += strideX; asm volatile("" : "+v"(PA), "+v"(PK), "+v"(PX)); } while (0)
#define SB_BODY(n_, AF, UW, QF, KF, GLV) do { const int t0_ = b * SEQ + (n_) * 64; \
            f32x4 acc = (f32x4){0.f, 0.f, 0.f, 0.f}; \
            _Pragma("unroll") for (int kk = 0; kk < 4; ++kk) { const bf16x8 bv = *(LAS bf16x8*)(sT + fr * 136 + 32 * kk + 8 * fq); acc = __builtin_amdgcn_mfma_f32_16x16x32_bf16(AF[kk], bv, acc, 0, 0, 0); } \
            if (wave < 4) { \
                const u32x4 uq_ = __builtin_bit_cast(u32x4, QF[0]); f32x4 vn; vn[0] = bflo(uq_.x) - acc[0]; vn[1] = bfhi(uq_.x) - acc[1]; vn[2] = bflo(uq_.y) - acc[2]; vn[3] = bfhi(uq_.y) - acc[3]; \
                u32x2 w_; w_.x = cvt_pk_bf16(vn[0], vn[1]); w_.y = cvt_pk_bf16(vn[2], vn[3]); \
                *(LAS u32x2*)(vT + fr * 72 + 16 * rt + 4 * fq) = w_; } \
            __syncthreads(); \
            const bf16x8 vb0 = *(LAS bf16x8*)(vT + fr * 72 + 8 * fq), vb1 = *(LAS bf16x8*)(vT + fr * 72 + 32 + 8 * fq); \
            if (wave >= 4) { \
                acc = __builtin_amdgcn_mfma_f32_16x16x32_bf16(QF[0], vb0, acc, 0, 0, 0); \
                acc = __builtin_amdgcn_mfma_f32_16x16x32_bf16(QF[1], vb1, acc, 0, 0, 0); \
                bf16_t* op = og + (size_t)(t0_ + 16 * rt + 4 * fq) * D + h * 128 + dv0 + fr; \
                _Pragma("unroll") for (int rg = 0; rg < 4; ++rg) op[(size_t)rg * D] = (bf16_t)(cvt_pk_bf16(acc[rg], 0.f) & 0xffffu); } \
            Sacc = Sacc * GLV; \
            Sacc = __builtin_amdgcn_mfma_f32_16x16x32_bf16(KF[0], vb0, Sacc, 0, 0, 0); \
            Sacc = __builtin_amdgcn_mfma_f32_16x16x32_bf16(KF[1], vb1, Sacc, 0, 0, 0); \
            { u32x2 w_; w_.x = cvt_pk_bf16(Sacc[0], Sacc[1]); w_.y = cvt_pk_bf16(Sacc[2], Sacc[3]); *(LAS u32x2*)(sT + fr * 136 + 16 * wave + 4 * fq) = w_; } \
            __syncthreads(); } while (0)
        bf16x8 afA[4], afB[4], qfA[2], qfB[2], kfA[2], kfB[2]; u32x2 uwA = (u32x2){0u, 0u}, uwB = uwA; float glA, glB;
        (void)uwA; (void)uwB; (void)paC; (void)paD; (void)pkC; (void)pkD; (void)pxC; (void)pxD;
        SB_LOAD(0, paA, pkA, pxA, afA, uwA, qfA, kfA, glA);
        for (int n = 0; n < 64; n += 2) {
            SB_LOAD(n + 1, paB, pkB, pxB, afB, uwB, qfB, kfB, glB);
            SB_BODY(n, afA, uwA, qfA, kfA, glA);
            if (n + 2 < 64) SB_LOAD(n + 2, paA, pkA, pxA, afA, uwA, qfA, kfA, glA);
            SB_BODY(n + 1, afB, uwB, qfB, kfB, glB);
        }
#undef SB_LOAD
#undef SB_BODY
    }
}

DI void gdn_stage_c(const Args& a, int L, int gw, int NGW, int lane) {
    bf16_t* og = (bf16_t*)(a.ws + WS_OG); const bf16_t* proj = (const bf16_t*)(a.ws + WS_R1);
    const float* ng = a.in[I_GNORM] + L * HD + (lane & 7) * 16;
    float gn[16];
#pragma unroll
    for (int j = 0; j < 16; ++j) gn[j] = ng[j];
    for (int m = gw; m < T; m += NGW) {
        u32x4* op = (u32x4*)(og + (size_t)m * D + lane * 16); const u32x4* gp = (const u32x4*)(proj + (size_t)m * PLD + 3072 + lane * 16);
        const u32x4 o0 = op[0], o1 = op[1], g0 = gp[0], g1 = gp[1];
        float o[16], g[16];
#pragma unroll
        for (int j = 0; j < 4; ++j) { o[2 * j] = bflo(o0[j]); o[2 * j + 1] = bfhi(o0[j]); o[8 + 2 * j] = bflo(o1[j]); o[8 + 2 * j + 1] = bfhi(o1[j]);
            g[2 * j] = bflo(g0[j]); g[2 * j + 1] = bfhi(g0[j]); g[8 + 2 * j] = bflo(g1[j]); g[8 + 2 * j + 1] = bfhi(g1[j]); }
        float s = 0.f;
#pragma unroll
        for (int j = 0; j < 16; ++j) s += o[j] * o[j];
        s += __shfl_xor(s, 1); s += __shfl_xor(s, 2); s += __shfl_xor(s, 4);
        const float r = rsqrtf(s * (1.0f / HD) + EPS);
        float y[16];
#pragma unroll
        for (int j = 0; j < 16; ++j) y[j] = o[j] * r * gn[j] * siluf_(g[j]);
        u32x4 w0, w1;
#pragma unroll
        for (int j = 0; j < 4; ++j) { w0[j] = cvt_pk_bf16(y[2 * j], y[2 * j + 1]); w1[j] = cvt_pk_bf16(y[8 + 2 * j], y[8 + 2 * j + 1]); }
        op[0] = w0; op[1] = w1;
    }
}

DI void sb_attention(const Args& a, int j2, int gw, int NGW, int lane) {
    const bf16_t* qo = (const bf16_t*)(a.ws + WS_OG); bf16_t* ob = (bf16_t*)(a.ws + WS_R1); const bf16_t* kbuf = (const bf16_t*)(a.ws + WS_KB); const bf16_t* vt = (const bf16_t*)(a.ws + WS_VT);
    const float* ssq = (const float*)(a.ws + WS_SSQ) + (size_t)j2 * NB * NH * SEQ; const float* ssk = (const float*)(a.ws + WS_SSK);
    const float* qn = a.in[I_SQNORM] + j2 * HD; const float* kn = a.in[I_KNORM];
    const int tl = lane & 31, hh = lane >> 5;
    for (int item = gw; item < NB * NH * (SEQ / 32); item += NGW) {
        const int qt = (SEQ / 32 - 1) - (item & 127), bh = item >> 7, h = bh & 7, b = bh >> 3, t0 = qt * 32;
        const size_t qrow = (size_t)(b * SEQ + t0 + tl) * D + h * 128;
        bf16x8 qf[8];
        {
            const float rq = rsqrtf((float)((const unsigned*)ssq)[(size_t)bh * SEQ + t0 + tl] * (SH_INV / HD) + EPS) * 0.08838834764831845f;
#pragma unroll
            for (int ks = 0; ks < 8; ++ks) { const u32x4 raw = *(const u32x4*)(qo + qrow + 16 * ks + 8 * hh);
                const f32x4 g0 = *(const f32x4*)(qn + 16 * ks + 8 * hh) * *(const f32x4*)(kn + 16 * ks + 8 * hh), g1 = *(const f32x4*)(qn + 16 * ks + 8 * hh + 4) * *(const f32x4*)(kn + 16 * ks + 8 * hh + 4);
                u32x4 w; w.x = cvt_pk_bf16(bflo(raw.x) * rq * g0[0], bfhi(raw.x) * rq * g0[1]); w.y = cvt_pk_bf16(bflo(raw.y) * rq * g0[2], bfhi(raw.y) * rq * g0[3]);
                w.z = cvt_pk_bf16(bflo(raw.z) * rq * g1[0], bfhi(raw.z) * rq * g1[1]); w.w = cvt_pk_bf16(bflo(raw.w) * rq * g1[2], bfhi(raw.w) * rq * g1[3]);
                qf[ks] = __builtin_bit_cast(bf16x8, w); }
        }
        f32x16 o[4];
#pragma unroll
        for (int dt = 0; dt < 4; ++dt)
#pragma unroll
            for (int i = 0; i < 16; ++i) o[dt][i] = 0.f;
        float carry = 0.f;
        bf16x8 kf[8];
        { const bf16_t* kp = kbuf + ((size_t)(bh * (SEQ / 32) + qt) * 8) * 512 + lane * 8;
#pragma unroll
          for (int ks = 0; ks < 8; ++ks) kf[ks] = *(const bf16x8*)(kp + 512 * ks); }
        for (int kt = qt; kt >= 0; --kt) {
            const int s0 = kt * 32;
            f32x16 z;
#pragma unroll
            for (int i = 0; i < 16; ++i) z[i] = 0.f;
#pragma unroll
            for (int ks = 0; ks < 8; ++ks) z = __builtin_amdgcn_mfma_f32_32x32x16_bf16(kf[ks], qf[ks], z, 0, 0, 0);
            if (kt > 0) {
                const bf16_t* kp = kbuf + ((size_t)(bh * (SEQ / 32) + kt - 1) * 8) * 512 + lane * 8;
#pragma unroll
                for (int ks = 0; ks < 8; ++ks) kf[ks] = *(const bf16x8*)(kp + 512 * ks);
            }
            bf16x8 vf[4][2];
            const bf16_t* vp = vt + ((size_t)(bh * (SEQ / 32) + kt) * 8) * 512 + lane * 8;
#define ATT_VLOAD(dt) do { _Pragma("unroll") for (int kv = 0; kv < 2; ++kv) vf[dt][kv] = *(const bf16x8*)(vp + ((dt) * 2 + kv) * 512); } while (0)
            ATT_VLOAD(0); ATT_VLOAD(1);
            float ln[16], zz[16];
            const bool diag = (kt == qt);
#pragma unroll
            for (int g = 0; g < 4; ++g) { const u32x4 k4 = *(const u32x4*)(ssk + (size_t)bh * SEQ + s0 + 8 * g + 4 * hh);
#pragma unroll
                for (int i = 0; i < 4; ++i) { const float rk = rsqrtf((float)k4[i] * (SH_INV / HD) + EPS); const float zv = z[4 * g + i] * rk;
                    const bool valid = !diag || (8 * g + 4 * hh + i < tl);
                    zz[4 * g + i] = zv; ln[4 * g + i] = valid ? -softplusf_(zv) : 0.f; } }
            float gs[4], og_[4];
#pragma unroll
            for (int g = 0; g < 4; ++g) { gs[g] = (ln[4 * g] + ln[4 * g + 1]) + (ln[4 * g + 2] + ln[4 * g + 3]); og_[g] = __shfl_xor(gs[g], 32); }
            float after[4]; float run = carry;
#pragma unroll
            for (int g = 3; g >= 0; --g) { after[g] = run + (hh == 0 ? og_[g] : 0.f); run += gs[g] + og_[g]; }
            float wv[16];
#pragma unroll
            for (int g = 0; g < 4; ++g) { float suf = after[g];
#pragma unroll
                for (int i = 3; i >= 0; --i) { const int e = 4 * g + i; const bool valid = !diag || (8 * g + 4 * hh + i < tl);
                    wv[e] = valid ? __expf(zz[e] + ln[e] + suf) : 0.f; suf += ln[e]; } }
            carry = run;
            ATT_VLOAD(2); ATT_VLOAD(3);
#undef ATT_VLOAD
#pragma unroll
            for (int kv = 0; kv < 2; ++kv) { u32x4 p; p.x = cvt_pk_bf16(wv[8 * kv], wv[8 * kv + 1]); p.y = cvt_pk_bf16(wv[8 * kv + 2], wv[8 * kv + 3]); p.z = cvt_pk_bf16(wv[8 * kv + 4], wv[8 * kv + 5]); p.w = cvt_pk_bf16(wv[8 * kv + 6], wv[8 * kv + 7]);
                const bf16x8 pb = __builtin_bit_cast(bf16x8, p);
#pragma unroll
                for (int dt = 0; dt < 4; ++dt) o[dt] = __builtin_amdgcn_mfma_f32_32x32x16_bf16(vf[dt][kv], pb, o[dt], 0, 0, 0); }
            if (__ballot(carry >= -110.0f) == 0ull) break;
        }
#pragma unroll
        for (int dt = 0; dt < 4; ++dt)
#pragma unroll
            for (int g = 0; g < 4; ++g) { u32x2 w; w.x = cvt_pk_bf16(o[dt][4 * g], o[dt][4 * g + 1]); w.y = cvt_pk_bf16(o[dt][4 * g + 2], o[dt][4 * g + 3]);
                *(u32x2*)(ob + qrow + 32 * dt + 8 * g + 4 * hh) = w; }
    }
}

#define XB_TMO      128
#define XB_XCNT(j)  (256  + 64 * (j))
#define XB_XSUB(j)  (1280 + 64 * (j))
#define XB_XGEN(j)  (2304 + 64 * (j))
#define XB_TOP      3328
#define XB_TOPGEN   3392
#define XCD_BAR_WORDS 3456
#define XB_SPIN_CAP (1u << 18)
DI unsigned xb_ld(unsigned* p)              { return __hip_atomic_load(p, __ATOMIC_RELAXED, __HIP_MEMORY_SCOPE_AGENT); }
DI unsigned xb_add(unsigned* p, unsigned v) { return __hip_atomic_fetch_add(p, v, __ATOMIC_RELAXED, __HIP_MEMORY_SCOPE_AGENT); }
DI unsigned xb_xcc_id() { return (unsigned)__builtin_amdgcn_s_getreg((3 << 11) | 20) & 0xFu; }
#define XB_SPIN(cond, bar) do { unsigned _sp = 0; while (cond) { __builtin_amdgcn_s_sleep(1); \
    if ((++_sp & 255u) == 0u) { if (xb_ld(&(bar)[XB_TMO])) break; if (_sp > XB_SPIN_CAP) { atomicAdd(&(bar)[XB_TMO], 1u); break; } } } } while (0)
struct XcdBarrier { unsigned* bar; unsigned x; volatile LAS unsigned* st; };
DI XcdBarrier xcd_barrier_post(unsigned* bar, volatile LAS unsigned* st) {
    XcdBarrier b; b.bar = bar; b.x = xb_xcc_id(); b.st = st;
    if (threadIdx.x == 0) (void)xb_add(&bar[XB_XCNT(b.x)], 1u);
    return b;
}
DI void xcd_barrier_complete(unsigned* bar, unsigned x, unsigned& nloc, unsigned& nx) {
    const unsigned G = gridDim.x * gridDim.y * gridDim.z;
    unsigned sum, cnt, mine, sp = 0u;
    for (;;) {
        sum = 0u; cnt = 0u; mine = 0u;
#pragma unroll
        for (unsigned j = 0; j < 16; ++j) { const unsigned c = xb_ld(&bar[XB_XCNT(j)]); sum += c; cnt += (c > 0u) ? 1u : 0u; mine = (j == x) ? c : mine; }
        if (sum == G) break;
        __builtin_amdgcn_s_sleep(1);
        if ((++sp & 255u) == 0u) { if (xb_ld(&bar[XB_TMO])) break; if (sp > XB_SPIN_CAP) { atomicAdd(&bar[XB_TMO], 1u); break; } }
    }
    nloc = mine > 0u ? mine : 1u; nx = cnt > 0u ? cnt : 1u;
}
DI void xcd_barrier(const XcdBarrier& b) {
    asm volatile("s_waitcnt vmcnt(0)" ::: "memory");
    __syncthreads();
    if (threadIdx.x == 0) {
        unsigned* bar = b.bar;
        __builtin_amdgcn_s_waitcnt(0);
        unsigned nloc = b.st[0], nx = b.st[1];
        if (nloc == 0u) { xcd_barrier_complete(bar, b.x, nloc, nx); b.st[0] = nloc; b.st[1] = nx; }
        const unsigned old = xb_add(&bar[XB_XSUB(b.x)], 1u);
        const unsigned gen = old / nloc;
        if (old + 1u == (gen + 1u) * nloc) {
            __builtin_amdgcn_fence(__ATOMIC_RELEASE, "agent");
            asm volatile("s_waitcnt vmcnt(0)" ::: "memory");
            const unsigned og = xb_add(&bar[XB_TOP], 1u);
            const unsigned tg = og / nx;
            if (og + 1u == (tg + 1u) * nx) xb_add(&bar[XB_TOPGEN], 1u);
            else XB_SPIN(xb_ld(&bar[XB_TOPGEN]) == tg, bar);
            __builtin_amdgcn_fence(__ATOMIC_ACQUIRE, "agent");
            xb_add(&bar[XB_XGEN(b.x)], 1u);
            asm volatile("s_waitcnt vmcnt(0)" ::: "memory");
        } else {
            XB_SPIN(xb_ld(&bar[XB_XGEN(b.x)]) == gen, bar);
            __builtin_amdgcn_fence(__ATOMIC_ACQUIRE, "agent");
            asm volatile("s_waitcnt vmcnt(0)" ::: "memory");
        }
    }
    __syncthreads();
}

enum Kind { K_PREP = 0, K_GIN, K_STA, K_STB, K_STC, K_OUT, K_FUP, K_FDN, K_PP, K_GATE, K_SINQ, K_SINV, K_ATT };
constexpr int NPHASES = 1 + 9 * 2 + 9 + 7;
DI void decode_phase(int ph, int& L, int& kind, int& sub, int& sync) {
    sub = 0; sync = 1;
    if (ph == 0) { L = 0; kind = K_PREP; sync = 0; return; }
    ph -= 1;
    if (ph < 18) { L = ph / 9; const int st = ph % 9;
        kind = st == 0 ? K_GIN : st == 1 ? K_STA : st == 2 ? K_STB : st == 3 ? K_STC : st == 4 ? K_OUT : st == 5 ? K_PP : st == 6 ? K_FUP : st == 7 ? K_FDN : K_GATE;
        if (st == 6) sync = 0; return; }
    ph -= 18;
    int st;
    if (ph < 9) { L = 2; st = ph; if (st == 1) { kind = K_SINQ; sub = 1; sync = 0; return; } if (st == 2) { kind = K_SINV; sync = 0; return; } if (st > 2) st -= 2; }
    else { L = 3; st = ph - 9; }
    kind = st == 0 ? K_SINQ : st == 1 ? K_ATT : st == 2 ? K_OUT : st == 3 ? K_PP : st == 4 ? K_FUP : st == 5 ? K_FDN : K_GATE;
    if (st == 4) sync = 0;
}

__global__ void __launch_bounds__(NTHR, 2) fwd_kernel(Args a0) {
    extern __shared__ __attribute__((aligned(16))) unsigned char lds_raw[];
    LAS unsigned char* lds = (LAS unsigned char*)lds_raw;
    XcdBarrier bar; bar.bar = (unsigned*)(a0.ws + WS_BAR); bar.x = 0; bar.st = (volatile LAS unsigned*)(lds + LDS_BYTES - 16);
    if (a0.coop) {
        if (threadIdx.x < 4) ((LAS unsigned*)(lds + LDS_BYTES - 16))[threadIdx.x] = 0u;
        __syncthreads();
        bar = xcd_barrier_post((unsigned*)(a0.ws + WS_BAR), (volatile LAS unsigned*)(lds + LDS_BYTES - 16));
    }
    for (int ph = a0.ph_lo; ph < a0.ph_hi; ++ph) {
        int L, kind, sub, sync; decode_phase(ph, L, kind, sub, sync);
        if (ph > a0.ph_lo && a0.coop && sync) { if (a0.coop == 2) cg::this_grid().sync(); else xcd_barrier(bar); }
#ifdef XSYNC
        if (ph == 1) { for (int i = 0; i < XSYNC; ++i) xcd_barrier(bar); }
#endif
#ifdef REP_KIND
        for (int rep = 0; rep < ((kind == REP_KIND) ? 2 : 1); ++rep) {
        if (rep) xcd_barrier(bar);
#endif
#ifdef ONLY_KIND
        if (kind != ONLY_KIND) continue;
#endif
        size_t zo; asm volatile("s_mov_b64 %0, 0" : "=s"(zo));
        int tid = threadIdx.x; asm volatile("" : "+v"(tid));
        const int lane = tid & 63, wave = __builtin_amdgcn_readfirstlane(tid >> 6);
        const int G = gridDim.x, gw = blockIdx.x * NWAVES + wave, NGW = G * NWAVES, gt = gw * 64 + lane, NGT = NGW * 64;
        Args a;
#pragma unroll
        for (int i = 0; i < 21; ++i) a.in[i] = a0.in[i] + zo;
        a.out = a0.out + zo; a.ws = a0.ws + zo; a.ph_lo = 0; a.ph_hi = 0; a.coop = 0; a.pad = 0;
        unsigned char* ws = a.ws;
        float* SS = (float*)(ws + WS_SS);
        bf16_t* hb_cur = (bf16_t*)(ws + ((L & 1) ? WS_HB1 : WS_HB0)); bf16_t* hb_oth = (bf16_t*)(ws + ((L & 1) ? WS_HB0 : WS_HB1));
        pg8::StaticOrder S;
        switch (kind) {
        case K_PREP: phase_prep(a, lds, gw, NGW, wave, lane); break;
        case K_GIN: {
            pg8::Gemm g{hb_cur, (const bf16_t*)(ws + WS_WIN) + (size_t)L * 4096 * D, T, 4096, D}; S.init(T, 4096, G, blockIdx.x);
            pg8::EpiBf16<0> E{(bf16_t*)(ws + WS_R1), PLD, SS + 3 * L * T, (bf16_t*)(ws + WS_HALO), nullptr, false};
            pg8::gemm_phase(lds, g, S, E, tid);
            ab_gemm(hb_cur, (const bf16_t*)(ws + WS_WAB) + (size_t)L * 16 * D, SS + 3 * L * T, (float*)(ws + WS_AB), gw, NGW, lane);
        } break;
#if defined(REP_KIND)
        case K_STA: gdn_stage_a(a, L, lds, tid, wave, lane, (REP_KIND == K_STA) && rep == 0); break;
#else
        case K_STA: gdn_stage_a(a, L, lds, tid, wave, lane, false); break;
#endif
        case K_STB: gdn_stage_b(a, L, lds, wave, lane); break;
        case K_STC: gdn_stage_c(a, L, gw, NGW, lane); break;
        case K_OUT: {
            const bf16_t* W = (L < 2) ? (const bf16_t*)(ws + WS_WO) + (size_t)L * D * D : (const bf16_t*)(ws + WS_SWO) + (size_t)(L - 2) * D * D;
            pg8::Gemm g{(const bf16_t*)(ws + (L < 2 ? WS_OG : WS_R1)), W, T, D, D}; S.init(T, D, G, blockIdx.x);
            pg8::EpiRes<false> E{a.out, hb_oth, SS + (3 * L + 1) * T, nullptr, nullptr, L == 0 ? a.in[I_X] : a.out};
            pg8::gemm_phase(lds, g, S, E, tid);
            convert_p(a, L, gt, NGT);
        } break;
        case K_FUP: {
            pg8::Gemm g{hb_oth, (const bf16_t*)(ws + WS_W1) + (size_t)L * 5632 * D, T, 5632, D}; S.init(T, 5632, G, blockIdx.x);
#if defined(REP_KIND)
            pg8::EpiSwiglu E{(bf16_t*)(ws + WS_R1), SS + (3 * L + 1) * T, (REP_KIND == K_FUP) && rep == 0};
#else
            pg8::EpiSwiglu E{(bf16_t*)(ws + WS_R1), SS + (3 * L + 1) * T, false};
#endif
            pg8::gemm_phase(lds, g, S, E, tid);
        } break;
        case K_FDN: {
            pg8::Gemm g{(const bf16_t*)(ws + WS_R1), (const bf16_t*)(ws + WS_W2) + (size_t)L * D * FF, T, D, FF}; S.init(T, D, G, blockIdx.x);
            pg8::EpiRes<false> E{a.out, hb_cur, SS + (3 * L + 2) * T, nullptr, nullptr, a.out};
            pg8::gemm_phase(lds, g, S, E, tid);
        } break;
        case K_PP: {
            pg8::Gemm g2{(const bf16_t*)(ws + WS_PB), (const bf16_t*)(ws + WS_WPROJ) + (size_t)L * D * PLE, T, D, PLE};
            if (G == 256) { if (blockIdx.x < 128) break; S.init(T, D, 128, blockIdx.x - 128); } else S.init(T, D, G, blockIdx.x);
            pg8::EpiBf16<1> E2{(bf16_t*)(ws + WS_OG), D, nullptr, nullptr, nullptr, false};
            pg8::gemm_phase(lds, g2, S, E2, tid);
        } break;
        case K_GATE: {
            pg8::Gemm g{hb_cur, (const bf16_t*)(ws + WS_WGATE) + (size_t)L * D * D, T, D, D}; S.init(T, D, G, blockIdx.x);
            pg8::EpiRes<true> E{a.out, hb_oth, SS + (3 * L + 3) * T, SS + (3 * L + 2) * T, (const bf16_t*)(ws + WS_OG), a.out};
            pg8::gemm_phase(lds, g, S, E, tid);
        } break;
        case K_SINQ: {
            pg8::Gemm g{hb_cur, sub == 0 ? (const bf16_t*)(ws + WS_WQ) + (size_t)(L - 2) * D * D : (const bf16_t*)(ws + WS_WK), T, D, D}; S.init(T, D, G, blockIdx.x);
            pg8::EpiBf16<2> E{sub == 0 ? (bf16_t*)(ws + WS_OG) : (bf16_t*)(ws + WS_KB), D, SS + 3 * L * T, nullptr, sub == 0 ? (float*)(ws + WS_SSQ) + (size_t)(L - 2) * NB * NH * SEQ : (float*)(ws + WS_SSK), sub != 0};
            pg8::gemm_phase(lds, g, S, E, tid);
        } break;
        case K_SINV: {
            pg8::Gemm g{(const bf16_t*)(ws + WS_WV), hb_cur, D, T, D}; S.init(D, T, G, blockIdx.x);
            pg8::EpiVT E{(bf16_t*)(ws + WS_VT), SS + 3 * L * T};
            pg8::gemm_phase(lds, g, S, E, tid);
        } break;
        case K_ATT: sb_attention(a, L - 2, gw, NGW, lane); break;
        }
#ifdef REP_KIND
        }
#endif
    }
}

#ifdef DBG_OFF
__global__ void dbg_dump(const unsigned* src, float* dst, int n) { for (int i = blockIdx.x * blockDim.x + threadIdx.x; i < n; i += gridDim.x * blockDim.x) dst[i] = (float)(src[i] & 0xFFFFFFu); }
#endif
extern "C" void kernel_launch(void* const* d_in, const int* in_sizes, int n_in, void* d_out, int out_size, void* d_ws, size_t ws_size, hipStream_t stream) {
    static int grid = 0;
    if (grid == 0) {
        int dev = 0, cus = 0, per_cu = 0;
        hipGetDevice(&dev); hipDeviceGetAttribute(&cus, hipDeviceAttributeMultiprocessorCount, dev);
        hipFuncSetAttribute((const void*)fwd_kernel, hipFuncAttributeMaxDynamicSharedMemorySize, LDS_BYTES);
        hipOccupancyMaxActiveBlocksPerMultiprocessor(&per_cu, (const void*)fwd_kernel, NTHR, LDS_BYTES);
        (void)hipGetLastError();
        if (per_cu < 1) fprintf(stderr, "kernel_launch: occupancy query reports %d blocks per CU\n", per_cu);
        grid = cus > 0 ? cus : 256;
        if (ws_size < WS_END) fprintf(stderr, "kernel_launch: workspace too small: %zu < %zu\n", ws_size, (size_t)WS_END);
    }
    Args a{};
    for (int i = 0; i < 21; ++i) a.in[i] = (const float*)d_in[i];
    a.out = (float*)d_out; a.ws = (unsigned char*)d_ws;
#if ONE_LAUNCH
    hipMemsetAsync((char*)d_ws + WS_BAR, 0, XCD_BAR_WORDS * 4, stream);
    a.ph_lo = 0; a.ph_hi = NPHASES; a.coop = 1;
    void* args[] = {&a};
    hipError_t e = hipLaunchCooperativeKernel((const void*)fwd_kernel, dim3(grid), dim3(NTHR), args, LDS_BYTES, stream);
    if (e != hipSuccess) fprintf(stderr, "cooperative launch failed: %s (grid %d)\n", hipGetErrorString(e), grid);
#else
    for (int ph = 0; ph < NPHASES && ph < MAXPH; ++ph) {
        a.ph_lo = ph; a.ph_hi = ph + 1; a.coop = 0;
        hipLaunchKernelGGL(fwd_kernel, dim3(grid), dim3(NTHR), LDS_BYTES, stream, a);
    }
#ifdef DBG_OFF
    hipLaunchKernelGGL(dbg_dump, dim3(1024), dim3(256), 0, stream, (const unsigned*)((const char*)d_ws + (size_t)(DBG_OFF)), (float*)d_out, out_size);
#endif
#endif
}
```

```cpp
#include <hip/hip_runtime.h>
#include <hip/hip_cooperative_groups.h>
#include <cstdio>
namespace cg = cooperative_groups;

#ifndef ONE_LAUNCH
#define ONE_LAUNCH 1
#endif
#ifndef MAXPH
#define MAXPH 1000
#endif

#define LAS __attribute__((address_space(3)))
#define GAS __attribute__((address_space(1)))
typedef const GAS char* GCP;
#define DI __device__ __forceinline__
typedef unsigned short bf16_t;
typedef short bf16x8 __attribute__((ext_vector_type(8)));
typedef float f32x4 __attribute__((ext_vector_type(4)));
typedef float f32x16 __attribute__((ext_vector_type(16)));
typedef unsigned u32x4 __attribute__((ext_vector_type(4)));
typedef unsigned u32x2 __attribute__((ext_vector_type(2)));

constexpr int T = 16384, D = 1024, SEQ = 4096, NB = 4, NH = 8, HD = 128, FF = 2816, PLE = 256;
constexpr float EPS = 1e-6f;
constexpr int NWAVES = 8, NTHR = 512;
constexpr int PLD = 4096 + 64;
constexpr int LDS_BYTES = 155648;

constexpr size_t MiB = 1u << 20;
constexpr size_t WS_SS = 0;
constexpr size_t WS_SSQ = 1 * MiB;
constexpr size_t WS_SSK = 2 * MiB;
constexpr size_t WS_GL = 2 * MiB + 512 * 1024;
constexpr size_t WS_BAR = 2 * MiB + 768 * 1024;
constexpr size_t WS_AB = 3 * MiB;
constexpr size_t WS_WIN = 4 * MiB;
constexpr size_t WS_W1 = 20 * MiB;
constexpr size_t WS_W2 = 64 * MiB;
constexpr size_t WS_WO = 86 * MiB;
constexpr size_t WS_WK = 90 * MiB;
constexpr size_t WS_WV = 92 * MiB;
constexpr size_t WS_WQ = 94 * MiB;
constexpr size_t WS_SWO = 98 * MiB;
constexpr size_t WS_WPROJ = 102 * MiB;
constexpr size_t WS_WGATE = 104 * MiB;
constexpr size_t WS_WAB = 112 * MiB;
constexpr size_t WS_R1 = 113 * MiB;
constexpr size_t WS_KB = WS_R1 + 88 * MiB;
constexpr size_t WS_VT = 4 * MiB;
constexpr size_t WS_HB0 = 243 * MiB, WS_HB1 = 275 * MiB;
constexpr size_t WS_OG = 307 * MiB;
constexpr size_t WS_PB = WS_R1 + 120 * MiB;
constexpr size_t WS_HALO = WS_OG;
constexpr size_t WS_END = 339 * MiB;

typedef __bf16 bf16v2 __attribute__((ext_vector_type(2)));
DI unsigned cvt_pk_bf16(float lo, float hi) { bf16v2 v; v[0] = (__bf16)lo; v[1] = (__bf16)hi; return __builtin_bit_cast(unsigned, v); }
DI float bf2f(unsigned short b) { return __uint_as_float(((unsigned)b) << 16); }
DI float bflo(unsigned w) { return __uint_as_float(w << 16); }
DI float bfhi(unsigned w) { return __uint_as_float(w & 0xffff0000u); }
DI float sigmoidf_(float x) { return __builtin_amdgcn_rcpf(1.0f + __expf(-x)); }
DI float siluf_(float x) { return x * __builtin_amdgcn_rcpf(1.0f + __expf(-x)); }
DI float softplusf_(float x) { return fmaxf(x, 0.f) + 0.6931471805599453f * __builtin_amdgcn_logf(1.0f + __builtin_amdgcn_exp2f(-1.4426950408889634f * fabsf(x))); }
constexpr float SS_SCALE = 2048.0f, SS_INV = 1.0f / 2048.0f, SH_SCALE = 16384.0f, SH_INV = 1.0f / 16384.0f;
DI float ss_rstd(const float* ss, int row) { return rsqrtf((float)((const unsigned*)ss)[row] * (SS_INV / 1024.0f) + 1e-6f); }
DI void ss_add(float* ss, int row, float v) { atomicAdd((unsigned*)ss + row, (unsigned)(v * SS_SCALE + 0.5f)); }
DI float wave_sum(float v) {
#pragma unroll
    for (int o = 1; o < 64; o <<= 1) v += __shfl_xor(v, o);
    return v;
}

namespace pg8 {
constexpr int BM = 256, BK = 64, HALF = 128, HTB = HALF * BK * 2, STAGE_BYTES = 8 * HTB, NXCD = 8, WGM = 8;
DI int lds_byte(int r, int c) { const int st = (r >> 4) * 2 + (c >> 5), rr = r & 15, cc = c & 31, ob = rr * 64 + cc * 2; return st * 1024 + (ob ^ (((ob >> 9) & 1) << 5)); }
DI void stage_rc(int b, int& R, int& C) { const int st = b / 1024, sb = b % 1024, swz = sb ^ (((sb >> 9) & 1) << 5); R = (st >> 1) * 16 + swz / 64; C = (st & 1) * 32 + (swz % 64) / 2; }
DI int perm32(int rho) { const int n = rho >> 4, i = rho & 15; return 8 * (i >> 2) + 4 * n + (i & 3); }
struct Unit { int pm, pn; };
struct Gemm { const bf16_t* A; const bf16_t* Bt; int M, N, K; };
struct StaticOrder {
    int nM, nN, nwg, G, c;
    DI void init(int M, int N, int G_, int c_) { nM = M / BM; nN = N / BM; nwg = nM * nN; G = G_; c = c_; }
    DI bool next(int i, Unit& u) const {
        const long L = (long)i * G + c; if (L >= nwg) return false;
        int wgid = (int)L; { const int q = nwg / NXCD, r = nwg % NXCD, xcd = wgid % NXCD, off = wgid / NXCD; wgid = (xcd < r ? xcd * (q + 1) : r * (q + 1) + (xcd - r) * q) + off; }
        const int nig = WGM * nN, gid = wgid / nig, fm = gid * WGM, gsz = (nM - fm) < WGM ? (nM - fm) : WGM;
        u.pm = fm + ((wgid % nig) % gsz); u.pn = (wgid % nig) / gsz; return true;
    }
};

template <class Epi>
DI void gemm_phase(LAS unsigned char* lds, const Gemm g, const StaticOrder& S, const Epi& E, const int tid) {
    const int wid = __builtin_amdgcn_readfirstlane(tid >> 6), lane = tid & 63, wr = wid >> 2, wc = wid & 3, fr = lane & 15, fq = lane >> 4;
    const int K = g.K, nt = K / BK;
    unsigned voffA[2], voffB[2];
#pragma unroll
    for (int i = 0; i < 2; ++i) { int R, C; stage_rc(tid * 16 + i * 8192, R, C); const int Rb = Epi::PERM ? ((R & ~31) + perm32(R & 31)) : R;
        voffA[i] = (unsigned)(R * K + C) * 2u; voffB[i] = (unsigned)(Rb * K + C) * 2u; }
    const size_t kstep = (size_t)(BK * 2);
    const size_t hstep = (size_t)HALF * K * 2;
    const size_t tstep = 2 * hstep;
    const unsigned ldsw = (unsigned)wid * 1024u;
    const int aoff = lds_byte(wr * 64 + fr, fq * 8), boff = lds_byte(wc * 32 + fr, fq * 8);
#define PG8_SA(b, h) (((b) * 2 + (h)) * HTB)
#define PG8_SB(b, h) ((4 + (b) * 2 + (h)) * HTB)
#define PG8_STAGE(bufoff, gbase, voff) do { _Pragma("unroll") for (int _i = 0; _i < 2; ++_i) \
        __builtin_amdgcn_global_load_lds((const unsigned*)((const char*)(gbase) + (voff)[_i]), (LAS unsigned*)(lds + (bufoff) + ldsw + _i * 8192), 16, 0, 0); } while (0)
#define PG8_LDA(dst, b, h) do { _Pragma("unroll") for (int m = 0; m < 4; ++m) _Pragma("unroll") for (int k = 0; k < 2; ++k) dst[m][k] = *(const LAS bf16x8*)(lds + PG8_SA(b, h) + aoff + m * 2048 + k * 1024); } while (0)
#define PG8_LDB(dst, b, h) do { _Pragma("unroll") for (int n = 0; n < 2; ++n) _Pragma("unroll") for (int k = 0; k < 2; ++k) dst[n][k] = *(const LAS bf16x8*)(lds + PG8_SB(b, h) + boff + n * 2048 + k * 1024); } while (0)
#define PG8_MMA(ai, bj, At, Bt) do { __builtin_amdgcn_s_setprio(1); _Pragma("unroll") for (int m = 0; m < 4; ++m) _Pragma("unroll") for (int n = 0; n < 2; ++n) _Pragma("unroll") for (int k = 0; k < 2; ++k) \
        acc[ai][bj][m][n] = __builtin_amdgcn_mfma_f32_16x16x32_bf16(Bt[n][k], At[m][k], acc[ai][bj][m][n], 0, 0, 0); __builtin_amdgcn_s_setprio(0); } while (0)
#define PG8_WAIT_V(n) asm volatile("s_waitcnt vmcnt(" #n ")" ::: "memory")
#define PG8_WAIT_L(n) asm volatile("s_waitcnt lgkmcnt(" #n ")" ::: "memory")
#define PG8_BAR __builtin_amdgcn_s_barrier()
#define PG8_SCHED __builtin_amdgcn_sched_barrier(0)
    Unit cur, nxt; int ui = 0;
    if (!S.next(0, cur)) return;
    f32x4 acc[2][2][4][2];
#pragma unroll
    for (int a = 0; a < 2; ++a)
#pragma unroll
        for (int b = 0; b < 2; ++b)
#pragma unroll
            for (int m = 0; m < 4; ++m)
#pragma unroll
                for (int n = 0; n < 2; ++n) acc[a][b][m][n] = (f32x4){0.f, 0.f, 0.f, 0.f};
    bf16x8 At[4][2], B0[2][2], B1[2][2];
    const char* cA = (const char*)g.A + (size_t)cur.pm * tstep; const char* cB = (const char*)g.Bt + (size_t)cur.pn * tstep;
    PG8_STAGE(PG8_SB(0, 0), cB, voffB); PG8_STAGE(PG8_SA(0, 0), cA, voffA); PG8_STAGE(PG8_SB(0, 1), cB + hstep, voffB); PG8_STAGE(PG8_SA(0, 1), cA + hstep, voffA);
    if (wr == 1) PG8_BAR;
    PG8_WAIT_V(4); PG8_BAR;
    PG8_STAGE(PG8_SB(1, 0), cB + kstep, voffB); PG8_STAGE(PG8_SA(1, 0), cA + kstep, voffA); PG8_STAGE(PG8_SB(1, 1), cB + hstep + kstep, voffB);
    PG8_WAIT_V(6); PG8_BAR;
    for (;;) {
        const bool has_next = S.next(ui + 1, nxt);
        const char* nA = has_next ? (const char*)g.A + (size_t)nxt.pm * tstep : cA; const char* nB = has_next ? (const char*)g.Bt + (size_t)nxt.pn * tstep : cB;
        for (int t = 0; t < nt; t += 2) {
            const bool last = (t == nt - 2);
            const char* a1 = cA + (size_t)(t + 1) * kstep;
            const char* a2 = last ? nA : cA + (size_t)(t + 2) * kstep; const char* b2 = last ? nB : cB + (size_t)(t + 2) * kstep;
            const char* a3 = a2 + kstep; const char* b3 = b2 + kstep;
            PG8_LDB(B0, 0, 0); PG8_SCHED; PG8_LDA(At, 0, 0); PG8_STAGE(PG8_SA(1, 1), a1 + hstep, voffA);
            PG8_WAIT_L(8); PG8_BAR; PG8_WAIT_L(0); PG8_MMA(0, 0, At, B0); PG8_BAR; PG8_SCHED;
            PG8_LDB(B1, 0, 1); PG8_STAGE(PG8_SB(0, 0), b2, voffB);
            PG8_BAR; PG8_WAIT_L(0); PG8_MMA(0, 1, At, B1); PG8_BAR;
            PG8_LDA(At, 0, 1); PG8_STAGE(PG8_SA(0, 0), a2, voffA);
            PG8_BAR; PG8_WAIT_L(0); PG8_MMA(1, 0, At, B0); PG8_BAR; PG8_SCHED;
            PG8_STAGE(PG8_SB(0, 1), b2 + hstep, voffB);
            PG8_WAIT_V(6); PG8_BAR; PG8_MMA(1, 1, At, B1); PG8_BAR;
            PG8_LDB(B0, 1, 0); PG8_SCHED; PG8_LDA(At, 1, 0); PG8_STAGE(PG8_SA(0, 1), a2 + hstep, voffA);
            PG8_WAIT_L(8); PG8_BAR; PG8_WAIT_L(0); PG8_MMA(0, 0, At, B0); PG8_BAR; PG8_SCHED;
            PG8_LDB(B1, 1, 1); PG8_STAGE(PG8_SB(1, 0), b3, voffB);
            PG8_BAR; PG8_WAIT_L(0); PG8_MMA(0, 1, At, B1); PG8_BAR;
            PG8_LDA(At, 1, 1); PG8_STAGE(PG8_SA(1, 0), a3, voffA);
            PG8_BAR; PG8_WAIT_L(0); PG8_MMA(1, 0, At, B0); PG8_BAR; PG8_SCHED;
            PG8_STAGE(PG8_SB(1, 1), b3 + hstep, voffB);
            PG8_WAIT_V(6); PG8_BAR; PG8_MMA(1, 1, At, B1); PG8_BAR;
        }
        E(acc, cur, wr, wc, fr, fq);
        if (!has_next) break;
#pragma unroll
        for (int a = 0; a < 2; ++a)
#pragma unroll
            for (int b = 0; b < 2; ++b)
#pragma unroll
                for (int m = 0; m < 4; ++m)
#pragma unroll
                    for (int n = 0; n < 2; ++n) acc[a][b][m][n] = (f32x4){0.f, 0.f, 0.f, 0.f};
        cur = nxt; cA = nA; cB = nB; ++ui;
    }
    PG8_WAIT_V(0);
    if (wr == 0) PG8_BAR;
    PG8_BAR;
#undef PG8_SA
#undef PG8_SB
#undef PG8_STAGE
#undef PG8_LDA
#undef PG8_LDB
#undef PG8_MMA
#undef PG8_WAIT_V
#undef PG8_WAIT_L
#undef PG8_BAR
#undef PG8_SCHED
}

typedef const f32x4 (&AccT)[2][2][4][2];

template <int MODE> struct EpiBf16 {
    static constexpr bool PERM = true;
    bf16_t* O; int ldc; const float* ss; bf16_t* halo; float* ssh; bool kfrag;
    DI void operator()(AccT acc, const Unit& u, int wr, int wc, int fr, int fq) const {
        const int row0 = u.pm * BM + wr * 64 + fr, col0 = u.pn * BM + wc * 32 + 8 * fq;
        float rs[8];
#pragma unroll
        for (int i = 0; i < 8; ++i) rs[i] = (MODE == 1) ? 1.0f : ss_rstd(ss, row0 + (i >> 2) * HALF + (i & 3) * 16);
#pragma unroll
        for (int ai = 0; ai < 2; ++ai)
#pragma unroll
            for (int m = 0; m < 4; ++m) {
                const int row = row0 + ai * HALF + m * 16;
                const float r = rs[ai * 4 + m];
#pragma unroll
                for (int bj = 0; bj < 2; ++bj) {
                    const f32x4 v0 = acc[ai][bj][m][0] * r, v1 = acc[ai][bj][m][1] * r;
                    u32x4 w; w.x = cvt_pk_bf16(v0[0], v0[1]); w.y = cvt_pk_bf16(v0[2], v0[3]); w.z = cvt_pk_bf16(v1[0], v1[1]); w.w = cvt_pk_bf16(v1[2], v1[3]);
                    const int col = col0 + bj * HALF;
                    if (MODE == 2 && kfrag) { const int d0 = col & 127;
                        *(u32x4*)(O + ((size_t)((((row >> 12) * NH + (col >> 7)) * (SEQ / 32) + ((row & (SEQ - 1)) >> 5)) * 8 + (d0 >> 4)) * 512) + (((d0 >> 3) & 1) * 32 + (row & 31)) * 8) = w; }
                    else *(u32x4*)(O + (size_t)row * ldc + col) = w;
                    if (MODE == 0) { if ((row & 63) >= 61 && col < 3072) *(u32x4*)(halo + ((size_t)(row >> 6) * 3 + ((row & 63) - 61)) * 3072 + col) = w; }
                    if (MODE == 2) {
                        float sq = (v0[0] * v0[0] + v0[1] * v0[1]) + (v0[2] * v0[2] + v0[3] * v0[3]) + (v1[0] * v1[0] + v1[1] * v1[1]) + (v1[2] * v1[2] + v1[3] * v1[3]);
                        sq += __shfl_xor(sq, 16); sq += __shfl_xor(sq, 32);
                        if (fq == 0) atomicAdd((unsigned*)ssh + (size_t)((row >> 12) * NH + (2 * u.pn + bj)) * SEQ + (row & (SEQ - 1)), (unsigned)(sq * SH_SCALE + 0.5f));
                    }
                }
            }
    }
};
struct EpiVT {
    static constexpr bool PERM = true;
    bf16_t* O; const float* ss;
    DI void operator()(AccT acc, const Unit& u, int wr, int wc, int fr, int fq) const {
        const int row0 = u.pm * BM + wr * 64 + fr, col0 = u.pn * BM + wc * 32 + 8 * fq;
        f32x4 rs[2][2];
#pragma unroll
        for (int bj = 0; bj < 2; ++bj)
#pragma unroll
            for (int n = 0; n < 2; ++n) { const u32x4 s4 = *(const u32x4*)(ss + col0 + bj * HALF + 4 * n);
#pragma unroll
                for (int j = 0; j < 4; ++j) rs[bj][n][j] = rsqrtf((float)s4[j] * (SS_INV / D) + EPS); }
#pragma unroll
        for (int ai = 0; ai < 2; ++ai)
#pragma unroll
            for (int m = 0; m < 4; ++m) {
                const int row = row0 + ai * HALF + m * 16;
#pragma unroll
                for (int bj = 0; bj < 2; ++bj) {
                    const f32x4 v0 = acc[ai][bj][m][0] * rs[bj][0], v1 = acc[ai][bj][m][1] * rs[bj][1];
                    u32x4 w; w.x = cvt_pk_bf16(v0[0], v0[1]); w.y = cvt_pk_bf16(v0[2], v0[3]); w.z = cvt_pk_bf16(v1[0], v1[1]); w.w = cvt_pk_bf16(v1[2], v1[3]);
                    const int tok = col0 + bj * HALF, sl_ = tok & 31;
                    bf16_t* vb_ = O + ((size_t)(((((tok >> 12) * NH + (row >> 7)) * (SEQ / 32) + ((tok & (SEQ - 1)) >> 5)) * 4 + ((row & 127) >> 5)) * 2 + ((sl_ >> 4) & 1)) * 512) + (row & 31) * 8 + ((sl_ >> 3) & 1) * 4;
                    *(u32x2*)(vb_) = (u32x2){w.x, w.y}; *(u32x2*)(vb_ + 256) = (u32x2){w.z, w.w};
                }
            }
    }
};
struct EpiSwiglu {
    static constexpr bool PERM = true;
    bf16_t* O; const float* ss; bool dry;
    DI void operator()(AccT acc, const Unit& u, int wr, int wc, int fr, int fq) const {
        if (dry) return;
        const int row0 = u.pm * BM + wr * 64 + fr, col0 = u.pn * HALF + wc * 32 + 8 * fq;
        float rs[8];
#pragma unroll
        for (int i = 0; i < 8; ++i) rs[i] = ss_rstd(ss, row0 + (i >> 2) * HALF + (i & 3) * 16);
#pragma unroll
        for (int ai = 0; ai < 2; ++ai)
#pragma unroll
            for (int m = 0; m < 4; ++m) {
                const int row = row0 + ai * HALF + m * 16;
                const float r = rs[ai * 4 + m];
                float o[8];
#pragma unroll
                for (int n = 0; n < 2; ++n)
#pragma unroll
                    for (int j = 0; j < 4; ++j) { const float gt = acc[ai][0][m][n][j] * r, up = acc[ai][1][m][n][j] * r; o[n * 4 + j] = siluf_(gt) * up; }
                u32x4 w; w.x = cvt_pk_bf16(o[0], o[1]); w.y = cvt_pk_bf16(o[2], o[3]); w.z = cvt_pk_bf16(o[4], o[5]); w.w = cvt_pk_bf16(o[6], o[7]);
                *(u32x4*)(O + (size_t)row * FF + col0) = w;
            }
    }
};
template <bool GATE> struct EpiRes {
    static constexpr bool PERM = false;
    float* h; bf16_t* hb; float* ss_out; const float* ss_in; const bf16_t* pp; const float* hin; const bf16_t* hres; bool res_bf16, write_f32;
    DI void operator()(AccT acc, const Unit& u, int wr, int wc, int fr, int fq) const {
        const int row0 = u.pm * BM + wr * 64 + fr, col0 = u.pn * BM + wc * 32 + 4 * fq;
        float rs[8];
#pragma unroll
        for (int i = 0; i < 8; ++i) rs[i] = GATE ? ss_rstd(ss_in, row0 + (i >> 2) * HALF + (i & 3) * 16) : 1.0f;
        f32x4 hv[2][4]; u32x2 pv[2][4];
#define ER_LOAD(i_, b_) do { const size_t o_ = (size_t)(row0 + ((i_) >> 2) * HALF + ((i_) & 3) * 16) * D + col0; \
            _Pragma("unroll") for (int q = 0; q < 4; ++q) { const size_t oq_ = o_ + (q >> 1) * HALF + (q & 1) * 16; \
                if (res_bf16) { const u32x2 t_ = *(const u32x2*)(hres + oq_); hv[b_][q][0] = __uint_as_float(t_.x); hv[b_][q][1] = __uint_as_float(t_.y); } \
                else hv[b_][q] = *(const f32x4*)(hin + oq_); \
                if (GATE) pv[b_][q] = *(const u32x2*)(pp + oq_); } } while (0)
        ER_LOAD(0, 0);
#pragma unroll
        for (int i = 0; i < 8; ++i) {
            const int ai = i >> 2, m = i & 3, bsel = i & 1;
            if (i + 1 < 8) { if (bsel) ER_LOAD(i + 1, 0); else ER_LOAD(i + 1, 1); }
            const int row = row0 + ai * HALF + m * 16; const float r = rs[i];
            float sq = 0.f;
#pragma unroll
            for (int q = 0; q < 4; ++q) {
                const int bj = q >> 1, n = q & 1;
                const size_t off = (size_t)row * D + col0 + bj * HALF + n * 16;
                f32x4 hvv = hv[bsel][q]; f32x4 a = acc[ai][bj][m][n];
                if (res_bf16) { const unsigned t0_ = __float_as_uint(hvv[0]), t1_ = __float_as_uint(hvv[1]); hvv[0] = bflo(t0_); hvv[1] = bfhi(t0_); hvv[2] = bflo(t1_); hvv[3] = bfhi(t1_); }
                if (GATE) { const u32x2 pw = pv[bsel][q];
                    a[0] = bflo(pw.x) * sigmoidf_(a[0] * r); a[1] = bfhi(pw.x) * sigmoidf_(a[1] * r); a[2] = bflo(pw.y) * sigmoidf_(a[2] * r); a[3] = bfhi(pw.y) * sigmoidf_(a[3] * r); }
                hvv = hvv + a;
                if (write_f32) *(f32x4*)(h + off) = hvv;
                u32x2 w; w.x = cvt_pk_bf16(hvv[0], hvv[1]); w.y = cvt_pk_bf16(hvv[2], hvv[3]);
                *(u32x2*)(hb + off) = w;
                sq += (hvv[0] * hvv[0] + hvv[1] * hvv[1]) + (hvv[2] * hvv[2] + hvv[3] * hvv[3]);
            }
            sq += __shfl_xor(sq, 16); sq += __shfl_xor(sq, 32);
            if (fq == 0) ss_add(ss_out, row, sq);
        }
#undef ER_LOAD
    }
};
}

struct Args { const float* in[21]; float* out; unsigned char* ws; int ph_lo, ph_hi, coop, pad; };
enum { I_X = 0, I_P, I_LNMIX, I_LNFFN, I_LNPLE, I_GWIN, I_GCONV, I_GALOG, I_GDT, I_GNORM, I_GWOUT, I_KVNORM, I_WKV, I_KNORM, I_SWQ, I_SQNORM, I_SWOUT, I_FWIN, I_FWOUT, I_PPROJ, I_PGATE };

DI void transpose_item(const float* W, int ldw, int col0, int K, const float* gain, bf16_t* WT, int dst_row0, int k0, int n0, LAS float* scr, int lane) {
    float v[32];
    const float* wp = W + (size_t)(k0 + (lane >> 5)) * ldw + col0 + n0 + (lane & 31);
#pragma unroll
    for (int i = 0; i < 32; ++i) v[i] = wp[(size_t)(2 * i) * ldw];
    const int c = lane & 7;
    f32x4 g0 = (f32x4){1.f, 1.f, 1.f, 1.f}, g1 = g0;
    if (gain) { g0 = *(const f32x4*)(gain + k0 + 8 * c); g1 = *(const f32x4*)(gain + k0 + 8 * c + 4); }
#pragma unroll
    for (int i = 0; i < 32; ++i) scr[(2 * i + (lane >> 5)) * 33 + (lane & 31)] = v[i];
    asm volatile("s_waitcnt lgkmcnt(0)" ::: "memory");
#pragma unroll
    for (int j = 0; j < 4; ++j) { const int n = (lane >> 3) + 8 * j; const LAS float* sp = scr + (8 * c) * 33 + n;
        u32x4 o; o.x = cvt_pk_bf16(sp[0 * 33] * g0[0], sp[1 * 33] * g0[1]); o.y = cvt_pk_bf16(sp[2 * 33] * g0[2], sp[3 * 33] * g0[3]); o.z = cvt_pk_bf16(sp[4 * 33] * g1[0], sp[5 * 33] * g1[1]); o.w = cvt_pk_bf16(sp[6 * 33] * g1[2], sp[7 * 33] * g1[3]);
        *(u32x4*)(WT + (size_t)(dst_row0 + n) * K + k0 + 8 * c) = o; }
    asm volatile("s_waitcnt lgkmcnt(0)" ::: "memory");
}
struct TJob { const float* W; int ldw, col0, K, ncols; const float* gain; bf16_t* WT; int mode; };
DI TJob get_job(int j, const Args& a) {
    TJob t; t.mode = 0; t.gain = nullptr; t.col0 = 0;
    unsigned char* ws = a.ws;
    if (j < 2) { t.W = a.in[I_GWIN] + (size_t)j * D * 4112; t.ldw = 4112; t.K = D; t.ncols = 4096; t.gain = a.in[I_LNMIX] + j * D; t.WT = (bf16_t*)(ws + WS_WIN) + (size_t)j * 4096 * D; return t; } j -= 2;
    if (j < 4) { t.W = a.in[I_FWIN] + (size_t)j * D * 5632; t.ldw = 5632; t.K = D; t.ncols = 5632; t.gain = a.in[I_LNFFN] + j * D; t.WT = (bf16_t*)(ws + WS_W1) + (size_t)j * 5632 * D; t.mode = 1; return t; } j -= 4;
    if (j < 4) { t.W = a.in[I_FWOUT] + (size_t)j * FF * D; t.ldw = D; t.K = FF; t.ncols = D; t.WT = (bf16_t*)(ws + WS_W2) + (size_t)j * D * FF; return t; } j -= 4;
    if (j < 2) { t.W = a.in[I_GWOUT] + (size_t)j * D * D; t.ldw = D; t.K = D; t.ncols = D; t.WT = (bf16_t*)(ws + WS_WO) + (size_t)j * D * D; return t; } j -= 2;
    if (j < 2) { t.W = a.in[I_WKV]; t.ldw = 2048; t.col0 = j * 1024; t.K = D; t.ncols = D; t.gain = a.in[I_KVNORM]; t.WT = (bf16_t*)(ws + (j ? WS_WV : WS_WK)); return t; } j -= 2;
    if (j < 2) { t.W = a.in[I_SWQ] + (size_t)j * D * D; t.ldw = D; t.K = D; t.ncols = D; t.gain = a.in[I_LNMIX] + (2 + j) * D; t.WT = (bf16_t*)(ws + WS_WQ) + (size_t)j * D * D; return t; } j -= 2;
    if (j < 2) { t.W = a.in[I_SWOUT] + (size_t)j * D * D; t.ldw = D; t.K = D; t.ncols = D; t.WT = (bf16_t*)(ws + WS_SWO) + (size_t)j * D * D; return t; } j -= 2;
    if (j < 4) { t.W = a.in[I_PPROJ] + (size_t)j * PLE * D; t.ldw = D; t.K = PLE; t.ncols = D; t.WT = (bf16_t*)(ws + WS_WPROJ) + (size_t)j * D * PLE; return t; } j -= 4;
    t.W = a.in[I_PGATE] + (size_t)j * D * D; t.ldw = D; t.K = D; t.ncols = D; t.gain = a.in[I_LNPLE] + j * D; t.WT = (bf16_t*)(ws + WS_WGATE) + (size_t)j * D * D; return t;
}
constexpr int NJOBS = 26;

struct TItem { const float* wp; const float* gp; bf16_t* wt; int ldw, K, valid; };
DI TItem decode_titem(int g, const Args& a, int lane) {
    TItem r; r.wp = nullptr; r.gp = nullptr; r.wt = nullptr; r.ldw = 0; r.K = 0; r.valid = 0;
    for (int j = 0; j < NJOBS; ++j) {
        const TJob t = get_job(j, a);
        const int nblk = t.ncols / 32, nitems = (t.K / 64) * nblk;
        if (g < nitems) {
            const int kb = g / nblk, nb = g % nblk, n0 = nb * 32, k0 = kb * 64;
            int drow = n0;
            if (t.mode == 1) { drow = (n0 < FF) ? ((n0 / 128) * 256 + (n0 % 128)) : (((n0 - FF) / 128) * 256 + 128 + ((n0 - FF) % 128)); }
            r.wp = t.W + (size_t)(k0 + (lane >> 5)) * t.ldw + t.col0 + n0 + (lane & 31);
            r.gp = t.gain ? t.gain + k0 + 8 * (lane & 7) : nullptr;
            r.wt = t.WT + (size_t)(drow + (lane >> 3)) * t.K + k0 + 8 * (lane & 7);
            r.ldw = t.ldw; r.K = t.K; r.valid = 1; return r;
        }
        g -= nitems;
    }
    return r;
}
constexpr int TR_TOTAL = 2 * 2048 + 4 * 2816 + 4 * 1408 + 2 * 512 + 2 * 512 + 2 * 512 + 2 * 512 + 4 * 128 + 4 * 512;
DI void phase_prep(const Args& a, LAS unsigned char* lds, int gw, int NGW, int wave, int lane) {
    LAS float* scr = (LAS float*)(lds + wave * 16384);
    {
        float v[32]; f32x4 g0 = (f32x4){1.f, 1.f, 1.f, 1.f}, g1 = g0;
        TItem cur = decode_titem(gw, a, lane);
        if (cur.valid) {
#pragma unroll
            for (int i = 0; i < 32; ++i) v[i] = cur.wp[(size_t)(2 * i) * cur.ldw];
            if (cur.gp) { g0 = *(const f32x4*)(cur.gp); g1 = *(const f32x4*)(cur.gp + 4); }
        }
        for (int g = gw; g < TR_TOTAL; g += NGW) {
#pragma unroll
            for (int i = 0; i < 32; ++i) scr[(2 * i + (lane >> 5)) * 33 + (lane & 31)] = v[i];
            const f32x4 h0 = g0, h1 = g1; bf16_t* wt = cur.wt; const int K = cur.K;
            cur = decode_titem(g + NGW, a, lane);
            g0 = (f32x4){1.f, 1.f, 1.f, 1.f}; g1 = g0;
            if (cur.valid) {
#pragma unroll
                for (int i = 0; i < 32; ++i) v[i] = cur.wp[(size_t)(2 * i) * cur.ldw];
                if (cur.gp) { g0 = *(const f32x4*)(cur.gp); g1 = *(const f32x4*)(cur.gp + 4); }
            }
            asm volatile("s_waitcnt lgkmcnt(0)" ::: "memory");
            const int c = lane & 7;
#pragma unroll
            for (int j = 0; j < 4; ++j) { const int n = (lane >> 3) + 8 * j; const LAS float* sp = scr + (8 * c) * 33 + n;
                u32x4 o; o.x = cvt_pk_bf16(sp[0 * 33] * h0[0], sp[1 * 33] * h0[1]); o.y = cvt_pk_bf16(sp[2 * 33] * h0[2], sp[3 * 33] * h0[3]); o.z = cvt_pk_bf16(sp[4 * 33] * h1[0], sp[5 * 33] * h1[1]); o.w = cvt_pk_bf16(sp[6 * 33] * h1[2], sp[7 * 33] * h1[3]);
                *(u32x4*)(wt + (size_t)(8 * j) * K) = o; }
            asm volatile("s_waitcnt lgkmcnt(0)" ::: "memory");
        }
    }
    const int gt = gw * 64 + lane, NGT = NGW * 64;
    for (int i = gt; i < 2 * 16 * D; i += NGT) { const int l = i / (16 * D), n = (i / D) % 16, k = i % D;
        const float v = a.in[I_GWIN][(size_t)l * D * 4112 + (size_t)k * 4112 + 4096 + n] * a.in[I_LNMIX][l * D + k];
        ((bf16_t*)(a.ws + WS_WAB))[i] = (bf16_t)(cvt_pk_bf16(v, 0.f) & 0xffffu); }
    { float* z = (float*)(a.ws + WS_SS) + T; for (int i = gt; i < 12 * T; i += NGT) z[i] = 0.f;
      float* z2 = (float*)(a.ws + WS_SSQ); for (int i = gt; i < (int)((WS_GL - WS_SSQ) / 4); i += NGT) z2[i] = 0.f; }
    float* ss0 = (float*)(a.ws + WS_SS); bf16_t* hb0 = (bf16_t*)(a.ws + WS_HB0);
    for (int m = gw; m < T; m += NGW) {
        const f32x4* xr = (const f32x4*)(a.in[I_X] + (size_t)m * D) + lane; u32x2* hbr = (u32x2*)(hb0 + (size_t)m * D) + lane;
        float s = 0.f;
#pragma unroll
        for (int j = 0; j < 4; ++j) { const f32x4 v = xr[64 * j]; u32x2 w; w.x = cvt_pk_bf16(v[0], v[1]); w.y = cvt_pk_bf16(v[2], v[3]); hbr[64 * j] = w; s += (v[0] * v[0] + v[1] * v[1]) + (v[2] * v[2] + v[3] * v[3]); }
        s = wave_sum(s);
        if (lane == 0) ((unsigned*)ss0)[m] = (unsigned)(s * SS_SCALE + 0.5f);
    }
}

DI void convert_p(const Args& a, int L, int gt, int NGT) {
    const f32x4* src = (const f32x4*)(a.in[I_P] + (size_t)L * T * PLE); u32x4* dst = (u32x4*)(a.ws + WS_PB);
    for (int i = gt; i < T * PLE / 8; i += NGT) { const f32x4 v0 = src[2 * i], v1 = src[2 * i + 1];
        u32x4 w; w.x = cvt_pk_bf16(v0[0], v0[1]); w.y = cvt_pk_bf16(v0[2], v0[3]); w.z = cvt_pk_bf16(v1[0], v1[1]); w.w = cvt_pk_bf16(v1[2], v1[3]); dst[i] = w; }
}

DI void ab_gemm(const bf16_t* hb, const bf16_t* wab, const float* ss, float* AB, int gw, int NGW, int lane) {
    const int fr = lane & 15, fq = lane >> 4;
    for (int tile = gw; tile < T / 16; tile += NGW) {
        f32x4 acc = (f32x4){0.f, 0.f, 0.f, 0.f};
        const bf16_t* ap = hb + (size_t)(tile * 16 + fr) * D + 8 * fq; const bf16_t* bp = wab + (size_t)fr * D + 8 * fq;
#pragma unroll 1
        for (int k8 = 0; k8 < D / 256; ++k8) {
            bf16x8 av[8], bv[8];
#pragma unroll
            for (int j = 0; j < 8; ++j) { av[j] = *(const bf16x8*)(ap + 256 * k8 + 32 * j); bv[j] = *(const bf16x8*)(bp + 256 * k8 + 32 * j); }
            asm volatile("" : "+v"(av[0]), "+v"(av[1]), "+v"(av[2]), "+v"(av[3]), "+v"(av[4]), "+v"(av[5]), "+v"(av[6]), "+v"(av[7]),
                              "+v"(bv[0]), "+v"(bv[1]), "+v"(bv[2]), "+v"(bv[3]), "+v"(bv[4]), "+v"(bv[5]), "+v"(bv[6]), "+v"(bv[7]));
#pragma unroll
            for (int j = 0; j < 8; ++j) acc = __builtin_amdgcn_mfma_f32_16x16x32_bf16(av[j], bv[j], acc, 0, 0, 0);
        }
#pragma unroll
        for (int r = 0; r < 4; ++r) { const int row = tile * 16 + 4 * fq + r; AB[(size_t)row * 16 + fr] = acc[r] * ss_rstd(ss, row); }
    }
}

constexpr int SA_QS = 0, SA_KS = 32768, SA_VS = 65536, SA_STG = 98304, SA_A = SA_STG, SA_KB = SA_A + 16384, SA_QB = SA_KB + 64 * 136 * 2, SA_BETA = SA_STG + 67 * 384 * 2, SA_G = SA_BETA + 256, SA_RQ = SA_G + 256, SA_RK = SA_RQ + 256;
static_assert(SA_QB + 64 * 136 * 2 <= SA_BETA && SA_RK + 256 <= LDS_BYTES - 16, "stage A LDS");

DI void gdn_stage_a(const Args& a, int L, LAS unsigned char* lds, int tid, int wave, int lane, const bool dry) {
    const int l = L;
    bf16_t* proj = (bf16_t*)(a.ws + WS_R1);
    const bf16_t* halo = (const bf16_t*)(a.ws + WS_HALO);
    bf16_t* wbuf = (bf16_t*)(a.ws + ((L & 1) ? WS_HB1 : WS_HB0));
    bf16_t* qkd = (bf16_t*)(a.ws + ((L & 1) ? WS_HB0 : WS_HB1));
    float* GL = (float*)(a.ws + WS_GL);
    const float* AB = (const float*)(a.ws + WS_AB);
    const float* convw = a.in[I_GCONV] + (size_t)l * 4 * 3072;
    LAS float* qs = (LAS float*)(lds + SA_QS); LAS float* ks = (LAS float*)(lds + SA_KS); LAS float* vs = (LAS float*)(lds + SA_VS); LAS float* Am = (LAS float*)(lds + SA_A); LAS bf16_t* stg = (LAS bf16_t*)(lds + SA_STG);
    LAS bf16_t* kb = (LAS bf16_t*)(lds + SA_KB); LAS bf16_t* qb = (LAS bf16_t*)(lds + SA_QB);
    LAS float* sbeta = (LAS float*)(lds + SA_BETA); LAS float* sG = (LAS float*)(lds + SA_G); LAS float* srq = (LAS float*)(lds + SA_RQ); LAS float* srk = (LAS float*)(lds + SA_RK);

    for (int item = blockIdx.x; item < NB * NH * 64; item += gridDim.x) {
        const int n = item & 63, bh = item >> 6, h = bh & 7, b = bh >> 3;
        const int t0 = b * SEQ + n * 64;
        int tidv = tid; asm volatile("" : "+v"(tidv));
        {
            u32x4 rv[7];
#pragma unroll
            for (int i = 0; i < 7; ++i) { const int id = tidv + i * NTHR; rv[i] = (u32x4){0u, 0u, 0u, 0u};
                if (id < 67 * 48) { const int row = id / 48, cc = id % 48, seg = cc >> 4, off = (cc & 15) * 8, rr = row - 3;
                    if (rr >= 0) rv[i] = *(const u32x4*)(proj + (size_t)(t0 + rr) * PLD + seg * 1024 + h * 128 + off);
                    else if (n > 0) rv[i] = *(const u32x4*)(halo + ((size_t)(b * 64 + n - 1) * 3 + row) * 3072 + seg * 1024 + h * 128 + off); } }
#pragma unroll
            for (int i = 0; i < 7; ++i) { const int id = tidv + i * NTHR;
                if (id < 67 * 48) { const int row = id / 48, cc = id % 48; *(LAS u32x4*)(stg + row * 384 + cc * 8) = rv[i]; } }
            if (tidv >= 448) {
                const int r = tidv - 448;
                const float ain = AB[(size_t)(t0 + r) * 16 + h], bin = AB[(size_t)(t0 + r) * 16 + 8 + h];
                float g = -__expf(a.in[I_GALOG][l * NH + h]) * softplusf_(ain + a.in[I_GDT][l * NH + h]);
#pragma unroll
                for (int o = 1; o < 64; o <<= 1) { const float t_ = __shfl_up(g, o); if (r >= o) g += t_; }
                sbeta[r] = sigmoidf_(bin); sG[r] = g;
                if (r == 63) GL[bh * 64 + n] = __expf(g);
            }
        }
        __syncthreads();
#pragma unroll 1
        for (int task = tidv; task < 384 * 4; task += NTHR) {
            const int col = task % 384, r0 = (task / 384) * 16, seg = col >> 7, c = col & 127, ch = seg * 1024 + h * 128 + c;
            const float w0 = convw[ch], w1 = convw[3072 + ch], w2 = convw[2 * 3072 + ch], w3 = convw[3 * 3072 + ch];
            LAS float* dst = (seg == 0 ? qs : seg == 1 ? ks : vs) + c;
            const LAS bf16_t* sp = stg + r0 * 384 + col;
            float x0 = bf2f(sp[0]), x1 = bf2f(sp[384]), x2 = bf2f(sp[2 * 384]);
#pragma unroll
            for (int r = 0; r < 16; ++r) { const float x3 = bf2f(sp[(r + 3) * 384]); dst[(r0 + r) * 128] = siluf_(w0 * x0 + w1 * x1 + w2 * x2 + w3 * x3); x0 = x1; x1 = x2; x2 = x3; }
        }
        __syncthreads();
        { const int r = tidv >> 3, l8 = tidv & 7; float sq = 0.f, sk = 0.f;
#pragma unroll
            for (int j = 0; j < 4; ++j) { const f32x4 qv = *(LAS f32x4*)(qs + r * 128 + 32 * j + 4 * l8), kv = *(LAS f32x4*)(ks + r * 128 + 32 * j + 4 * l8);
                sq += (qv[0] * qv[0] + qv[1] * qv[1]) + (qv[2] * qv[2] + qv[3] * qv[3]); sk += (kv[0] * kv[0] + kv[1] * kv[1]) + (kv[2] * kv[2] + kv[3] * kv[3]); }
            sq += __shfl_xor(sq, 1); sk += __shfl_xor(sk, 1); sq += __shfl_xor(sq, 2); sk += __shfl_xor(sk, 2); sq += __shfl_xor(sq, 4); sk += __shfl_xor(sk, 4);
            if (l8 == 0) { srq[r] = rsqrtf(sq + EPS) * 0.08838834764831845f; srk[r] = rsqrtf(sk + EPS); } }
        __syncthreads();
#pragma unroll 1
        for (int i = tidv; i < 64 * 32; i += NTHR) { const int r = i >> 5, c4 = (i & 31) * 4;
            f32x4 qv = *(LAS f32x4*)(qs + r * 128 + c4) * srq[r], kv = *(LAS f32x4*)(ks + r * 128 + c4) * srk[r];
            *(LAS f32x4*)(qs + r * 128 + c4) = qv; *(LAS f32x4*)(ks + r * 128 + c4) = kv;
            u32x2 wq, wk; wq.x = cvt_pk_bf16(qv[0], qv[1]); wq.y = cvt_pk_bf16(qv[2], qv[3]); wk.x = cvt_pk_bf16(kv[0], kv[1]); wk.y = cvt_pk_bf16(kv[2], kv[3]);
            *(LAS u32x2*)(qb + r * 136 + c4) = wq; *(LAS u32x2*)(kb + r * 136 + c4) = wk; }
        __syncthreads();
        {
            const int fr = lane & 15, fq = lane >> 4;
#pragma unroll
            for (int tt = 0; tt < 2; ++tt) { const int tile = wave * 2 + tt, rt = tile >> 2, ct = tile & 3;
                f32x4 acc = (f32x4){0.f, 0.f, 0.f, 0.f};
#pragma unroll
                for (int kk = 0; kk < 4; ++kk) { const bf16x8 av = *(LAS bf16x8*)(kb + (16 * rt + fr) * 136 + 32 * kk + 8 * fq), bv = *(LAS bf16x8*)(kb + (16 * ct + fr) * 136 + 32 * kk + 8 * fq);
                    acc = __builtin_amdgcn_mfma_f32_16x16x32_bf16(av, bv, acc, 0, 0, 0); }
                const int s = 16 * ct + fr; const float Gs = sG[s];
#pragma unroll
                for (int rg = 0; rg < 4; ++rg) { const int r = 16 * rt + 4 * fq + rg; const float v = (s < r) ? sbeta[r] * acc[rg] * __expf(sG[r] - Gs) : 0.f; Am[r * 64 + s] = v; } }
        }
        __syncthreads();
        if (tid < 256) {
            int lz; asm volatile("v_mov_b32 %0, 0" : "=v"(lz));
            LAS float* sbeta_v = sbeta + lz; LAS float* sG_v = sG + lz; LAS float* Am_v = Am + lz;
            float X[64];
            if (tid < 128) {
#pragma unroll
                for (int r = 0; r < 64; ++r) X[r] = vs[r * 128 + tid] * sbeta_v[r];
            } else {
#pragma unroll
                for (int r = 0; r < 64; ++r) X[r] = ks[r * 128 + (tid - 128)] * sbeta_v[r] * __expf(sG_v[r]);
            }
#pragma unroll
            for (int r = 1; r < 64; ++r) {
                float a0 = 0.f, a1 = 0.f, a2 = 0.f, a3 = 0.f;
#pragma unroll
                for (int s4 = 0; s4 < (r + 3) / 4; ++s4) { const f32x4 av = *(LAS f32x4*)(Am_v + r * 64 + 4 * s4);
                    a0 += av[0] * X[4 * s4]; a1 += av[1] * X[4 * s4 + 1]; a2 += av[2] * X[4 * s4 + 2]; a3 += av[3] * X[4 * s4 + 3]; }
                X[r] -= (a0 + a1) + (a2 + a3);
            }
            if (tid < 128) {
                bf16_t* vs_ = proj + (size_t)t0 * PLD + 2048 + h * 128 + (size_t)((tid >> 4) * 8) * PLD + (tid & 15) * 4;
#pragma unroll
                for (int rp = 0; rp < 8; ++rp) {
#pragma unroll
                    for (int hf = 0; hf < 2; ++hf) { const int c0 = 16 * (rp >> 1) + 4 * (2 * (rp & 1) + hf); u32x2 w; w.x = cvt_pk_bf16(X[c0], X[c0 + 1]); w.y = cvt_pk_bf16(X[c0 + 2], X[c0 + 3]);
                        if (!dry) *(u32x2*)(vs_ + hf * 64) = w; }
                    vs_ += PLD; asm volatile("" : "+v"(vs_)); }
            } else {
                const int c_ = tid - 128;
                bf16_t* wp = wbuf + (size_t)t0 * D + h * 128 + (size_t)((c_ >> 5) * 4 + ((c_ >> 3) & 3)) * D + (c_ & 7);
#pragma unroll
                for (int rt_ = 0; rt_ < 4; ++rt_) {
#pragma unroll
                    for (int fr_ = 0; fr_ < 16; ++fr_) wp[fr_ * 8] = (bf16_t)(cvt_pk_bf16(X[16 * rt_ + fr_], 0.f) & 0xffffu);
                    wp += 16 * D; asm volatile("" : "+v"(wp)); }
            }
        } else {
            const int w4 = wave - 4, fr = lane & 15, fq = lane >> 4, tt = tid - 256;
            bf16_t* qk_o = qkd + (size_t)item * 4096;
#pragma unroll
            for (int ct = 0; ct < 4; ++ct) {
                f32x4 acc = (f32x4){0.f, 0.f, 0.f, 0.f};
#pragma unroll
                for (int kk = 0; kk < 4; ++kk) { const bf16x8 av = *(LAS bf16x8*)(qb + (16 * w4 + fr) * 136 + 32 * kk + 8 * fq), bv = *(LAS bf16x8*)(kb + (16 * ct + fr) * 136 + 32 * kk + 8 * fq);
                    acc = __builtin_amdgcn_mfma_f32_16x16x32_bf16(av, bv, acc, 0, 0, 0); }
                const int s = 16 * ct + fr; const float Gs = sG[s];
#pragma unroll
                for (int rg = 0; rg < 4; ++rg) { const int r = 16 * w4 + 4 * fq + rg; const float v = (s <= r) ? acc[rg] * __expf(sG[r] - Gs) : 0.f;
                    qk_o[((r >> 4) * 2 + (s >> 5)) * 512 + (((s >> 3) & 3) * 16 + (r & 15)) * 8 + (s & 7)] = (bf16_t)(cvt_pk_bf16(v, 0.f) & 0xffffu); }
            }
#pragma unroll 1
            for (int i = tt; i < 64 * 16; i += 256) { const int blk_ = i >> 6, ln_ = i & 63, r = 16 * (blk_ >> 2) + (ln_ & 15), c8 = 32 * (blk_ & 3) + 8 * (ln_ >> 4); const float e = __expf(sG[r]);
                const f32x4 v0 = *(LAS f32x4*)(qs + r * 128 + c8) * e, v1 = *(LAS f32x4*)(qs + r * 128 + c8 + 4) * e;
                u32x4 w; w.x = cvt_pk_bf16(v0[0], v0[1]); w.y = cvt_pk_bf16(v0[2], v0[3]); w.z = cvt_pk_bf16(v1[0], v1[1]); w.w = cvt_pk_bf16(v1[2], v1[3]);
                if (!dry) *(u32x4*)(proj + (size_t)t0 * PLD + h * 128 + (size_t)((((r >> 4) * 4 + (c8 >> 5)) * 4) + ((c8 >> 3) & 3)) * PLD + (r & 15) * 8) = w; }
            const float Glast = sG[63];
#pragma unroll 1
            for (int i = tt; i < 128 * 8; i += 256) { const int blk_ = i >> 6, ln_ = i & 63, dk = 16 * (blk_ >> 1) + (ln_ & 15), c8 = 32 * (blk_ & 1) + 8 * (ln_ >> 4); float v[8];
#pragma unroll
                for (int j = 0; j < 8; ++j) v[j] = ks[(c8 + j) * 128 + dk] * __expf(Glast - sG[c8 + j]);
                u32x4 w; w.x = cvt_pk_bf16(v[0], v[1]); w.y = cvt_pk_bf16(v[2], v[3]); w.z = cvt_pk_bf16(v[4], v[5]); w.w = cvt_pk_bf16(v[6], v[7]);
                if (!dry) *(u32x4*)(proj + (size_t)t0 * PLD + 1024 + h * 128 + (size_t)((((dk >> 4) * 2 + (c8 >> 5)) * 4) + ((c8 >> 3) & 3)) * PLD + (dk & 15) * 8) = w; }
        }
        __syncthreads();
    }
}

constexpr int SB_ST = 0, SB_VT = 16 * 136 * 2;
DI void gdn_stage_b(const Args& a, int L, LAS unsigned char* lds, int wave, int lane) {
    const bf16_t* proj = (const bf16_t*)(a.ws + WS_R1);
    const bf16_t* wbuf = (const bf16_t*)(a.ws + ((L & 1) ? WS_HB1 : WS_HB0));
    const bf16_t* qkd = (const bf16_t*)(a.ws + ((L & 1) ? WS_HB0 : WS_HB1));
    const float* GL = (const float*)(a.ws + WS_GL);
    bf16_t* og = (bf16_t*)(a.ws + WS_OG);
    LAS bf16_t* sT = (LAS bf16_t*)(lds + SB_ST); LAS bf16_t* vT = (LAS bf16_t*)(lds + SB_VT);
    const int fr = lane & 15, fq = lane >> 4, rt = wave & 3;
    for (int item = blockIdx.x; item < NB * NH * 8; item += gridDim.x) {
        const int xcd_ = item & 7, idx_ = item >> 3;
        const int sl = idx_ & 7, bh = xcd_ * 4 + (idx_ >> 3), h = bh & 7, b = bh >> 3, dv0 = sl * 16;
        f32x4 Sacc = (f32x4){0.f, 0.f, 0.f, 0.f};
        __syncthreads();
        { unsigned zz; asm volatile("v_mov_b32 %0, 0" : "=v"(zz)); u32x2 z2; z2.x = zz; z2.y = zz; *(LAS u32x2*)(sT + fr * 136 + 16 * wave + 4 * fq) = z2; }
        __syncthreads();
        const size_t strideA = (wave < 4) ? (size_t)128 * D * 2 : (size_t)128 * PLD * 2, strideX = (wave < 4) ? (size_t)128 * PLD * 2 : (size_t)2 * 8192, stepA = strideA / 2, stepX = strideX / 2;
        const size_t kstepA = (wave < 4) ? (size_t)4 * D * 2 : (size_t)4 * PLD * 2;
        GCP pa0 = (wave < 4) ? (GCP)wbuf + ((size_t)(b * SEQ + 16 * rt + fq) * D + h * 128 + 8 * fr) * 2 : (GCP)proj + ((size_t)(b * SEQ + 16 * rt + fq) * PLD + h * 128 + 8 * fr) * 2;
        GCP pk0 = (GCP)proj + ((size_t)(b * SEQ) * PLD + 1024 + h * 128 + (size_t)(8 * wave + fq) * PLD + 8 * fr) * 2;
        GCP px0 = (wave < 4) ? (GCP)proj + ((size_t)(b * SEQ) * PLD + 2048 + h * 128 + (size_t)((sl * 4 + rt) * 2 + (lane >> 5)) * PLD + (lane & 31) * 4) * 2
                                     : (GCP)qkd + ((size_t)(bh * 64) * 4096 + rt * 1024 + lane * 8) * 2;
        const size_t kstepX = (wave < 4) ? (size_t)16 : (size_t)1024;
        GCP paA = pa0, paB = pa0 + stepA, paC = pa0 + 2 * stepA, paD = pa0 + 3 * stepA;
        GCP pkA = pk0, pkB = pk0 + (size_t)64 * PLD * 2, pkC = pk0 + 2 * 524288, pkD = pk0 + 3 * 524288;
        GCP pxA = px0, pxB = px0 + stepX, pxC = px0 + 2 * stepX, pxD = px0 + 3 * stepX;
#define SB_LOAD(n_, PA, PK, PX, AF, UW, QF, KF, GLV) do { \
            _Pragma("unroll") for (int kk = 0; kk < 4; ++kk) AF[kk] = *(GAS const bf16x8*)(PA + kk * kstepA); \
            KF[0] = *(GAS const bf16x8*)(PK); KF[1] = *(GAS const bf16x8*)(PK + (size_t)4 * PLD * 2); \
            QF[0] = *(GAS const bf16x8*)(PX); QF[1] = *(GAS const bf16x8*)(PX + kstepX);     \
            GLV = GL[bh * 64 + (n_)]; \
            PA += strideA; PK += (size_t)128 * PLD * 2; PX += strideX; asm volatile("" : "+v"(PA), "+v"(PK), "+v"(PX)); } while (0)
#define SB_BODY(n_, AF, UW, QF, KF, GLV) do { const int t0_ = b * SEQ + (n_) * 64; \
            f32x4 acc = (f32x4){0.f, 0.f, 0.f, 0.f}; \
            _Pragma("unroll") for (int kk = 0; kk < 4; ++kk) { const bf16x8 bv = *(LAS bf16x8*)(sT + fr * 136 + 32 * kk + 8 * fq); acc = __builtin_amdgcn_mfma_f32_16x16x32_bf16(AF[kk], bv, acc, 0, 0, 0); } \
            if (wave < 4) { \
                const u32x4 uq_ = __builtin_bit_cast(u32x4, QF[0]); f32x4 vn; vn[0] = bflo(uq_.x) - acc[0]; vn[1] = bfhi(uq_.x) - acc[1]; vn[2] = bflo(uq_.y) - acc[2]; vn[3] = bfhi(uq_.y) - acc[3]; \
                u32x2 w_; w_.x = cvt_pk_bf16(vn[0], vn[1]); w_.y = cvt_pk_bf16(vn[2], vn[3]); \
                *(LAS u32x2*)(vT + fr * 72 + 16 * rt + 4 * fq) = w_; } \
            __syncthreads(); \
            const bf16x8 vb0 = *(LAS bf16x8*)(vT + fr * 72 + 8 * fq), vb1 = *(LAS bf16x8*)(vT + fr * 72 + 32 + 8 * fq); \
            if (wave >= 4) { \
                acc = __builtin_amdgcn_mfma_f32_16x16x32_bf16(QF[0], vb0, acc, 0, 0, 0); \
                acc = __builtin_amdgcn_mfma_f32_16x16x32_bf16(QF[1], vb1, acc, 0, 0, 0); \
                bf16_t* op = og + (size_t)(t0_ + 16 * rt + 4 * fq) * D + h * 128 + dv0 + fr; \
                _Pragma("unroll") for (int rg = 0; rg < 4; ++rg) op[(size_t)rg * D] = (bf16_t)(cvt_pk_bf16(acc[rg], 0.f) & 0xffffu); } \
            Sacc = Sacc * GLV; \
            Sacc = __builtin_amdgcn_mfma_f32_16x16x32_bf16(KF[0], vb0, Sacc, 0, 0, 0); \
            Sacc = __builtin_amdgcn_mfma_f32_16x16x32_bf16(KF[1], vb1, Sacc, 0, 0, 0); \
            { u32x2 w_; w_.x = cvt_pk_bf16(Sacc[0], Sacc[1]); w_.y = cvt_pk_bf16(Sacc[2], Sacc[3]); *(LAS u32x2*)(sT + fr * 136 + 16 * wave + 4 * fq) = w_; } \
            __syncthreads(); } while (0)
        bf16x8 afA[4], afB[4], qfA[2], qfB[2], kfA[2], kfB[2]; u32x2 uwA = (u32x2){0u, 0u}, uwB = uwA; float glA, glB;
        (void)uwA; (void)uwB; (void)paC; (void)paD; (void)pkC; (void)pkD; (void)pxC; (void)pxD;
        SB_LOAD(0, paA, pkA, pxA, afA, uwA, qfA, kfA, glA);
        for (int n = 0; n < 64; n += 2) {
            SB_LOAD(n + 1, paB, pkB, pxB, afB, uwB, qfB, kfB, glB);
            SB_BODY(n, afA, uwA, qfA, kfA, glA);
            if (n + 2 < 64) SB_LOAD(n + 2, paA, pkA, pxA, afA, uwA, qfA, kfA, glA);
            SB_BODY(n + 1, afB, uwB, qfB, kfB, glB);
        }
#undef SB_LOAD
#undef SB_BODY
    }
}

DI void gdn_stage_c(const Args& a, int L, int gw, int NGW, int lane) {
    bf16_t* og = (bf16_t*)(a.ws + WS_OG); const bf16_t* proj = (const bf16_t*)(a.ws + WS_R1);
    const float* ng = a.in[I_GNORM] + L * HD + (lane & 7) * 16;
    float gn[16];
#pragma unroll
    for (int j = 0; j < 16; ++j) gn[j] = ng[j];
    for (int m = gw; m < T; m += NGW) {
        u32x4* op = (u32x4*)(og + (size_t)m * D + lane * 16); const u32x4* gp = (const u32x4*)(proj + (size_t)m * PLD + 3072 + lane * 16);
        const u32x4 o0 = op[0], o1 = op[1], g0 = gp[0], g1 = gp[1];
        float o[16], g[16];
#pragma unroll
        for (int j = 0; j < 4; ++j) { o[2 * j] = bflo(o0[j]); o[2 * j + 1] = bfhi(o0[j]); o[8 + 2 * j] = bflo(o1[j]); o[8 + 2 * j + 1] = bfhi(o1[j]);
            g[2 * j] = bflo(g0[j]); g[2 * j + 1] = bfhi(g0[j]); g[8 + 2 * j] = bflo(g1[j]); g[8 + 2 * j + 1] = bfhi(g1[j]); }
        float s = 0.f;
#pragma unroll
        for (int j = 0; j < 16; ++j) s += o[j] * o[j];
        s += __shfl_xor(s, 1); s += __shfl_xor(s, 2); s += __shfl_xor(s, 4);
        const float r = rsqrtf(s * (1.0f / HD) + EPS);
        float y[16];
#pragma unroll
        for (int j = 0; j < 16; ++j) y[j] = o[j] * r * gn[j] * siluf_(g[j]);
        u32x4 w0, w1;
#pragma unroll
        for (int j = 0; j < 4; ++j) { w0[j] = cvt_pk_bf16(y[2 * j], y[2 * j + 1]); w1[j] = cvt_pk_bf16(y[8 + 2 * j], y[8 + 2 * j + 1]); }
        op[0] = w0; op[1] = w1;
    }
}

DI void sb_attention(const Args& a, int j2, int gw, int NGW, int lane) {
    const bf16_t* qo = (const bf16_t*)(a.ws + WS_OG); bf16_t* ob = (bf16_t*)(a.ws + WS_R1); const bf16_t* kbuf = (const bf16_t*)(a.ws + WS_KB); const bf16_t* vt = (const bf16_t*)(a.ws + WS_VT);
    const float* ssq = (const float*)(a.ws + WS_SSQ) + (size_t)j2 * NB * NH * SEQ; const float* ssk = (const float*)(a.ws + WS_SSK);
    const float* qn = a.in[I_SQNORM] + j2 * HD; const float* kn = a.in[I_KNORM];
    const int tl = lane & 31, hh = lane >> 5;
    for (int item = gw; item < NB * NH * (SEQ / 32); item += NGW) {
        const int qt = (SEQ / 32 - 1) - (item & 127), bh = item >> 7, h = bh & 7, b = bh >> 3, t0 = qt * 32;
        const size_t qrow = (size_t)(b * SEQ + t0 + tl) * D + h * 128;
        bf16x8 qf[8];
        {
            const float rq = rsqrtf((float)((const unsigned*)ssq)[(size_t)bh * SEQ + t0 + tl] * (SH_INV / HD) + EPS) * 0.08838834764831845f;
#pragma unroll
            for (int ks = 0; ks < 8; ++ks) { const u32x4 raw = *(const u32x4*)(qo + qrow + 16 * ks + 8 * hh);
                const f32x4 g0 = *(const f32x4*)(qn + 16 * ks + 8 * hh) * *(const f32x4*)(kn + 16 * ks + 8 * hh), g1 = *(const f32x4*)(qn + 16 * ks + 8 * hh + 4) * *(const f32x4*)(kn + 16 * ks + 8 * hh + 4);
                u32x4 w; w.x = cvt_pk_bf16(bflo(raw.x) * rq * g0[0], bfhi(raw.x) * rq * g0[1]); w.y = cvt_pk_bf16(bflo(raw.y) * rq * g0[2], bfhi(raw.y) * rq * g0[3]);
                w.z = cvt_pk_bf16(bflo(raw.z) * rq * g1[0], bfhi(raw.z) * rq * g1[1]); w.w = cvt_pk_bf16(bflo(raw.w) * rq * g1[2], bfhi(raw.w) * rq * g1[3]);
                qf[ks] = __builtin_bit_cast(bf16x8, w); }
        }
        f32x16 o[4];
#pragma unroll
        for (int dt = 0; dt < 4; ++dt)
#pragma unroll
            for (int i = 0; i < 16; ++i) o[dt][i] = 0.f;
        float carry = 0.f;
        bf16x8 kf[8];
        { const bf16_t* kp = kbuf + ((size_t)(bh * (SEQ / 32) + qt) * 8) * 512 + lane * 8;
#pragma unroll
          for (int ks = 0; ks < 8; ++ks) kf[ks] = *(const bf16x8*)(kp + 512 * ks); }
        for (int kt = qt; kt >= 0; --kt) {
            const int s0 = kt * 32;
            f32x16 z;
#pragma unroll
            for (int i = 0; i < 16; ++i) z[i] = 0.f;
#pragma unroll
            for (int ks = 0; ks < 8; ++ks) z = __builtin_amdgcn_mfma_f32_32x32x16_bf16(kf[ks], qf[ks], z, 0, 0, 0);
            if (kt > 0) {
                const bf16_t* kp = kbuf + ((size_t)(bh * (SEQ / 32) + kt - 1) * 8) * 512 + lane * 8;
#pragma unroll
                for (int ks = 0; ks < 8; ++ks) kf[ks] = *(const bf16x8*)(kp + 512 * ks);
            }
            bf16x8 vf[4][2];
            const bf16_t* vp = vt + ((size_t)(bh * (SEQ / 32) + kt) * 8) * 512 + lane * 8;
#define ATT_VLOAD(dt) do { _Pragma("unroll") for (int kv = 0; kv < 2; ++kv) vf[dt][kv] = *(const bf16x8*)(vp + ((dt) * 2 + kv) * 512); } while (0)
            ATT_VLOAD(0); ATT_VLOAD(1);
            float ln[16], zz[16];
            const bool diag = (kt == qt);
#pragma unroll
            for (int g = 0; g < 4; ++g) { const u32x4 k4 = *(const u32x4*)(ssk + (size_t)bh * SEQ + s0 + 8 * g + 4 * hh);
#pragma unroll
                for (int i = 0; i < 4; ++i) { const float rk = rsqrtf((float)k4[i] * (SH_INV / HD) + EPS); const float zv = z[4 * g + i] * rk;
                    const bool valid = !diag || (8 * g + 4 * hh + i < tl);
                    zz[4 * g + i] = zv; ln[4 * g + i] = valid ? -softplusf_(zv) : 0.f; } }
            float gs[4], og_[4];
#pragma unroll
            for (int g = 0; g < 4; ++g) { gs[g] = (ln[4 * g] + ln[4 * g + 1]) + (ln[4 * g + 2] + ln[4 * g + 3]); og_[g] = __shfl_xor(gs[g], 32); }
            float after[4]; float run = carry;
#pragma unroll
            for (int g = 3; g >= 0; --g) { after[g] = run + (hh == 0 ? og_[g] : 0.f); run += gs[g] + og_[g]; }
            float wv[16];
#pragma unroll
            for (int g = 0; g < 4; ++g) { float suf = after[g];
#pragma unroll
                for (int i = 3; i >= 0; --i) { const int e = 4 * g + i; const bool valid = !diag || (8 * g + 4 * hh + i < tl);
                    wv[e] = valid ? __expf(zz[e] + ln[e] + suf) : 0.f; suf += ln[e]; } }
            carry = run;
            ATT_VLOAD(2); ATT_VLOAD(3);
#undef ATT_VLOAD
#pragma unroll
            for (int kv = 0; kv < 2; ++kv) { u32x4 p; p.x = cvt_pk_bf16(wv[8 * kv], wv[8 * kv + 1]); p.y = cvt_pk_bf16(wv[8 * kv + 2], wv[8 * kv + 3]); p.z = cvt_pk_bf16(wv[8 * kv + 4], wv[8 * kv + 5]); p.w = cvt_pk_bf16(wv[8 * kv + 6], wv[8 * kv + 7]);
                const bf16x8 pb = __builtin_bit_cast(bf16x8, p);
#pragma unroll
                for (int dt = 0; dt < 4; ++dt) o[dt] = __builtin_amdgcn_mfma_f32_32x32x16_bf16(vf[dt][kv], pb, o[dt], 0, 0, 0); }
            if (__ballot(carry >= -110.0f) == 0ull) break;
        }
#pragma unroll
        for (int dt = 0; dt < 4; ++dt)
#pragma unroll
            for (int g = 0; g < 4; ++g) { u32x2 w; w.x = cvt_pk_bf16(o[dt][4 * g], o[dt][4 * g + 1]); w.y = cvt_pk_bf16(o[dt][4 * g + 2], o[dt][4 * g + 3]);
                *(u32x2*)(ob + qrow + 32 * dt + 8 * g + 4 * hh) = w; }
    }
}

#define XB_TMO      128
#define XB_XCNT(j)  (256  + 64 * (j))
#define XB_XSUB(j)  (1280 + 64 * (j))
#define XB_XGEN(j)  (2304 + 64 * (j))
#define XB_TOP      3328
#define XB_TOPGEN   3392
#define XCD_BAR_WORDS 3456
#define XB_SPIN_CAP (1u << 18)
DI unsigned xb_ld(unsigned* p)              { return __hip_atomic_load(p, __ATOMIC_RELAXED, __HIP_MEMORY_SCOPE_AGENT); }
DI unsigned xb_add(unsigned* p, unsigned v) { return __hip_atomic_fetch_add(p, v, __ATOMIC_RELAXED, __HIP_MEMORY_SCOPE_AGENT); }
DI unsigned xb_xcc_id() { return (unsigned)__builtin_amdgcn_s_getreg((3 << 11) | 20) & 0xFu; }
#define XB_SPIN(cond, bar) do { unsigned _sp = 0; while (cond) { __builtin_amdgcn_s_sleep(1); \
    if ((++_sp & 255u) == 0u) { if (xb_ld(&(bar)[XB_TMO])) break; if (_sp > XB_SPIN_CAP) { atomicAdd(&(bar)[XB_TMO], 1u); break; } } } } while (0)
struct XcdBarrier { unsigned* bar; unsigned x; volatile LAS unsigned* st; };
DI XcdBarrier xcd_barrier_post(unsigned* bar, volatile LAS unsigned* st) {
    XcdBarrier b; b.bar = bar; b.x = xb_xcc_id(); b.st = st;
    if (threadIdx.x == 0) (void)xb_add(&bar[XB_XCNT(b.x)], 1u);
    return b;
}
DI void xcd_barrier_complete(unsigned* bar, unsigned x, unsigned& nloc, unsigned& nx) {
    const unsigned G = gridDim.x * gridDim.y * gridDim.z;
    unsigned sum, cnt, mine, sp = 0u;
    for (;;) {
        sum = 0u; cnt = 0u; mine = 0u;
#pragma unroll
        for (unsigned j = 0; j < 16; ++j) { const unsigned c = xb_ld(&bar[XB_XCNT(j)]); sum += c; cnt += (c > 0u) ? 1u : 0u; mine = (j == x) ? c : mine; }
        if (sum == G) break;
        __builtin_amdgcn_s_sleep(1);
        if ((++sp & 255u) == 0u) { if (xb_ld(&bar[XB_TMO])) break; if (sp > XB_SPIN_CAP) { atomicAdd(&bar[XB_TMO], 1u); break; } }
    }
    nloc = mine > 0u ? mine : 1u; nx = cnt > 0u ? cnt : 1u;
}
DI void xcd_barrier(const XcdBarrier& b) {
    asm volatile("s_waitcnt vmcnt(0)" ::: "memory");
    __syncthreads();
    if (threadIdx.x == 0) {
        unsigned* bar = b.bar;
        __builtin_amdgcn_s_waitcnt(0);
        unsigned nloc = b.st[0], nx = b.st[1];
        if (nloc == 0u) { xcd_barrier_complete(bar, b.x, nloc, nx); b.st[0] = nloc; b.st[1] = nx; }
        const unsigned old = xb_add(&bar[XB_XSUB(b.x)], 1u);
        const unsigned gen = old / nloc;
        if (old + 1u == (gen + 1u) * nloc) {
            __builtin_amdgcn_fence(__ATOMIC_RELEASE, "agent");
            asm volatile("s_waitcnt vmcnt(0)" ::: "memory");
            const unsigned og = xb_add(&bar[XB_TOP], 1u);
            const unsigned tg = og / nx;
            if (og + 1u == (tg + 1u) * nx) xb_add(&bar[XB_TOPGEN], 1u);
            else XB_SPIN(xb_ld(&bar[XB_TOPGEN]) == tg, bar);
            __builtin_amdgcn_fence(__ATOMIC_ACQUIRE, "agent");
            xb_add(&bar[XB_XGEN(b.x)], 1u);
            asm volatile("s_waitcnt vmcnt(0)" ::: "memory");
        } else {
            XB_SPIN(xb_ld(&bar[XB_XGEN(b.x)]) == gen, bar);
            __builtin_amdgcn_fence(__ATOMIC_ACQUIRE, "agent");
            asm volatile("s_waitcnt vmcnt(0)" ::: "memory");
        }
    }
    __syncthreads();
}

enum Kind { K_PREP = 0, K_GIN, K_STA, K_STB, K_STC, K_OUT, K_FUP, K_FDN, K_PP, K_GATE, K_SINQ, K_SINV, K_ATT };
constexpr int NPHASES = 1 + 9 * 2 + 9 + 7;
DI void decode_phase(int ph, int& L, int& kind, int& sub, int& sync) {
    sub = 0; sync = 1;
    if (ph == 0) { L = 0; kind = K_PREP; sync = 0; return; }
    ph -= 1;
    if (ph < 18) { L = ph / 9; const int st = ph % 9;
        kind = st == 0 ? K_GIN : st == 1 ? K_STA : st == 2 ? K_STB : st == 3 ? K_STC : st == 4 ? K_OUT : st == 5 ? K_PP : st == 6 ? K_FUP : st == 7 ? K_FDN : K_GATE;
        if (st == 6) sync = 0; return; }
    ph -= 18;
    int st;
    if (ph < 9) { L = 2; st = ph; if (st == 1) { kind = K_SINQ; sub = 1; sync = 0; return; } if (st == 2) { kind = K_SINV; sync = 0; return; } if (st > 2) st -= 2; }
    else { L = 3; st = ph - 9; }
    kind = st == 0 ? K_SINQ : st == 1 ? K_ATT : st == 2 ? K_OUT : st == 3 ? K_PP : st == 4 ? K_FUP : st == 5 ? K_FDN : K_GATE;
    if (st == 4) sync = 0;
}

__global__ void __launch_bounds__(NTHR, 2) fwd_kernel(Args a0) {
    extern __shared__ __attribute__((aligned(16))) unsigned char lds_raw[];
    LAS unsigned char* lds = (LAS unsigned char*)lds_raw;
    XcdBarrier bar; bar.bar = (unsigned*)(a0.ws + WS_BAR); bar.x = 0; bar.st = (volatile LAS unsigned*)(lds + LDS_BYTES - 16);
    if (a0.coop) {
        if (threadIdx.x < 4) ((LAS unsigned*)(lds + LDS_BYTES - 16))[threadIdx.x] = 0u;
        __syncthreads();
        bar = xcd_barrier_post((unsigned*)(a0.ws + WS_BAR), (volatile LAS unsigned*)(lds + LDS_BYTES - 16));
    }
    for (int ph = a0.ph_lo; ph < a0.ph_hi; ++ph) {
        int L, kind, sub, sync; decode_phase(ph, L, kind, sub, sync);
        if (ph > a0.ph_lo && a0.coop && sync) { if (a0.coop == 2) cg::this_grid().sync(); else xcd_barrier(bar); }
#ifdef XSYNC
        if (ph == 1) { for (int i = 0; i < XSYNC; ++i) xcd_barrier(bar); }
#endif
#ifdef REP_KIND
        for (int rep = 0; rep < ((kind == REP_KIND) ? 2 : 1); ++rep) {
        if (rep) xcd_barrier(bar);
#endif
#ifdef ONLY_KIND
        if (kind != ONLY_KIND) continue;
#endif
        size_t zo; asm volatile("s_mov_b64 %0, 0" : "=s"(zo));
        int tid = threadIdx.x; asm volatile("" : "+v"(tid));
        const int lane = tid & 63, wave = __builtin_amdgcn_readfirstlane(tid >> 6);
        const int G = gridDim.x, gw = blockIdx.x * NWAVES + wave, NGW = G * NWAVES, gt = gw * 64 + lane, NGT = NGW * 64;
        Args a;
#pragma unroll
        for (int i = 0; i < 21; ++i) a.in[i] = a0.in[i] + zo;
        a.out = a0.out + zo; a.ws = a0.ws + zo; a.ph_lo = 0; a.ph_hi = 0; a.coop = 0; a.pad = 0;
        unsigned char* ws = a.ws;
        float* SS = (float*)(ws + WS_SS);
        bf16_t* hb_cur = (bf16_t*)(ws + ((L & 1) ? WS_HB1 : WS_HB0)); bf16_t* hb_oth = (bf16_t*)(ws + ((L & 1) ? WS_HB0 : WS_HB1));
        pg8::StaticOrder S;
        switch (kind) {
        case K_PREP: phase_prep(a, lds, gw, NGW, wave, lane); break;
        case K_GIN: {
            pg8::Gemm g{hb_cur, (const bf16_t*)(ws + WS_WIN) + (size_t)L * 4096 * D, T, 4096, D}; S.init(T, 4096, G, blockIdx.x);
            pg8::EpiBf16<0> E{(bf16_t*)(ws + WS_R1), PLD, SS + 3 * L * T, (bf16_t*)(ws + WS_HALO), nullptr, false};
            pg8::gemm_phase(lds, g, S, E, tid);
            ab_gemm(hb_cur, (const bf16_t*)(ws + WS_WAB) + (size_t)L * 16 * D, SS + 3 * L * T, (float*)(ws + WS_AB), gw, NGW, lane);
        } break;
#if defined(REP_KIND)
        case K_STA: gdn_stage_a(a, L, lds, tid, wave, lane, (REP_KIND == K_STA) && rep == 0); break;
#else
        case K_STA: gdn_stage_a(a, L, lds, tid, wave, lane, false); break;
#endif
        case K_STB: gdn_stage_b(a, L, lds, wave, lane); break;
        case K_STC: gdn_stage_c(a, L, gw, NGW, lane); break;
        case K_OUT: {
            const bf16_t* W = (L < 2) ? (const bf16_t*)(ws + WS_WO) + (size_t)L * D * D : (const bf16_t*)(ws + WS_SWO) + (size_t)(L - 2) * D * D;
            pg8::Gemm g{(const bf16_t*)(ws + (L < 2 ? WS_OG : WS_R1)), W, T, D, D}; S.init(T, D, G, blockIdx.x);
            pg8::EpiRes<false> E{a.out, hb_oth, SS + (3 * L + 1) * T, nullptr, nullptr, L == 0 ? a.in[I_X] : a.out, hb_cur, L == 2, L == 3};
            pg8::gemm_phase(lds, g, S, E, tid);
            convert_p(a, L, gt, NGT);
        } break;
        case K_FUP: {
            pg8::Gemm g{hb_oth, (const bf16_t*)(ws + WS_W1) + (size_t)L * 5632 * D, T, 5632, D}; S.init(T, 5632, G, blockIdx.x);
#if defined(REP_KIND)
            pg8::EpiSwiglu E{(bf16_t*)(ws + WS_R1), SS + (3 * L + 1) * T, (REP_KIND == K_FUP) && rep == 0};
#else
            pg8::EpiSwiglu E{(bf16_t*)(ws + WS_R1), SS + (3 * L + 1) * T, false};
#endif
            pg8::gemm_phase(lds, g, S, E, tid);
        } break;
        case K_FDN: {
            pg8::Gemm g{(const bf16_t*)(ws + WS_R1), (const bf16_t*)(ws + WS_W2) + (size_t)L * D * FF, T, D, FF}; S.init(T, D, G, blockIdx.x);
            pg8::EpiRes<false> E{a.out, hb_cur, SS + (3 * L + 2) * T, nullptr, nullptr, a.out, hb_oth, L != 3, L == 3};
            pg8::gemm_phase(lds, g, S, E, tid);
        } break;
        case K_PP: {
            pg8::Gemm g2{(const bf16_t*)(ws + WS_PB), (const bf16_t*)(ws + WS_WPROJ) + (size_t)L * D * PLE, T, D, PLE};
            if (G == 256) { if (blockIdx.x < 128) break; S.init(T, D, 128, blockIdx.x - 128); } else S.init(T, D, G, blockIdx.x);
            pg8::EpiBf16<1> E2{(bf16_t*)(ws + WS_OG), D, nullptr, nullptr, nullptr, false};
            pg8::gemm_phase(lds, g2, S, E2, tid);
        } break;
        case K_GATE: {
            pg8::Gemm g{hb_cur, (const bf16_t*)(ws + WS_WGATE) + (size_t)L * D * D, T, D, D}; S.init(T, D, G, blockIdx.x);
            pg8::EpiRes<true> E{a.out, hb_oth, SS + (3 * L + 3) * T, SS + (3 * L + 2) * T, (const bf16_t*)(ws + WS_OG), a.out, hb_cur, L != 3, L == 0 || L >= 2};
            pg8::gemm_phase(lds, g, S, E, tid);
        } break;
        case K_SINQ: {
            pg8::Gemm g{hb_cur, sub == 0 ? (const bf16_t*)(ws + WS_WQ) + (size_t)(L - 2) * D * D : (const bf16_t*)(ws + WS_WK), T, D, D}; S.init(T, D, G, blockIdx.x);
            pg8::EpiBf16<2> E{sub == 0 ? (bf16_t*)(ws + WS_OG) : (bf16_t*)(ws + WS_KB), D, SS + 3 * L * T, nullptr, sub == 0 ? (float*)(ws + WS_SSQ) + (size_t)(L - 2) * NB * NH * SEQ : (float*)(ws + WS_SSK), sub != 0};
            pg8::gemm_phase(lds, g, S, E, tid);
        } break;
        case K_SINV: {
            pg8::Gemm g{(const bf16_t*)(ws + WS_WV), hb_cur, D, T, D}; S.init(D, T, G, blockIdx.x);
            pg8::EpiVT E{(bf16_t*)(ws + WS_VT), SS + 3 * L * T};
            pg8::gemm_phase(lds, g, S, E, tid);
        } break;
        case K_ATT: sb_attention(a, L - 2, gw, NGW, lane); break;
        }
#ifdef REP_KIND
        }
#endif
    }
}

#ifdef DBG_OFF
__global__ void dbg_dump(const unsigned* src, float* dst, int n) { for (int i = blockIdx.x * blockDim.x + threadIdx.x; i < n; i += gridDim.x * blockDim.x) dst[i] = (float)(src[i] & 0xFFFFFFu); }
#endif
extern "C" void kernel_launch(void* const* d_in, const int* in_sizes, int n_in, void* d_out, int out_size, void* d_ws, size_t ws_size, hipStream_t stream) {
    static int grid = 0;
    if (grid == 0) {
        int dev = 0, cus = 0, per_cu = 0;
        hipGetDevice(&dev); hipDeviceGetAttribute(&cus, hipDeviceAttributeMultiprocessorCount, dev);
        hipFuncSetAttribute((const void*)fwd_kernel, hipFuncAttributeMaxDynamicSharedMemorySize, LDS_BYTES);
        hipOccupancyMaxActiveBlocksPerMultiprocessor(&per_cu, (const void*)fwd_kernel, NTHR, LDS_BYTES);
        (void)hipGetLastError();
        if (per_cu < 1) fprintf(stderr, "kernel_launch: occupancy query reports %d blocks per CU\n", per_cu);
        grid = cus > 0 ? cus : 256;
        if (ws_size < WS_END) fprintf(stderr, "kernel_launch: workspace too small: %zu < %zu\n", ws_size, (size_t)WS_END);
    }
    Args a{};
    for (int i = 0; i < 21; ++i) a.in[i] = (const float*)d_in[i];
    a.out = (float*)d_out; a.ws = (unsigned char*)d_ws;
#if ONE_LAUNCH
    hipMemsetAsync((char*)d_ws + WS_BAR, 0, XCD_BAR_WORDS * 4, stream);
    a.ph_lo = 0; a.ph_hi = NPHASES; a.coop = 1;
    void* args[] = {&a};
    hipError_t e = hipLaunchCooperativeKernel((const void*)fwd_kernel, dim3(grid), dim3(NTHR), args, LDS_BYTES, stream);
    if (e != hipSuccess) fprintf(stderr, "cooperative launch failed: %s (grid %d)\n", hipGetErrorString(e), grid);
#else
    for (int ph = 0; ph < NPHASES && ph < MAXPH; ++ph) {
        a.ph_lo = ph; a.ph_hi = ph + 1; a.coop = 0;
        hipLaunchKernelGGL(fwd_kernel, dim3(grid), dim3(NTHR), LDS_BYTES, stream, a);
    }
#ifdef DBG_OFF
    hipLaunchKernelGGL(dbg_dump, dim3(1024), dim3(256), 0, stream, (const unsigned*)((const char*)d_ws + (size_t)(DBG_OFF)), (float*)d_out, out_size);
#endif
#endif
}
```

```cpp
#include <hip/hip_runtime.h>
#include <hip/hip_cooperative_groups.h>
#include <cstdio>
namespace cg = cooperative_groups;

#ifndef ONE_LAUNCH
#define ONE_LAUNCH 1
#endif
#ifndef MAXPH
#define MAXPH 1000
#endif

#define LAS __attribute__((address_space(3)))
#define GAS __attribute__((address_space(1)))
typedef const GAS char* GCP;
#define DI __device__ __forceinline__
typedef unsigned short bf16_t;
typedef short bf16x8 __attribute__((ext_vector_type(8)));
typedef float f32x4 __attribute__((ext_vector_type(4)));
typedef float f32x16 __attribute__((ext_vector_type(16)));
typedef unsigned u32x4 __attribute__((ext_vector_type(4)));
typedef unsigned u32x2 __attribute__((ext_vector_type(2)));

constexpr int T = 16384, D = 1024, SEQ = 4096, NB = 4, NH = 8, HD = 128, FF = 2816, PLE = 256;
constexpr float EPS = 1e-6f;
constexpr int NWAVES = 8, NTHR = 512;
constexpr int PLD = 4096 + 64;
constexpr int LDS_BYTES = 155648;

constexpr size_t MiB = 1u << 20;
constexpr size_t WS_SS = 0;
constexpr size_t WS_SSQ = 1 * MiB;
constexpr size_t WS_SSK = 2 * MiB;
constexpr size_t WS_GL = 2 * MiB + 512 * 1024;
constexpr size_t WS_BAR = 2 * MiB + 768 * 1024;
constexpr size_t WS_AB = 3 * MiB;
constexpr size_t WS_WIN = 4 * MiB;
constexpr size_t WS_W1 = 20 * MiB;
constexpr size_t WS_W2 = 64 * MiB;
constexpr size_t WS_WO = 86 * MiB;
constexpr size_t WS_WK = 90 * MiB;
constexpr size_t WS_WV = 92 * MiB;
constexpr size_t WS_WQ = 94 * MiB;
constexpr size_t WS_SWO = 98 * MiB;
constexpr size_t WS_WPROJ = 102 * MiB;
constexpr size_t WS_WGATE = 104 * MiB;
constexpr size_t WS_WAB = 112 * MiB;
constexpr size_t WS_R1 = 113 * MiB;
constexpr size_t WS_KB = WS_R1 + 88 * MiB;
constexpr size_t WS_VT = 4 * MiB;
constexpr size_t WS_HB0 = 243 * MiB, WS_HB1 = 275 * MiB;
constexpr size_t WS_OG = 307 * MiB;
constexpr size_t WS_PB = WS_R1 + 120 * MiB;
constexpr size_t WS_HALO = WS_OG;
constexpr size_t WS_END = 339 * MiB;

typedef __bf16 bf16v2 __attribute__((ext_vector_type(2)));
DI unsigned cvt_pk_bf16(float lo, float hi) { bf16v2 v; v[0] = (__bf16)lo; v[1] = (__bf16)hi; return __builtin_bit_cast(unsigned, v); }
DI float bf2f(unsigned short b) { return __uint_as_float(((unsigned)b) << 16); }
DI float bflo(unsigned w) { return __uint_as_float(w << 16); }
DI float bfhi(unsigned w) { return __uint_as_float(w & 0xffff0000u); }
DI float sigmoidf_(float x) { return __builtin_amdgcn_rcpf(1.0f + __expf(-x)); }
DI float siluf_(float x) { return x * __builtin_amdgcn_rcpf(1.0f + __expf(-x)); }
DI float softplusf_(float x) { return fmaxf(x, 0.f) + 0.6931471805599453f * __builtin_amdgcn_logf(1.0f + __builtin_amdgcn_exp2f(-1.4426950408889634f * fabsf(x))); }
constexpr float SS_SCALE = 2048.0f, SS_INV = 1.0f / 2048.0f, SH_SCALE = 16384.0f, SH_INV = 1.0f / 16384.0f;
DI float ss_rstd(const float* ss, int row) { return rsqrtf((float)((const unsigned*)ss)[row] * (SS_INV / 1024.0f) + 1e-6f); }
DI void ss_add(float* ss, int row, float v) { atomicAdd((unsigned*)ss + row, (unsigned)(v * SS_SCALE + 0.5f)); }
DI float wave_sum(float v) {
#pragma unroll
    for (int o = 1; o < 64; o <<= 1) v += __shfl_xor(v, o);
    return v;
}

namespace pg8 {
constexpr int BM = 256, BK = 64, HALF = 128, HTB = HALF * BK * 2, STAGE_BYTES = 8 * HTB, NXCD = 8, WGM = 8;
DI int lds_byte(int r, int c) { const int st = (r >> 4) * 2 + (c >> 5), rr = r & 15, cc = c & 31, ob = rr * 64 + cc * 2; return st * 1024 + (ob ^ (((ob >> 9) & 1) << 5)); }
DI void stage_rc(int b, int& R, int& C) { const int st = b / 1024, sb = b % 1024, swz = sb ^ (((sb >> 9) & 1) << 5); R = (st >> 1) * 16 + swz / 64; C = (st & 1) * 32 + (swz % 64) / 2; }
DI int perm32(int rho) { const int n = rho >> 4, i = rho & 15; return 8 * (i >> 2) + 4 * n + (i & 3); }
struct Unit { int pm, pn; };
struct Gemm { const bf16_t* A; const bf16_t* Bt; int M, N, K; };
struct StaticOrder {
    int nM, nN, nwg, G, c;
    DI void init(int M, int N, int G_, int c_) { nM = M / BM; nN = N / BM; nwg = nM * nN; G = G_; c = c_; }
    DI bool next(int i, Unit& u) const {
        const long L = (long)i * G + c; if (L >= nwg) return false;
        int wgid = (int)L; { const int q = nwg / NXCD, r = nwg % NXCD, xcd = wgid % NXCD, off = wgid / NXCD; wgid = (xcd < r ? xcd * (q + 1) : r * (q + 1) + (xcd - r) * q) + off; }
        const int nig = WGM * nN, gid = wgid / nig, fm = gid * WGM, gsz = (nM - fm) < WGM ? (nM - fm) : WGM;
        u.pm = fm + ((wgid % nig) % gsz); u.pn = (wgid % nig) / gsz; return true;
    }
};

template <class Epi>
DI void gemm_phase(LAS unsigned char* lds, const Gemm g, const StaticOrder& S, const Epi& E, const int tid) {
    const int wid = __builtin_amdgcn_readfirstlane(tid >> 6), lane = tid & 63, wr = wid >> 2, wc = wid & 3, fr = lane & 15, fq = lane >> 4;
    const int K = g.K, nt = K / BK;
    unsigned voffA[2], voffB[2];
#pragma unroll
    for (int i = 0; i < 2; ++i) { int R, C; stage_rc(tid * 16 + i * 8192, R, C); const int Rb = Epi::PERM ? ((R & ~31) + perm32(R & 31)) : R;
        voffA[i] = (unsigned)(R * K + C) * 2u; voffB[i] = (unsigned)(Rb * K + C) * 2u; }
    const size_t kstep = (size_t)(BK * 2);
    const size_t hstep = (size_t)HALF * K * 2;
    const size_t tstep = 2 * hstep;
    const unsigned ldsw = (unsigned)wid * 1024u;
    const int aoff = lds_byte(wr * 64 + fr, fq * 8), boff = lds_byte(wc * 32 + fr, fq * 8);
#define PG8_SA(b, h) (((b) * 2 + (h)) * HTB)
#define PG8_SB(b, h) ((4 + (b) * 2 + (h)) * HTB)
#define PG8_STAGE(bufoff, gbase, voff) do { _Pragma("unroll") for (int _i = 0; _i < 2; ++_i) \
        __builtin_amdgcn_global_load_lds((const unsigned*)((const char*)(gbase) + (voff)[_i]), (LAS unsigned*)(lds + (bufoff) + ldsw + _i * 8192), 16, 0, 0); } while (0)
#define PG8_LDA(dst, b, h) do { _Pragma("unroll") for (int m = 0; m < 4; ++m) _Pragma("unroll") for (int k = 0; k < 2; ++k) dst[m][k] = *(const LAS bf16x8*)(lds + PG8_SA(b, h) + aoff + m * 2048 + k * 1024); } while (0)
#define PG8_LDB(dst, b, h) do { _Pragma("unroll") for (int n = 0; n < 2; ++n) _Pragma("unroll") for (int k = 0; k < 2; ++k) dst[n][k] = *(const LAS bf16x8*)(lds + PG8_SB(b, h) + boff + n * 2048 + k * 1024); } while (0)
#define PG8_MMA(ai, bj, At, Bt) do { __builtin_amdgcn_s_setprio(1); _Pragma("unroll") for (int m = 0; m < 4; ++m) _Pragma("unroll") for (int n = 0; n < 2; ++n) _Pragma("unroll") for (int k = 0; k < 2; ++k) \
        acc[ai][bj][m][n] = __builtin_amdgcn_mfma_f32_16x16x32_bf16(Bt[n][k], At[m][k], acc[ai][bj][m][n], 0, 0, 0); __builtin_amdgcn_s_setprio(0); } while (0)
#define PG8_WAIT_V(n) asm volatile("s_waitcnt vmcnt(" #n ")" ::: "memory")
#define PG8_WAIT_L(n) asm volatile("s_waitcnt lgkmcnt(" #n ")" ::: "memory")
#define PG8_BAR __builtin_amdgcn_s_barrier()
#define PG8_SCHED __builtin_amdgcn_sched_barrier(0)
    Unit cur, nxt; int ui = 0;
    if (!S.next(0, cur)) return;
    f32x4 acc[2][2][4][2];
#pragma unroll
    for (int a = 0; a < 2; ++a)
#pragma unroll
        for (int b = 0; b < 2; ++b)
#pragma unroll
            for (int m = 0; m < 4; ++m)
#pragma unroll
                for (int n = 0; n < 2; ++n) acc[a][b][m][n] = (f32x4){0.f, 0.f, 0.f, 0.f};
    bf16x8 At[4][2], B0[2][2], B1[2][2];
    const char* cA = (const char*)g.A + (size_t)cur.pm * tstep; const char* cB = (const char*)g.Bt + (size_t)cur.pn * tstep;
    PG8_STAGE(PG8_SB(0, 0), cB, voffB); PG8_STAGE(PG8_SA(0, 0), cA, voffA); PG8_STAGE(PG8_SB(0, 1), cB + hstep, voffB); PG8_STAGE(PG8_SA(0, 1), cA + hstep, voffA);
    if (wr == 1) PG8_BAR;
    PG8_WAIT_V(4); PG8_BAR;
    PG8_STAGE(PG8_SB(1, 0), cB + kstep, voffB); PG8_STAGE(PG8_SA(1, 0), cA + kstep, voffA); PG8_STAGE(PG8_SB(1, 1), cB + hstep + kstep, voffB);
    PG8_WAIT_V(6); PG8_BAR;
    for (;;) {
        const bool has_next = S.next(ui + 1, nxt);
        const char* nA = has_next ? (const char*)g.A + (size_t)nxt.pm * tstep : cA; const char* nB = has_next ? (const char*)g.Bt + (size_t)nxt.pn * tstep : cB;
        for (int t = 0; t < nt; t += 2) {
            const bool last = (t == nt - 2);
            const char* a1 = cA + (size_t)(t + 1) * kstep;
            const char* a2 = last ? nA : cA + (size_t)(t + 2) * kstep; const char* b2 = last ? nB : cB + (size_t)(t + 2) * kstep;
            const char* a3 = a2 + kstep; const char* b3 = b2 + kstep;
            PG8_LDB(B0, 0, 0); PG8_SCHED; PG8_LDA(At, 0, 0); PG8_STAGE(PG8_SA(1, 1), a1 + hstep, voffA);
            PG8_WAIT_L(8); PG8_BAR; PG8_WAIT_L(0); PG8_MMA(0, 0, At, B0); PG8_BAR; PG8_SCHED;
            PG8_LDB(B1, 0, 1); PG8_STAGE(PG8_SB(0, 0), b2, voffB);
            PG8_BAR; PG8_WAIT_L(0); PG8_MMA(0, 1, At, B1); PG8_BAR;
            PG8_LDA(At, 0, 1); PG8_STAGE(PG8_SA(0, 0), a2, voffA);
            PG8_BAR; PG8_WAIT_L(0); PG8_MMA(1, 0, At, B0); PG8_BAR; PG8_SCHED;
            PG8_STAGE(PG8_SB(0, 1), b2 + hstep, voffB);
            PG8_WAIT_V(6); PG8_BAR; PG8_MMA(1, 1, At, B1); PG8_BAR;
            PG8_LDB(B0, 1, 0); PG8_SCHED; PG8_LDA(At, 1, 0); PG8_STAGE(PG8_SA(0, 1), a2 + hstep, voffA);
            PG8_WAIT_L(8); PG8_BAR; PG8_WAIT_L(0); PG8_MMA(0, 0, At, B0); PG8_BAR; PG8_SCHED;
            PG8_LDB(B1, 1, 1); PG8_STAGE(PG8_SB(1, 0), b3, voffB);
            PG8_BAR; PG8_WAIT_L(0); PG8_MMA(0, 1, At, B1); PG8_BAR;
            PG8_LDA(At, 1, 1); PG8_STAGE(PG8_SA(1, 0), a3, voffA);
            PG8_BAR; PG8_WAIT_L(0); PG8_MMA(1, 0, At, B0); PG8_BAR; PG8_SCHED;
            PG8_STAGE(PG8_SB(1, 1), b3 + hstep, voffB);
            PG8_WAIT_V(6); PG8_BAR; PG8_MMA(1, 1, At, B1); PG8_BAR;
        }
        E(acc, cur, wr, wc, fr, fq);
        if (!has_next) break;
#pragma unroll
        for (int a = 0; a < 2; ++a)
#pragma unroll
            for (int b = 0; b < 2; ++b)
#pragma unroll
                for (int m = 0; m < 4; ++m)
#pragma unroll
                    for (int n = 0; n < 2; ++n) acc[a][b][m][n] = (f32x4){0.f, 0.f, 0.f, 0.f};
        cur = nxt; cA = nA; cB = nB; ++ui;
    }
    PG8_WAIT_V(0);
    if (wr == 0) PG8_BAR;
    PG8_BAR;
#undef PG8_SA
#undef PG8_SB
#undef PG8_STAGE
#undef PG8_LDA
#undef PG8_LDB
#undef PG8_MMA
#undef PG8_WAIT_V
#undef PG8_WAIT_L
#undef PG8_BAR
#undef PG8_SCHED
}

typedef const f32x4 (&AccT)[2][2][4][2];

template <int MODE> struct EpiBf16 {
    static constexpr bool PERM = true;
    bf16_t* O; int ldc; const float* ss; bf16_t* halo; float* ssh; bool kfrag;
    DI void operator()(AccT acc, const Unit& u, int wr, int wc, int fr, int fq) const {
        const int row0 = u.pm * BM + wr * 64 + fr, col0 = u.pn * BM + wc * 32 + 8 * fq;
        float rs[8];
#pragma unroll
        for (int i = 0; i < 8; ++i) rs[i] = (MODE == 1) ? 1.0f : ss_rstd(ss, row0 + (i >> 2) * HALF + (i & 3) * 16);
#pragma unroll
        for (int ai = 0; ai < 2; ++ai)
#pragma unroll
            for (int m = 0; m < 4; ++m) {
                const int row = row0 + ai * HALF + m * 16;
                const float r = rs[ai * 4 + m];
#pragma unroll
                for (int bj = 0; bj < 2; ++bj) {
                    const f32x4 v0 = acc[ai][bj][m][0] * r, v1 = acc[ai][bj][m][1] * r;
                    u32x4 w; w.x = cvt_pk_bf16(v0[0], v0[1]); w.y = cvt_pk_bf16(v0[2], v0[3]); w.z = cvt_pk_bf16(v1[0], v1[1]); w.w = cvt_pk_bf16(v1[2], v1[3]);
                    const int col = col0 + bj * HALF;
                    if (MODE == 2 && kfrag) { const int d0 = col & 127;
                        *(u32x4*)(O + ((size_t)((((row >> 12) * NH + (col >> 7)) * (SEQ / 32) + ((row & (SEQ - 1)) >> 5)) * 8 + (d0 >> 4)) * 512) + (((d0 >> 3) & 1) * 32 + (row & 31)) * 8) = w; }
                    else *(u32x4*)(O + (size_t)row * ldc + col) = w;
                    if (MODE == 0) { if ((row & 63) >= 61 && col < 3072) *(u32x4*)(halo + ((size_t)(row >> 6) * 3 + ((row & 63) - 61)) * 3072 + col) = w; }
                    if (MODE == 2) {
                        float sq = (v0[0] * v0[0] + v0[1] * v0[1]) + (v0[2] * v0[2] + v0[3] * v0[3]) + (v1[0] * v1[0] + v1[1] * v1[1]) + (v1[2] * v1[2] + v1[3] * v1[3]);
                        sq += __shfl_xor(sq, 16); sq += __shfl_xor(sq, 32);
                        if (fq == 0) atomicAdd((unsigned*)ssh + (size_t)((row >> 12) * NH + (2 * u.pn + bj)) * SEQ + (row & (SEQ - 1)), (unsigned)(sq * SH_SCALE + 0.5f));
                    }
                }
            }
    }
};
struct EpiVT {
    static constexpr bool PERM = true;
    bf16_t* O; const float* ss;
    DI void operator()(AccT acc, const Unit& u, int wr, int wc, int fr, int fq) const {
        const int row0 = u.pm * BM + wr * 64 + fr, col0 = u.pn * BM + wc * 32 + 8 * fq;
        f32x4 rs[2][2];
#pragma unroll
        for (int bj = 0; bj < 2; ++bj)
#pragma unroll
            for (int n = 0; n < 2; ++n) { const u32x4 s4 = *(const u32x4*)(ss + col0 + bj * HALF + 4 * n);
#pragma unroll
                for (int j = 0; j < 4; ++j) rs[bj][n][j] = rsqrtf((float)s4[j] * (SS_INV / D) + EPS); }
#pragma unroll
        for (int ai = 0; ai < 2; ++ai)
#pragma unroll
            for (int m = 0; m < 4; ++m) {
                const int row = row0 + ai * HALF + m * 16;
#pragma unroll
                for (int bj = 0; bj < 2; ++bj) {
                    const f32x4 v0 = acc[ai][bj][m][0] * rs[bj][0], v1 = acc[ai][bj][m][1] * rs[bj][1];
                    u32x4 w; w.x = cvt_pk_bf16(v0[0], v0[1]); w.y = cvt_pk_bf16(v0[2], v0[3]); w.z = cvt_pk_bf16(v1[0], v1[1]); w.w = cvt_pk_bf16(v1[2], v1[3]);
                    const int tok = col0 + bj * HALF, sl_ = tok & 31;
                    bf16_t* vb_ = O + ((size_t)(((((tok >> 12) * NH + (row >> 7)) * (SEQ / 32) + ((tok & (SEQ - 1)) >> 5)) * 4 + ((row & 127) >> 5)) * 2 + ((sl_ >> 4) & 1)) * 512) + (row & 31) * 8 + ((sl_ >> 3) & 1) * 4;
                    *(u32x2*)(vb_) = (u32x2){w.x, w.y}; *(u32x2*)(vb_ + 256) = (u32x2){w.z, w.w};
                }
            }
    }
};
struct EpiSwiglu {
    static constexpr bool PERM = true;
    bf16_t* O; const float* ss; bool dry;
    DI void operator()(AccT acc, const Unit& u, int wr, int wc, int fr, int fq) const {
        if (dry) return;
        const int row0 = u.pm * BM + wr * 64 + fr, col0 = u.pn * HALF + wc * 32 + 8 * fq;
        float rs[8];
#pragma unroll
        for (int i = 0; i < 8; ++i) rs[i] = ss_rstd(ss, row0 + (i >> 2) * HALF + (i & 3) * 16);
#pragma unroll
        for (int ai = 0; ai < 2; ++ai)
#pragma unroll
            for (int m = 0; m < 4; ++m) {
                const int row = row0 + ai * HALF + m * 16;
                const float r = rs[ai * 4 + m];
                float o[8];
#pragma unroll
                for (int n = 0; n < 2; ++n)
#pragma unroll
                    for (int j = 0; j < 4; ++j) { const float gt = acc[ai][0][m][n][j] * r, up = acc[ai][1][m][n][j] * r; o[n * 4 + j] = siluf_(gt) * up; }
                u32x4 w; w.x = cvt_pk_bf16(o[0], o[1]); w.y = cvt_pk_bf16(o[2], o[3]); w.z = cvt_pk_bf16(o[4], o[5]); w.w = cvt_pk_bf16(o[6], o[7]);
                *(u32x4*)(O + (size_t)row * FF + col0) = w;
            }
    }
};
DI void swap16v(u32x4& v) { const auto r0 = __builtin_amdgcn_permlane16_swap(v.x, v.z, false, false); const auto r1 = __builtin_amdgcn_permlane16_swap(v.y, v.w, false, false); v.x = r0[0]; v.z = r0[1]; v.y = r1[0]; v.w = r1[1]; }
template <bool GATE> struct EpiRes {
    static constexpr bool PERM = false;
    float* h; bf16_t* hb; float* ss_out; const float* ss_in; const bf16_t* pp; const float* hin; const bf16_t* hres; bool res_bf16, write_f32;
    DI void operator()(AccT acc, const Unit& u, int wr, int wc, int fr, int fq) const {
        const int row0 = u.pm * BM + wr * 64 + fr, col0 = u.pn * BM + wc * 32 + 4 * fq;
        const int colw = u.pn * BM + wc * 32 + ((fq & 1) ? 12 + 4 * fq : 4 * fq);
        float rs[8];
#pragma unroll
        for (int i = 0; i < 8; ++i) rs[i] = GATE ? ss_rstd(ss_in, row0 + (i >> 2) * HALF + (i & 3) * 16) : 1.0f;
        f32x4 hv[2][4]; u32x4 hw[2][2], pw4[2][2];
#define ER_LOAD(i_, b_) do { const size_t r_ = (size_t)(row0 + ((i_) >> 2) * HALF + ((i_) & 3) * 16) * D; \
            if (res_bf16) { hw[b_][0] = *(const u32x4*)(hres + r_ + colw); hw[b_][1] = *(const u32x4*)(hres + r_ + colw + HALF); } \
            else { _Pragma("unroll") for (int q = 0; q < 4; ++q) hv[b_][q] = *(const f32x4*)(hin + r_ + col0 + (q >> 1) * HALF + (q & 1) * 16); } \
            if (GATE) { pw4[b_][0] = *(const u32x4*)(pp + r_ + colw); pw4[b_][1] = *(const u32x4*)(pp + r_ + colw + HALF); } } while (0)
        ER_LOAD(0, 0);
#pragma unroll
        for (int i = 0; i < 8; ++i) {
            const int ai = i >> 2, m = i & 3, bsel = i & 1;
            if (i + 1 < 8) { if (bsel) ER_LOAD(i + 1, 0); else ER_LOAD(i + 1, 1); }
            const int row = row0 + ai * HALF + m * 16; const float r = rs[i];
            float sq = 0.f;
#pragma unroll
            for (int bj = 0; bj < 2; ++bj) {
                u32x4 rw = hw[bsel][bj], pq = pw4[bsel][bj];
                if (res_bf16) swap16v(rw);
                if (GATE) swap16v(pq);
                u32x4 ow;
#pragma unroll
                for (int n = 0; n < 2; ++n) {
                    const size_t off = (size_t)row * D + col0 + bj * HALF + n * 16;
                    f32x4 hvv = hv[bsel][bj * 2 + n]; f32x4 a = acc[ai][bj][m][n];
                    if (res_bf16) { const unsigned t0_ = n ? rw.z : rw.x, t1_ = n ? rw.w : rw.y; hvv[0] = bflo(t0_); hvv[1] = bfhi(t0_); hvv[2] = bflo(t1_); hvv[3] = bfhi(t1_); }
                    if (GATE) { const unsigned p0_ = n ? pq.z : pq.x, p1_ = n ? pq.w : pq.y;
                        a[0] = bflo(p0_) * sigmoidf_(a[0] * r); a[1] = bfhi(p0_) * sigmoidf_(a[1] * r); a[2] = bflo(p1_) * sigmoidf_(a[2] * r); a[3] = bfhi(p1_) * sigmoidf_(a[3] * r); }
                    hvv = hvv + a;
                    if (write_f32) *(f32x4*)(h + off) = hvv;
                    if (n == 0) { ow.x = cvt_pk_bf16(hvv[0], hvv[1]); ow.y = cvt_pk_bf16(hvv[2], hvv[3]); } else { ow.z = cvt_pk_bf16(hvv[0], hvv[1]); ow.w = cvt_pk_bf16(hvv[2], hvv[3]); }
                    sq += (hvv[0] * hvv[0] + hvv[1] * hvv[1]) + (hvv[2] * hvv[2] + hvv[3] * hvv[3]);
                }
                swap16v(ow);
                *(u32x4*)(hb + (size_t)row * D + colw + bj * HALF) = ow;
            }
            sq += __shfl_xor(sq, 16); sq += __shfl_xor(sq, 32);
            if (fq == 0) ss_add(ss_out, row, sq);
        }
#undef ER_LOAD
    }
};
}

struct Args { const float* in[21]; float* out; unsigned char* ws; int ph_lo, ph_hi, coop, pad; };
enum { I_X = 0, I_P, I_LNMIX, I_LNFFN, I_LNPLE, I_GWIN, I_GCONV, I_GALOG, I_GDT, I_GNORM, I_GWOUT, I_KVNORM, I_WKV, I_KNORM, I_SWQ, I_SQNORM, I_SWOUT, I_FWIN, I_FWOUT, I_PPROJ, I_PGATE };

DI void transpose_item(const float* W, int ldw, int col0, int K, const float* gain, bf16_t* WT, int dst_row0, int k0, int n0, LAS float* scr, int lane) {
    float v[32];
    const float* wp = W + (size_t)(k0 + (lane >> 5)) * ldw + col0 + n0 + (lane & 31);
#pragma unroll
    for (int i = 0; i < 32; ++i) v[i] = wp[(size_t)(2 * i) * ldw];
    const int c = lane & 7;
    f32x4 g0 = (f32x4){1.f, 1.f, 1.f, 1.f}, g1 = g0;
    if (gain) { g0 = *(const f32x4*)(gain + k0 + 8 * c); g1 = *(const f32x4*)(gain + k0 + 8 * c + 4); }
#pragma unroll
    for (int i = 0; i < 32; ++i) scr[(2 * i + (lane >> 5)) * 33 + (lane & 31)] = v[i];
    asm volatile("s_waitcnt lgkmcnt(0)" ::: "memory");
#pragma unroll
    for (int j = 0; j < 4; ++j) { const int n = (lane >> 3) + 8 * j; const LAS float* sp = scr + (8 * c) * 33 + n;
        u32x4 o; o.x = cvt_pk_bf16(sp[0 * 33] * g0[0], sp[1 * 33] * g0[1]); o.y = cvt_pk_bf16(sp[2 * 33] * g0[2], sp[3 * 33] * g0[3]); o.z = cvt_pk_bf16(sp[4 * 33] * g1[0], sp[5 * 33] * g1[1]); o.w = cvt_pk_bf16(sp[6 * 33] * g1[2], sp[7 * 33] * g1[3]);
        *(u32x4*)(WT + (size_t)(dst_row0 + n) * K + k0 + 8 * c) = o; }
    asm volatile("s_waitcnt lgkmcnt(0)" ::: "memory");
}
struct TJob { const float* W; int ldw, col0, K, ncols; const float* gain; bf16_t* WT; int mode; };
DI TJob get_job(int j, const Args& a) {
    TJob t; t.mode = 0; t.gain = nullptr; t.col0 = 0;
    unsigned char* ws = a.ws;
    if (j < 2) { t.W = a.in[I_GWIN] + (size_t)j * D * 4112; t.ldw = 4112; t.K = D; t.ncols = 4096; t.gain = a.in[I_LNMIX] + j * D; t.WT = (bf16_t*)(ws + WS_WIN) + (size_t)j * 4096 * D; return t; } j -= 2;
    if (j < 4) { t.W = a.in[I_FWIN] + (size_t)j * D * 5632; t.ldw = 5632; t.K = D; t.ncols = 5632; t.gain = a.in[I_LNFFN] + j * D; t.WT = (bf16_t*)(ws + WS_W1) + (size_t)j * 5632 * D; t.mode = 1; return t; } j -= 4;
    if (j < 4) { t.W = a.in[I_FWOUT] + (size_t)j * FF * D; t.ldw = D; t.K = FF; t.ncols = D; t.WT = (bf16_t*)(ws + WS_W2) + (size_t)j * D * FF; return t; } j -= 4;
    if (j < 2) { t.W = a.in[I_GWOUT] + (size_t)j * D * D; t.ldw = D; t.K = D; t.ncols = D; t.WT = (bf16_t*)(ws + WS_WO) + (size_t)j * D * D; return t; } j -= 2;
    if (j < 2) { t.W = a.in[I_WKV]; t.ldw = 2048; t.col0 = j * 1024; t.K = D; t.ncols = D; t.gain = a.in[I_KVNORM]; t.WT = (bf16_t*)(ws + (j ? WS_WV : WS_WK)); return t; } j -= 2;
    if (j < 2) { t.W = a.in[I_SWQ] + (size_t)j * D * D; t.ldw = D; t.K = D; t.ncols = D; t.gain = a.in[I_LNMIX] + (2 + j) * D; t.WT = (bf16_t*)(ws + WS_WQ) + (size_t)j * D * D; return t; } j -= 2;
    if (j < 2) { t.W = a.in[I_SWOUT] + (size_t)j * D * D; t.ldw = D; t.K = D; t.ncols = D; t.WT = (bf16_t*)(ws + WS_SWO) + (size_t)j * D * D; return t; } j -= 2;
    if (j < 4) { t.W = a.in[I_PPROJ] + (size_t)j * PLE * D; t.ldw = D; t.K = PLE; t.ncols = D; t.WT = (bf16_t*)(ws + WS_WPROJ) + (size_t)j * D * PLE; return t; } j -= 4;
    t.W = a.in[I_PGATE] + (size_t)j * D * D; t.ldw = D; t.K = D; t.ncols = D; t.gain = a.in[I_LNPLE] + j * D; t.WT = (bf16_t*)(ws + WS_WGATE) + (size_t)j * D * D; return t;
}
constexpr int NJOBS = 26;

struct TItem { const float* wp; const float* gp; bf16_t* wt; int ldw, K, valid; };
DI TItem decode_titem(int g, const Args& a, int lane) {
    TItem r; r.wp = nullptr; r.gp = nullptr; r.wt = nullptr; r.ldw = 0; r.K = 0; r.valid = 0;
    for (int j = 0; j < NJOBS; ++j) {
        const TJob t = get_job(j, a);
        const int nblk = t.ncols / 32, nitems = (t.K / 64) * nblk;
        if (g < nitems) {
            const int kb = g / nblk, nb = g % nblk, n0 = nb * 32, k0 = kb * 64;
            int drow = n0;
            if (t.mode == 1) { drow = (n0 < FF) ? ((n0 / 128) * 256 + (n0 % 128)) : (((n0 - FF) / 128) * 256 + 128 + ((n0 - FF) % 128)); }
            r.wp = t.W + (size_t)(k0 + (lane >> 5)) * t.ldw + t.col0 + n0 + (lane & 31);
            r.gp = t.gain ? t.gain + k0 + 8 * (lane & 7) : nullptr;
            r.wt = t.WT + (size_t)(drow + (lane >> 3)) * t.K + k0 + 8 * (lane & 7);
            r.ldw = t.ldw; r.K = t.K; r.valid = 1; return r;
        }
        g -= nitems;
    }
    return r;
}
constexpr int TR_TOTAL = 2 * 2048 + 4 * 2816 + 4 * 1408 + 2 * 512 + 2 * 512 + 2 * 512 + 2 * 512 + 4 * 128 + 4 * 512;
DI void phase_prep(const Args& a, LAS unsigned char* lds, int gw, int NGW, int wave, int lane) {
    LAS float* scr = (LAS float*)(lds + wave * 16384);
    {
        float v[32]; f32x4 g0 = (f32x4){1.f, 1.f, 1.f, 1.f}, g1 = g0;
        TItem cur = decode_titem(gw, a, lane);
        if (cur.valid) {
#pragma unroll
            for (int i = 0; i < 32; ++i) v[i] = cur.wp[(size_t)(2 * i) * cur.ldw];
            if (cur.gp) { g0 = *(const f32x4*)(cur.gp); g1 = *(const f32x4*)(cur.gp + 4); }
        }
        for (int g = gw; g < TR_TOTAL; g += NGW) {
#pragma unroll
            for (int i = 0; i < 32; ++i) scr[(2 * i + (lane >> 5)) * 33 + (lane & 31)] = v[i];
            const f32x4 h0 = g0, h1 = g1; bf16_t* wt = cur.wt; const int K = cur.K;
            cur = decode_titem(g + NGW, a, lane);
            g0 = (f32x4){1.f, 1.f, 1.f, 1.f}; g1 = g0;
            if (cur.valid) {
#pragma unroll
                for (int i = 0; i < 32; ++i) v[i] = cur.wp[(size_t)(2 * i) * cur.ldw];
                if (cur.gp) { g0 = *(const f32x4*)(cur.gp); g1 = *(const f32x4*)(cur.gp + 4); }
            }
            asm volatile("s_waitcnt lgkmcnt(0)" ::: "memory");
            const int c = lane & 7;
#pragma unroll
            for (int j = 0; j < 4; ++j) { const int n = (lane >> 3) + 8 * j; const LAS float* sp = scr + (8 * c) * 33 + n;
                u32x4 o; o.x = cvt_pk_bf16(sp[0 * 33] * h0[0], sp[1 * 33] * h0[1]); o.y = cvt_pk_bf16(sp[2 * 33] * h0[2], sp[3 * 33] * h0[3]); o.z = cvt_pk_bf16(sp[4 * 33] * h1[0], sp[5 * 33] * h1[1]); o.w = cvt_pk_bf16(sp[6 * 33] * h1[2], sp[7 * 33] * h1[3]);
                *(u32x4*)(wt + (size_t)(8 * j) * K) = o; }
            asm volatile("s_waitcnt lgkmcnt(0)" ::: "memory");
        }
    }
    const int gt = gw * 64 + lane, NGT = NGW * 64;
    for (int i = gt; i < 2 * 16 * D; i += NGT) { const int l = i / (16 * D), n = (i / D) % 16, k = i % D;
        const float v = a.in[I_GWIN][(size_t)l * D * 4112 + (size_t)k * 4112 + 4096 + n] * a.in[I_LNMIX][l * D + k];
        ((bf16_t*)(a.ws + WS_WAB))[i] = (bf16_t)(cvt_pk_bf16(v, 0.f) & 0xffffu); }
    { float* z = (float*)(a.ws + WS_SS) + T; for (int i = gt; i < 12 * T; i += NGT) z[i] = 0.f;
      float* z2 = (float*)(a.ws + WS_SSQ); for (int i = gt; i < (int)((WS_GL - WS_SSQ) / 4); i += NGT) z2[i] = 0.f; }
    float* ss0 = (float*)(a.ws + WS_SS); bf16_t* hb0 = (bf16_t*)(a.ws + WS_HB0);
    for (int m = gw; m < T; m += NGW) {
        const f32x4* xr = (const f32x4*)(a.in[I_X] + (size_t)m * D) + lane; u32x2* hbr = (u32x2*)(hb0 + (size_t)m * D) + lane;
        float s = 0.f;
#pragma unroll
        for (int j = 0; j < 4; ++j) { const f32x4 v = xr[64 * j]; u32x2 w; w.x = cvt_pk_bf16(v[0], v[1]); w.y = cvt_pk_bf16(v[2], v[3]); hbr[64 * j] = w; s += (v[0] * v[0] + v[1] * v[1]) + (v[2] * v[2] + v[3] * v[3]); }
        s = wave_sum(s);
        if (lane == 0) ((unsigned*)ss0)[m] = (unsigned)(s * SS_SCALE + 0.5f);
    }
}

DI void convert_p(const Args& a, int L, int gt, int NGT) {
    const f32x4* src = (const f32x4*)(a.in[I_P] + (size_t)L * T * PLE); u32x4* dst = (u32x4*)(a.ws + WS_PB);
    for (int i = gt; i < T * PLE / 8; i += NGT) { const f32x4 v0 = src[2 * i], v1 = src[2 * i + 1];
        u32x4 w; w.x = cvt_pk_bf16(v0[0], v0[1]); w.y = cvt_pk_bf16(v0[2], v0[3]); w.z = cvt_pk_bf16(v1[0], v1[1]); w.w = cvt_pk_bf16(v1[2], v1[3]); dst[i] = w; }
}

DI void ab_gemm(const bf16_t* hb, const bf16_t* wab, const float* ss, float* AB, int gw, int NGW, int lane) {
    const int fr = lane & 15, fq = lane >> 4;
    for (int tile = gw; tile < T / 16; tile += NGW) {
        f32x4 acc = (f32x4){0.f, 0.f, 0.f, 0.f};
        const bf16_t* ap = hb + (size_t)(tile * 16 + fr) * D + 8 * fq; const bf16_t* bp = wab + (size_t)fr * D + 8 * fq;
#pragma unroll 1
        for (int k8 = 0; k8 < D / 256; ++k8) {
            bf16x8 av[8], bv[8];
#pragma unroll
            for (int j = 0; j < 8; ++j) { av[j] = *(const bf16x8*)(ap + 256 * k8 + 32 * j); bv[j] = *(const bf16x8*)(bp + 256 * k8 + 32 * j); }
            asm volatile("" : "+v"(av[0]), "+v"(av[1]), "+v"(av[2]), "+v"(av[3]), "+v"(av[4]), "+v"(av[5]), "+v"(av[6]), "+v"(av[7]),
                              "+v"(bv[0]), "+v"(bv[1]), "+v"(bv[2]), "+v"(bv[3]), "+v"(bv[4]), "+v"(bv[5]), "+v"(bv[6]), "+v"(bv[7]));
#pragma unroll
            for (int j = 0; j < 8; ++j) acc = __builtin_amdgcn_mfma_f32_16x16x32_bf16(av[j], bv[j], acc, 0, 0, 0);
        }
#pragma unroll
        for (int r = 0; r < 4; ++r) { const int row = tile * 16 + 4 * fq + r; AB[(size_t)row * 16 + fr] = acc[r] * ss_rstd(ss, row); }
    }
}

constexpr int SA_QS = 0, SA_KS = 32768, SA_VS = 65536, SA_STG = 98304, SA_A = SA_STG, SA_KB = SA_A + 16384, SA_QB = SA_KB + 64 * 136 * 2, SA_BETA = SA_STG + 67 * 384 * 2, SA_G = SA_BETA + 256, SA_RQ = SA_G + 256, SA_RK = SA_RQ + 256;
static_assert(SA_QB + 64 * 136 * 2 <= SA_BETA && SA_RK + 256 <= LDS_BYTES - 16, "stage A LDS");

DI void gdn_stage_a(const Args& a, int L, LAS unsigned char* lds, int tid, int wave, int lane, const bool dry) {
    const int l = L;
    bf16_t* proj = (bf16_t*)(a.ws + WS_R1);
    const bf16_t* halo = (const bf16_t*)(a.ws + WS_HALO);
    bf16_t* wbuf = (bf16_t*)(a.ws + ((L & 1) ? WS_HB1 : WS_HB0));
    bf16_t* qkd = (bf16_t*)(a.ws + ((L & 1) ? WS_HB0 : WS_HB1));
    float* GL = (float*)(a.ws + WS_GL);
    const float* AB = (const float*)(a.ws + WS_AB);
    const float* convw = a.in[I_GCONV] + (size_t)l * 4 * 3072;
    LAS float* qs = (LAS float*)(lds + SA_QS); LAS float* ks = (LAS float*)(lds + SA_KS); LAS float* vs = (LAS float*)(lds + SA_VS); LAS float* Am = (LAS float*)(lds + SA_A); LAS bf16_t* stg = (LAS bf16_t*)(lds + SA_STG);
    LAS bf16_t* kb = (LAS bf16_t*)(lds + SA_KB); LAS bf16_t* qb = (LAS bf16_t*)(lds + SA_QB);
    LAS float* sbeta = (LAS float*)(lds + SA_BETA); LAS float* sG = (LAS float*)(lds + SA_G); LAS float* srq = (LAS float*)(lds + SA_RQ); LAS float* srk = (LAS float*)(lds + SA_RK);

    for (int item = blockIdx.x; item < NB * NH * 64; item += gridDim.x) {
        const int n = item & 63, bh = item >> 6, h = bh & 7, b = bh >> 3;
        const int t0 = b * SEQ + n * 64;
        int tidv = tid; asm volatile("" : "+v"(tidv));
        {
            u32x4 rv[7];
#pragma unroll
            for (int i = 0; i < 7; ++i) { const int id = tidv + i * NTHR; rv[i] = (u32x4){0u, 0u, 0u, 0u};
                if (id < 67 * 48) { const int row = id / 48, cc = id % 48, seg = cc >> 4, off = (cc & 15) * 8, rr = row - 3;
                    if (rr >= 0) rv[i] = *(const u32x4*)(proj + (size_t)(t0 + rr) * PLD + seg * 1024 + h * 128 + off);
                    else if (n > 0) rv[i] = *(const u32x4*)(halo + ((size_t)(b * 64 + n - 1) * 3 + row) * 3072 + seg * 1024 + h * 128 + off); } }
#pragma unroll
            for (int i = 0; i < 7; ++i) { const int id = tidv + i * NTHR;
                if (id < 67 * 48) { const int row = id / 48, cc = id % 48; *(LAS u32x4*)(stg + row * 384 + cc * 8) = rv[i]; } }
            if (tidv >= 448) {
                const int r = tidv - 448;
                const float ain = AB[(size_t)(t0 + r) * 16 + h], bin = AB[(size_t)(t0 + r) * 16 + 8 + h];
                float g = -__expf(a.in[I_GALOG][l * NH + h]) * softplusf_(ain + a.in[I_GDT][l * NH + h]);
#pragma unroll
                for (int o = 1; o < 64; o <<= 1) { const float t_ = __shfl_up(g, o); if (r >= o) g += t_; }
                sbeta[r] = sigmoidf_(bin); sG[r] = g;
                if (r == 63) GL[bh * 64 + n] = __expf(g);
            }
        }
        __syncthreads();
#pragma unroll 1
        for (int task = tidv; task < 384 * 4; task += NTHR) {
            const int col = task % 384, r0 = (task / 384) * 16, seg = col >> 7, c = col & 127, ch = seg * 1024 + h * 128 + c;
            const float w0 = convw[ch], w1 = convw[3072 + ch], w2 = convw[2 * 3072 + ch], w3 = convw[3 * 3072 + ch];
            LAS float* dst = (seg == 0 ? qs : seg == 1 ? ks : vs) + c;
            const LAS bf16_t* sp = stg + r0 * 384 + col;
            float x0 = bf2f(sp[0]), x1 = bf2f(sp[384]), x2 = bf2f(sp[2 * 384]);
#pragma unroll
            for (int r = 0; r < 16; ++r) { const float x3 = bf2f(sp[(r + 3) * 384]); dst[(r0 + r) * 128] = siluf_(w0 * x0 + w1 * x1 + w2 * x2 + w3 * x3); x0 = x1; x1 = x2; x2 = x3; }
        }
        __syncthreads();
        { const int r = tidv >> 3, l8 = tidv & 7; float sq = 0.f, sk = 0.f;
#pragma unroll
            for (int j = 0; j < 4; ++j) { const f32x4 qv = *(LAS f32x4*)(qs + r * 128 + 32 * j + 4 * l8), kv = *(LAS f32x4*)(ks + r * 128 + 32 * j + 4 * l8);
                sq += (qv[0] * qv[0] + qv[1] * qv[1]) + (qv[2] * qv[2] + qv[3] * qv[3]); sk += (kv[0] * kv[0] + kv[1] * kv[1]) + (kv[2] * kv[2] + kv[3] * kv[3]); }
            sq += __shfl_xor(sq, 1); sk += __shfl_xor(sk, 1); sq += __shfl_xor(sq, 2); sk += __shfl_xor(sk, 2); sq += __shfl_xor(sq, 4); sk += __shfl_xor(sk, 4);
            if (l8 == 0) { srq[r] = rsqrtf(sq + EPS) * 0.08838834764831845f; srk[r] = rsqrtf(sk + EPS); } }
        __syncthreads();
#pragma unroll 1
        for (int i = tidv; i < 64 * 32; i += NTHR) { const int r = i >> 5, c4 = (i & 31) * 4;
            f32x4 qv = *(LAS f32x4*)(qs + r * 128 + c4) * srq[r], kv = *(LAS f32x4*)(ks + r * 128 + c4) * srk[r];
            *(LAS f32x4*)(qs + r * 128 + c4) = qv; *(LAS f32x4*)(ks + r * 128 + c4) = kv;
            u32x2 wq, wk; wq.x = cvt_pk_bf16(qv[0], qv[1]); wq.y = cvt_pk_bf16(qv[2], qv[3]); wk.x = cvt_pk_bf16(kv[0], kv[1]); wk.y = cvt_pk_bf16(kv[2], kv[3]);
            *(LAS u32x2*)(qb + r * 136 + c4) = wq; *(LAS u32x2*)(kb + r * 136 + c4) = wk; }
        __syncthreads();
        {
            const int fr = lane & 15, fq = lane >> 4;
#pragma unroll
            for (int tt = 0; tt < 2; ++tt) { const int tile = wave * 2 + tt, rt = tile >> 2, ct = tile & 3;
                f32x4 acc = (f32x4){0.f, 0.f, 0.f, 0.f};
#pragma unroll
                for (int kk = 0; kk < 4; ++kk) { const bf16x8 av = *(LAS bf16x8*)(kb + (16 * rt + fr) * 136 + 32 * kk + 8 * fq), bv = *(LAS bf16x8*)(kb + (16 * ct + fr) * 136 + 32 * kk + 8 * fq);
                    acc = __builtin_amdgcn_mfma_f32_16x16x32_bf16(av, bv, acc, 0, 0, 0); }
                const int s = 16 * ct + fr; const float Gs = sG[s];
#pragma unroll
                for (int rg = 0; rg < 4; ++rg) { const int r = 16 * rt + 4 * fq + rg; const float v = (s < r) ? sbeta[r] * acc[rg] * __expf(sG[r] - Gs) : 0.f; Am[r * 64 + s] = v; } }
        }
        __syncthreads();
        if (tid < 256) {
            int lz; asm volatile("v_mov_b32 %0, 0" : "=v"(lz));
            LAS float* sbeta_v = sbeta + lz; LAS float* sG_v = sG + lz; LAS float* Am_v = Am + lz;
            float X[64];
            if (tid < 128) {
#pragma unroll
                for (int r = 0; r < 64; ++r) X[r] = vs[r * 128 + tid] * sbeta_v[r];
            } else {
#pragma unroll
                for (int r = 0; r < 64; ++r) X[r] = ks[r * 128 + (tid - 128)] * sbeta_v[r] * __expf(sG_v[r]);
            }
#pragma unroll
            for (int r = 1; r < 64; ++r) {
                float a0 = 0.f, a1 = 0.f, a2 = 0.f, a3 = 0.f;
#pragma unroll
                for (int s4 = 0; s4 < (r + 3) / 4; ++s4) { const f32x4 av = *(LAS f32x4*)(Am_v + r * 64 + 4 * s4);
                    a0 += av[0] * X[4 * s4]; a1 += av[1] * X[4 * s4 + 1]; a2 += av[2] * X[4 * s4 + 2]; a3 += av[3] * X[4 * s4 + 3]; }
                X[r] -= (a0 + a1) + (a2 + a3);
            }
            if (tid < 128) {
                bf16_t* vs_ = proj + (size_t)t0 * PLD + 2048 + h * 128 + (size_t)((tid >> 4) * 8) * PLD + (tid & 15) * 4;
#pragma unroll
                for (int rp = 0; rp < 8; ++rp) {
#pragma unroll
                    for (int hf = 0; hf < 2; ++hf) { const int c0 = 16 * (rp >> 1) + 4 * (2 * (rp & 1) + hf); u32x2 w; w.x = cvt_pk_bf16(X[c0], X[c0 + 1]); w.y = cvt_pk_bf16(X[c0 + 2], X[c0 + 3]);
                        if (!dry) *(u32x2*)(vs_ + hf * 64) = w; }
                    vs_ += PLD; asm volatile("" : "+v"(vs_)); }
            } else {
                const int c_ = tid - 128;
                bf16_t* wp = wbuf + (size_t)t0 * D + h * 128 + (size_t)((c_ >> 5) * 4 + ((c_ >> 3) & 3)) * D + (c_ & 7);
#pragma unroll
                for (int rt_ = 0; rt_ < 4; ++rt_) {
#pragma unroll
                    for (int fr_ = 0; fr_ < 16; ++fr_) wp[fr_ * 8] = (bf16_t)(cvt_pk_bf16(X[16 * rt_ + fr_], 0.f) & 0xffffu);
                    wp += 16 * D; asm volatile("" : "+v"(wp)); }
            }
        } else {
            const int w4 = wave - 4, fr = lane & 15, fq = lane >> 4, tt = tid - 256;
            bf16_t* qk_o = qkd + (size_t)item * 4096;
#pragma unroll
            for (int ct = 0; ct < 4; ++ct) {
                f32x4 acc = (f32x4){0.f, 0.f, 0.f, 0.f};
#pragma unroll
                for (int kk = 0; kk < 4; ++kk) { const bf16x8 av = *(LAS bf16x8*)(qb + (16 * w4 + fr) * 136 + 32 * kk + 8 * fq), bv = *(LAS bf16x8*)(kb + (16 * ct + fr) * 136 + 32 * kk + 8 * fq);
                    acc = __builtin_amdgcn_mfma_f32_16x16x32_bf16(av, bv, acc, 0, 0, 0); }
                const int s = 16 * ct + fr; const float Gs = sG[s];
#pragma unroll
                for (int rg = 0; rg < 4; ++rg) { const int r = 16 * w4 + 4 * fq + rg; const float v = (s <= r) ? acc[rg] * __expf(sG[r] - Gs) : 0.f;
                    qk_o[((r >> 4) * 2 + (s >> 5)) * 512 + (((s >> 3) & 3) * 16 + (r & 15)) * 8 + (s & 7)] = (bf16_t)(cvt_pk_bf16(v, 0.f) & 0xffffu); }
            }
#pragma unroll 1
            for (int i = tt; i < 64 * 16; i += 256) { const int blk_ = i >> 6, ln_ = i & 63, r = 16 * (blk_ >> 2) + (ln_ & 15), c8 = 32 * (blk_ & 3) + 8 * (ln_ >> 4); const float e = __expf(sG[r]);
                const f32x4 v0 = *(LAS f32x4*)(qs + r * 128 + c8) * e, v1 = *(LAS f32x4*)(qs + r * 128 + c8 + 4) * e;
                u32x4 w; w.x = cvt_pk_bf16(v0[0], v0[1]); w.y = cvt_pk_bf16(v0[2], v0[3]); w.z = cvt_pk_bf16(v1[0], v1[1]); w.w = cvt_pk_bf16(v1[2], v1[3]);
                if (!dry) *(u32x4*)(proj + (size_t)t0 * PLD + h * 128 + (size_t)((((r >> 4) * 4 + (c8 >> 5)) * 4) + ((c8 >> 3) & 3)) * PLD + (r & 15) * 8) = w; }
            const float Glast = sG[63];
#pragma unroll 1
            for (int i = tt; i < 128 * 8; i += 256) { const int blk_ = i >> 6, ln_ = i & 63, dk = 16 * (blk_ >> 1) + (ln_ & 15), c8 = 32 * (blk_ & 1) + 8 * (ln_ >> 4); float v[8];
#pragma unroll
                for (int j = 0; j < 8; ++j) v[j] = ks[(c8 + j) * 128 + dk] * __expf(Glast - sG[c8 + j]);
                u32x4 w; w.x = cvt_pk_bf16(v[0], v[1]); w.y = cvt_pk_bf16(v[2], v[3]); w.z = cvt_pk_bf16(v[4], v[5]); w.w = cvt_pk_bf16(v[6], v[7]);
                if (!dry) *(u32x4*)(proj + (size_t)t0 * PLD + 1024 + h * 128 + (size_t)((((dk >> 4) * 2 + (c8 >> 5)) * 4) + ((c8 >> 3) & 3)) * PLD + (dk & 15) * 8) = w; }
        }
        __syncthreads();
    }
}

constexpr int SB_ST = 0, SB_VT = 16 * 136 * 2;
DI void gdn_stage_b(const Args& a, int L, LAS unsigned char* lds, int wave, int lane) {
    const bf16_t* proj = (const bf16_t*)(a.ws + WS_R1);
    const bf16_t* wbuf = (const bf16_t*)(a.ws + ((L & 1) ? WS_HB1 : WS_HB0));
    const bf16_t* qkd = (const bf16_t*)(a.ws + ((L & 1) ? WS_HB0 : WS_HB1));
    const float* GL = (const float*)(a.ws + WS_GL);
    bf16_t* og = (bf16_t*)(a.ws + WS_OG);
    LAS bf16_t* sT = (LAS bf16_t*)(lds + SB_ST); LAS bf16_t* vT = (LAS bf16_t*)(lds + SB_VT);
    const int fr = lane & 15, fq = lane >> 4, rt = wave & 3;
    for (int item = blockIdx.x; item < NB * NH * 8; item += gridDim.x) {
        const int xcd_ = item & 7, idx_ = item >> 3;
        const int sl = idx_ & 7, bh = xcd_ * 4 + (idx_ >> 3), h = bh & 7, b = bh >> 3, dv0 = sl * 16;
        f32x4 Sacc = (f32x4){0.f, 0.f, 0.f, 0.f};
        __syncthreads();
        { unsigned zz; asm volatile("v_mov_b32 %0, 0" : "=v"(zz)); u32x2 z2; z2.x = zz; z2.y = zz; *(LAS u32x2*)(sT + fr * 136 + 16 * wave + 4 * fq) = z2; }
        __syncthreads();
        const size_t strideA = (wave < 4) ? (size_t)128 * D * 2 : (size_t)128 * PLD * 2, strideX = (wave < 4) ? (size_t)128 * PLD * 2 : (size_t)2 * 8192, stepA = strideA / 2, stepX = strideX / 2;
        const size_t kstepA = (wave < 4) ? (size_t)4 * D * 2 : (size_t)4 * PLD * 2;
        GCP pa0 = (wave < 4) ? (GCP)wbuf + ((size_t)(b * SEQ + 16 * rt + fq) * D + h * 128 + 8 * fr) * 2 : (GCP)proj + ((size_t)(b * SEQ + 16 * rt + fq) * PLD + h * 128 + 8 * fr) * 2;
        GCP pk0 = (GCP)proj + ((size_t)(b * SEQ) * PLD + 1024 + h * 128 + (size_t)(8 * wave + fq) * PLD + 8 * fr) * 2;
        GCP px0 = (wave < 4) ? (GCP)proj + ((size_t)(b * SEQ) * PLD + 2048 + h * 128 + (size_t)((sl * 4 + rt) * 2 + (lane >> 5)) * PLD + (lane & 31) * 4) * 2
                                     : (GCP)qkd + ((size_t)(bh * 64) * 4096 + rt * 1024 + lane * 8) * 2;
        const size_t kstepX = (wave < 4) ? (size_t)16 : (size_t)1024;
        GCP paA = pa0, paB = pa0 + stepA, paC = pa0 + 2 * stepA, paD = pa0 + 3 * stepA;
        GCP pkA = pk0, pkB = pk0 + (size_t)64 * PLD * 2, pkC = pk0 + 2 * 524288, pkD = pk0 + 3 * 524288;
        GCP pxA = px0, pxB = px0 + stepX, pxC = px0 + 2 * stepX, pxD = px0 + 3 * stepX;
#define SB_LOAD(n_, PA, PK, PX, AF, UW, QF, KF, GLV) do { \
            _Pragma("unroll") for (int kk = 0; kk < 4; ++kk) AF[kk] = *(GAS const bf16x8*)(PA + kk * kstepA); \
            KF[0] = *(GAS const bf16x8*)(PK); KF[1] = *(GAS const bf16x8*)(PK + (size_t)4 * PLD * 2); \
            QF[0] = *(GAS const bf16x8*)(PX); QF[1] = *(GAS const bf16x8*)(PX + kstepX);     \
            GLV = GL[bh * 64 + (n_)]; \
            PA += strideA; PK += (size_t)128 * PLD * 2; PX += strideX; asm volatile("" : "+v"(PA), "+v"(PK), "+v"(PX)); } while (0)
#define SB_BODY(n_, AF, UW, QF, KF, GLV) do { const int t0_ = b * SEQ + (n_) * 64; \
            f32x4 acc = (f32x4){0.f, 0.f, 0.f, 0.f}; \
            _Pragma("unroll") for (int kk = 0; kk < 4; ++kk) { const bf16x8 bv = *(LAS bf16x8*)(sT + fr * 136 + 32 * kk + 8 * fq); acc = __builtin_amdgcn_mfma_f32_16x16x32_bf16(AF[kk], bv, acc, 0, 0, 0); } \
            if (wave < 4) { \
                const u32x4 uq_ = __builtin_bit_cast(u32x4, QF[0]); f32x4 vn; vn[0] = bflo(uq_.x) - acc[0]; vn[1] = bfhi(uq_.x) - acc[1]; vn[2] = bflo(uq_.y) - acc[2]; vn[3] = bfhi(uq_.y) - acc[3]; \
                u32x2 w_; w_.x = cvt_pk_bf16(vn[0], vn[1]); w_.y = cvt_pk_bf16(vn[2], vn[3]); \
                *(LAS u32x2*)(vT + fr * 72 + 16 * rt + 4 * fq) = w_; } \
            __syncthreads(); \
            const bf16x8 vb0 = *(LAS bf16x8*)(vT + fr * 72 + 8 * fq), vb1 = *(LAS bf16x8*)(vT + fr * 72 + 32 + 8 * fq); \
            if (wave >= 4) { \
                acc = __builtin_amdgcn_mfma_f32_16x16x32_bf16(QF[0], vb0, acc, 0, 0, 0); \
                acc = __builtin_amdgcn_mfma_f32_16x16x32_bf16(QF[1], vb1, acc, 0, 0, 0); \
                bf16_t* op = og + (size_t)(t0_ + 16 * rt + 4 * fq) * D + h * 128 + dv0 + fr; \
                _Pragma("unroll") for (int rg = 0; rg < 4; ++rg) op[(size_t)rg * D] = (bf16_t)(cvt_pk_bf16(acc[rg], 0.f) & 0xffffu); } \
            Sacc = Sacc * GLV; \
            Sacc = __builtin_amdgcn_mfma_f32_16x16x32_bf16(KF[0], vb0, Sacc, 0, 0, 0); \
            Sacc = __builtin_amdgcn_mfma_f32_16x16x32_bf16(KF[1], vb1, Sacc, 0, 0, 0); \
            { u32x2 w_; w_.x = cvt_pk_bf16(Sacc[0], Sacc[1]); w_.y = cvt_pk_bf16(Sacc[2], Sacc[3]); *(LAS u32x2*)(sT + fr * 136 + 16 * wave + 4 * fq) = w_; } \
            __syncthreads(); } while (0)
        bf16x8 afA[4], afB[4], qfA[2], qfB[2], kfA[2], kfB[2]; u32x2 uwA = (u32x2){0u, 0u}, uwB = uwA; float glA, glB;
        (void)uwA; (void)uwB; (void)paC; (void)paD; (void)pkC; (void)pkD; (void)pxC; (void)pxD;
        SB_LOAD(0, paA, pkA, pxA, afA, uwA, qfA, kfA, glA);
        for (int n = 0; n < 64; n += 2) {
            SB_LOAD(n + 1, paB, pkB, pxB, afB, uwB, qfB, kfB, glB);
            SB_BODY(n, afA, uwA, qfA, kfA, glA);
            if (n + 2 < 64) SB_LOAD(n + 2, paA, pkA, pxA, afA, uwA, qfA, kfA, glA);
            SB_BODY(n + 1, afB, uwB, qfB, kfB, glB);
        }
#undef SB_LOAD
#undef SB_BODY
    }
}

DI void gdn_stage_c(const Args& a, int L, int gw, int NGW, int lane) {
    bf16_t* og = (bf16_t*)(a.ws + WS_OG); const bf16_t* proj = (const bf16_t*)(a.ws + WS_R1);
    const float* ng = a.in[I_GNORM] + L * HD + (lane & 7) * 16;
    float gn[16];
#pragma unroll
    for (int j = 0; j < 16; ++j) gn[j] = ng[j];
    for (int m = gw; m < T; m += NGW) {
        u32x4* op = (u32x4*)(og + (size_t)m * D + lane * 16); const u32x4* gp = (const u32x4*)(proj + (size_t)m * PLD + 3072 + lane * 16);
        const u32x4 o0 = op[0], o1 = op[1], g0 = gp[0], g1 = gp[1];
        float o[16], g[16];
#pragma unroll
        for (int j = 0; j < 4; ++j) { o[2 * j] = bflo(o0[j]); o[2 * j + 1] = bfhi(o0[j]); o[8 + 2 * j] = bflo(o1[j]); o[8 + 2 * j + 1] = bfhi(o1[j]);
            g[2 * j] = bflo(g0[j]); g[2 * j + 1] = bfhi(g0[j]); g[8 + 2 * j] = bflo(g1[j]); g[8 + 2 * j + 1] = bfhi(g1[j]); }
        float s = 0.f;
#pragma unroll
        for (int j = 0; j < 16; ++j) s += o[j] * o[j];
        s += __shfl_xor(s, 1); s += __shfl_xor(s, 2); s += __shfl_xor(s, 4);
        const float r = rsqrtf(s * (1.0f / HD) + EPS);
        float y[16];
#pragma unroll
        for (int j = 0; j < 16; ++j) y[j] = o[j] * r * gn[j] * siluf_(g[j]);
        u32x4 w0, w1;
#pragma unroll
        for (int j = 0; j < 4; ++j) { w0[j] = cvt_pk_bf16(y[2 * j], y[2 * j + 1]); w1[j] = cvt_pk_bf16(y[8 + 2 * j], y[8 + 2 * j + 1]); }
        op[0] = w0; op[1] = w1;
    }
}

DI void sb_attention(const Args& a, int j2, int gw, int NGW, int lane) {
    const bf16_t* qo = (const bf16_t*)(a.ws + WS_OG); bf16_t* ob = (bf16_t*)(a.ws + WS_R1); const bf16_t* kbuf = (const bf16_t*)(a.ws + WS_KB); const bf16_t* vt = (const bf16_t*)(a.ws + WS_VT);
    const float* ssq = (const float*)(a.ws + WS_SSQ) + (size_t)j2 * NB * NH * SEQ; const float* ssk = (const float*)(a.ws + WS_SSK);
    const float* qn = a.in[I_SQNORM] + j2 * HD; const float* kn = a.in[I_KNORM];
    const int tl = lane & 31, hh = lane >> 5;
    for (int item = gw; item < NB * NH * (SEQ / 32); item += NGW) {
        const int qt = (SEQ / 32 - 1) - (item & 127), bh = item >> 7, h = bh & 7, b = bh >> 3, t0 = qt * 32;
        const size_t qrow = (size_t)(b * SEQ + t0 + tl) * D + h * 128;
        bf16x8 qf[8];
        {
            const float rq = rsqrtf((float)((const unsigned*)ssq)[(size_t)bh * SEQ + t0 + tl] * (SH_INV / HD) + EPS) * 0.08838834764831845f;
#pragma unroll
            for (int ks = 0; ks < 8; ++ks) { const u32x4 raw = *(const u32x4*)(qo + qrow + 16 * ks + 8 * hh);
                const f32x4 g0 = *(const f32x4*)(qn + 16 * ks + 8 * hh) * *(const f32x4*)(kn + 16 * ks + 8 * hh), g1 = *(const f32x4*)(qn + 16 * ks + 8 * hh + 4) * *(const f32x4*)(kn + 16 * ks + 8 * hh + 4);
                u32x4 w; w.x = cvt_pk_bf16(bflo(raw.x) * rq * g0[0], bfhi(raw.x) * rq * g0[1]); w.y = cvt_pk_bf16(bflo(raw.y) * rq * g0[2], bfhi(raw.y) * rq * g0[3]);
                w.z = cvt_pk_bf16(bflo(raw.z) * rq * g1[0], bfhi(raw.z) * rq * g1[1]); w.w = cvt_pk_bf16(bflo(raw.w) * rq * g1[2], bfhi(raw.w) * rq * g1[3]);
                qf[ks] = __builtin_bit_cast(bf16x8, w); }
        }
        f32x16 o[4];
#pragma unroll
        for (int dt = 0; dt < 4; ++dt)
#pragma unroll
            for (int i = 0; i < 16; ++i) o[dt][i] = 0.f;
        float carry = 0.f;
        bf16x8 kf[8];
        { const bf16_t* kp = kbuf + ((size_t)(bh * (SEQ / 32) + qt) * 8) * 512 + lane * 8;
#pragma unroll
          for (int ks = 0; ks < 8; ++ks) kf[ks] = *(const bf16x8*)(kp + 512 * ks); }
        for (int kt = qt; kt >= 0; --kt) {
            const int s0 = kt * 32;
            f32x16 z;
#pragma unroll
            for (int i = 0; i < 16; ++i) z[i] = 0.f;
#pragma unroll
            for (int ks = 0; ks < 8; ++ks) z = __builtin_amdgcn_mfma_f32_32x32x16_bf16(kf[ks], qf[ks], z, 0, 0, 0);
            if (kt > 0) {
                const bf16_t* kp = kbuf + ((size_t)(bh * (SEQ / 32) + kt - 1) * 8) * 512 + lane * 8;
#pragma unroll
                for (int ks = 0; ks < 8; ++ks) kf[ks] = *(const bf16x8*)(kp + 512 * ks);
            }
            bf16x8 vf[4][2];
            const bf16_t* vp = vt + ((size_t)(bh * (SEQ / 32) + kt) * 8) * 512 + lane * 8;
#define ATT_VLOAD(dt) do { _Pragma("unroll") for (int kv = 0; kv < 2; ++kv) vf[dt][kv] = *(const bf16x8*)(vp + ((dt) * 2 + kv) * 512); } while (0)
            ATT_VLOAD(0); ATT_VLOAD(1);
            float ln[16], zz[16];
            const bool diag = (kt == qt);
#pragma unroll
            for (int g = 0; g < 4; ++g) { const u32x4 k4 = *(const u32x4*)(ssk + (size_t)bh * SEQ + s0 + 8 * g + 4 * hh);
#pragma unroll
                for (int i = 0; i < 4; ++i) { const float rk = rsqrtf((float)k4[i] * (SH_INV / HD) + EPS); const float zv = z[4 * g + i] * rk;
                    const bool valid = !diag || (8 * g + 4 * hh + i < tl);
                    zz[4 * g + i] = zv; ln[4 * g + i] = valid ? -softplusf_(zv) : 0.f; } }
            float gs[4], og_[4];
#pragma unroll
            for (int g = 0; g < 4; ++g) { gs[g] = (ln[4 * g] + ln[4 * g + 1]) + (ln[4 * g + 2] + ln[4 * g + 3]); og_[g] = __shfl_xor(gs[g], 32); }
            float after[4]; float run = carry;
#pragma unroll
            for (int g = 3; g >= 0; --g) { after[g] = run + (hh == 0 ? og_[g] : 0.f); run += gs[g] + og_[g]; }
            float wv[16];
#pragma unroll
            for (int g = 0; g < 4; ++g) { float suf = after[g];
#pragma unroll
                for (int i = 3; i >= 0; --i) { const int e = 4 * g + i; const bool valid = !diag || (8 * g + 4 * hh + i < tl);
                    wv[e] = valid ? __expf(zz[e] + ln[e] + suf) : 0.f; suf += ln[e]; } }
            carry = run;
            ATT_VLOAD(2); ATT_VLOAD(3);
#undef ATT_VLOAD
#pragma unroll
            for (int kv = 0; kv < 2; ++kv) { u32x4 p; p.x = cvt_pk_bf16(wv[8 * kv], wv[8 * kv + 1]); p.y = cvt_pk_bf16(wv[8 * kv + 2], wv[8 * kv + 3]); p.z = cvt_pk_bf16(wv[8 * kv + 4], wv[8 * kv + 5]); p.w = cvt_pk_bf16(wv[8 * kv + 6], wv[8 * kv + 7]);
                const bf16x8 pb = __builtin_bit_cast(bf16x8, p);
#pragma unroll
                for (int dt = 0; dt < 4; ++dt) o[dt] = __builtin_amdgcn_mfma_f32_32x32x16_bf16(vf[dt][kv], pb, o[dt], 0, 0, 0); }
            if (__ballot(carry >= -110.0f) == 0ull) break;
        }
#pragma unroll
        for (int dt = 0; dt < 4; ++dt)
#pragma unroll
            for (int g = 0; g < 4; ++g) { u32x2 w; w.x = cvt_pk_bf16(o[dt][4 * g], o[dt][4 * g + 1]); w.y = cvt_pk_bf16(o[dt][4 * g + 2], o[dt][4 * g + 3]);
                *(u32x2*)(ob + qrow + 32 * dt + 8 * g + 4 * hh) = w; }
    }
}

#define XB_TMO      128
#define XB_XCNT(j)  (256  + 64 * (j))
#define XB_XSUB(j)  (1280 + 64 * (j))
#define XB_XGEN(j)  (2304 + 64 * (j))
#define XB_TOP      3328
#define XB_TOPGEN   3392
#define XCD_BAR_WORDS 3456
#define XB_SPIN_CAP (1u << 18)
DI unsigned xb_ld(unsigned* p)              { return __hip_atomic_load(p, __ATOMIC_RELAXED, __HIP_MEMORY_SCOPE_AGENT); }
DI unsigned xb_add(unsigned* p, unsigned v) { return __hip_atomic_fetch_add(p, v, __ATOMIC_RELAXED, __HIP_MEMORY_SCOPE_AGENT); }
DI unsigned xb_xcc_id() { return (unsigned)__builtin_amdgcn_s_getreg((3 << 11) | 20) & 0xFu; }
#define XB_SPIN(cond, bar) do { unsigned _sp = 0; while (cond) { __builtin_amdgcn_s_sleep(1); \
    if ((++_sp & 255u) == 0u) { if (xb_ld(&(bar)[XB_TMO])) break; if (_sp > XB_SPIN_CAP) { atomicAdd(&(bar)[XB_TMO], 1u); break; } } } } while (0)
struct XcdBarrier { unsigned* bar; unsigned x; volatile LAS unsigned* st; };
DI XcdBarrier xcd_barrier_post(unsigned* bar, volatile LAS unsigned* st) {
    XcdBarrier b; b.bar = bar; b.x = xb_xcc_id(); b.st = st;
    if (threadIdx.x == 0) (void)xb_add(&bar[XB_XCNT(b.x)], 1u);
    return b;
}
DI void xcd_barrier_complete(unsigned* bar, unsigned x, unsigned& nloc, unsigned& nx) {
    const unsigned G = gridDim.x * gridDim.y * gridDim.z;
    unsigned sum, cnt, mine, sp = 0u;
    for (;;) {
        sum = 0u; cnt = 0u; mine = 0u;
#pragma unroll
        for (unsigned j = 0; j < 16; ++j) { const unsigned c = xb_ld(&bar[XB_XCNT(j)]); sum += c; cnt += (c > 0u) ? 1u : 0u; mine = (j == x) ? c : mine; }
        if (sum == G) break;
        __builtin_amdgcn_s_sleep(1);
        if ((++sp & 255u) == 0u) { if (xb_ld(&bar[XB_TMO])) break; if (sp > XB_SPIN_CAP) { atomicAdd(&bar[XB_TMO], 1u); break; } }
    }
    nloc = mine > 0u ? mine : 1u; nx = cnt > 0u ? cnt : 1u;
}
DI void xcd_barrier(const XcdBarrier& b) {
    asm volatile("s_waitcnt vmcnt(0)" ::: "memory");
    __syncthreads();
    if (threadIdx.x == 0) {
        unsigned* bar = b.bar;
        __builtin_amdgcn_s_waitcnt(0);
        unsigned nloc = b.st[0], nx = b.st[1];
        if (nloc == 0u) { xcd_barrier_complete(bar, b.x, nloc, nx); b.st[0] = nloc; b.st[1] = nx; }
        const unsigned old = xb_add(&bar[XB_XSUB(b.x)], 1u);
        const unsigned gen = old / nloc;
        if (old + 1u == (gen + 1u) * nloc) {
            __builtin_amdgcn_fence(__ATOMIC_RELEASE, "agent");
            asm volatile("s_waitcnt vmcnt(0)" ::: "memory");
            const unsigned og = xb_add(&bar[XB_TOP], 1u);
            const unsigned tg = og / nx;
            if (og + 1u == (tg + 1u) * nx) xb_add(&bar[XB_TOPGEN], 1u);
            else XB_SPIN(xb_ld(&bar[XB_TOPGEN]) == tg, bar);
            __builtin_amdgcn_fence(__ATOMIC_ACQUIRE, "agent");
            xb_add(&bar[XB_XGEN(b.x)], 1u);
            asm volatile("s_waitcnt vmcnt(0)" ::: "memory");
        } else {
            XB_SPIN(xb_ld(&bar[XB_XGEN(b.x)]) == gen, bar);
            __builtin_amdgcn_fence(__ATOMIC_ACQUIRE, "agent");
            asm volatile("s_waitcnt vmcnt(0)" ::: "memory");
        }
    }
    __syncthreads();
}

enum Kind { K_PREP = 0, K_GIN, K_STA, K_STB, K_STC, K_OUT, K_FUP, K_FDN, K_PP, K_GATE, K_SINQ, K_SINV, K_ATT };
constexpr int NPHASES = 1 + 9 * 2 + 9 + 7;
DI void decode_phase(int ph, int& L, int& kind, int& sub, int& sync) {
    sub = 0; sync = 1;
    if (ph == 0) { L = 0; kind = K_PREP; sync = 0; return; }
    ph -= 1;
    if (ph < 18) { L = ph / 9; const int st = ph % 9;
        kind = st == 0 ? K_GIN : st == 1 ? K_STA : st == 2 ? K_STB : st == 3 ? K_STC : st == 4 ? K_OUT : st == 5 ? K_PP : st == 6 ? K_FUP : st == 7 ? K_FDN : K_GATE;
        if (st == 6) sync = 0; return; }
    ph -= 18;
    int st;
    if (ph < 9) { L = 2; st = ph; if (st == 1) { kind = K_SINQ; sub = 1; sync = 0; return; } if (st == 2) { kind = K_SINV; sync = 0; return; } if (st > 2) st -= 2; }
    else { L = 3; st = ph - 9; }
    kind = st == 0 ? K_SINQ : st == 1 ? K_ATT : st == 2 ? K_OUT : st == 3 ? K_PP : st == 4 ? K_FUP : st == 5 ? K_FDN : K_GATE;
    if (st == 4) sync = 0;
}

__global__ void __launch_bounds__(NTHR, 2) fwd_kernel(Args a0) {
    extern __shared__ __attribute__((aligned(16))) unsigned char lds_raw[];
    LAS unsigned char* lds = (LAS unsigned char*)lds_raw;
    XcdBarrier bar; bar.bar = (unsigned*)(a0.ws + WS_BAR); bar.x = 0; bar.st = (volatile LAS unsigned*)(lds + LDS_BYTES - 16);
    if (a0.coop) {
        if (threadIdx.x < 4) ((LAS unsigned*)(lds + LDS_BYTES - 16))[threadIdx.x] = 0u;
        __syncthreads();
        bar = xcd_barrier_post((unsigned*)(a0.ws + WS_BAR), (volatile LAS unsigned*)(lds + LDS_BYTES - 16));
    }
    for (int ph = a0.ph_lo; ph < a0.ph_hi; ++ph) {
        int L, kind, sub, sync; decode_phase(ph, L, kind, sub, sync);
        if (ph > a0.ph_lo && a0.coop && sync) { if (a0.coop == 2) cg::this_grid().sync(); else xcd_barrier(bar); }
#ifdef XSYNC
        if (ph == 1) { for (int i = 0; i < XSYNC; ++i) xcd_barrier(bar); }
#endif
#ifdef REP_KIND
        for (int rep = 0; rep < ((kind == REP_KIND) ? 2 : 1); ++rep) {
        if (rep) xcd_barrier(bar);
#endif
#ifdef ONLY_KIND
        if (kind != ONLY_KIND) continue;
#endif
        size_t zo; asm volatile("s_mov_b64 %0, 0" : "=s"(zo));
        int tid = threadIdx.x; asm volatile("" : "+v"(tid));
        const int lane = tid & 63, wave = __builtin_amdgcn_readfirstlane(tid >> 6);
        const int G = gridDim.x, gw = blockIdx.x * NWAVES + wave, NGW = G * NWAVES, gt = gw * 64 + lane, NGT = NGW * 64;
        Args a;
#pragma unroll
        for (int i = 0; i < 21; ++i) a.in[i] = a0.in[i] + zo;
        a.out = a0.out + zo; a.ws = a0.ws + zo; a.ph_lo = 0; a.ph_hi = 0; a.coop = 0; a.pad = 0;
        unsigned char* ws = a.ws;
        float* SS = (float*)(ws + WS_SS);
        bf16_t* hb_cur = (bf16_t*)(ws + ((L & 1) ? WS_HB1 : WS_HB0)); bf16_t* hb_oth = (bf16_t*)(ws + ((L & 1) ? WS_HB0 : WS_HB1));
        pg8::StaticOrder S;
        switch (kind) {
        case K_PREP: phase_prep(a, lds, gw, NGW, wave, lane); break;
        case K_GIN: {
            pg8::Gemm g{hb_cur, (const bf16_t*)(ws + WS_WIN) + (size_t)L * 4096 * D, T, 4096, D}; S.init(T, 4096, G, blockIdx.x);
            pg8::EpiBf16<0> E{(bf16_t*)(ws + WS_R1), PLD, SS + 3 * L * T, (bf16_t*)(ws + WS_HALO), nullptr, false};
            pg8::gemm_phase(lds, g, S, E, tid);
            ab_gemm(hb_cur, (const bf16_t*)(ws + WS_WAB) + (size_t)L * 16 * D, SS + 3 * L * T, (float*)(ws + WS_AB), gw, NGW, lane);
        } break;
#if defined(REP_KIND)
        case K_STA: gdn_stage_a(a, L, lds, tid, wave, lane, (REP_KIND == K_STA) && rep == 0); break;
#else
        case K_STA: gdn_stage_a(a, L, lds, tid, wave, lane, false); break;
#endif
        case K_STB: gdn_stage_b(a, L, lds, wave, lane); break;
        case K_STC: gdn_stage_c(a, L, gw, NGW, lane); break;
        case K_OUT: {
            const bf16_t* W = (L < 2) ? (const bf16_t*)(ws + WS_WO) + (size_t)L * D * D : (const bf16_t*)(ws + WS_SWO) + (size_t)(L - 2) * D * D;
            pg8::Gemm g{(const bf16_t*)(ws + (L < 2 ? WS_OG : WS_R1)), W, T, D, D}; S.init(T, D, G, blockIdx.x);
            pg8::EpiRes<false> E{a.out, hb_oth, SS + (3 * L + 1) * T, nullptr, nullptr, L == 0 ? a.in[I_X] : a.out, hb_cur, L == 2, L == 3};
            pg8::gemm_phase(lds, g, S, E, tid);
            convert_p(a, L, gt, NGT);
        } break;
        case K_FUP: {
            pg8::Gemm g{hb_oth, (const bf16_t*)(ws + WS_W1) + (size_t)L * 5632 * D, T, 5632, D}; S.init(T, 5632, G, blockIdx.x);
#if defined(REP_KIND)
            pg8::EpiSwiglu E{(bf16_t*)(ws + WS_R1), SS + (3 * L + 1) * T, (REP_KIND == K_FUP) && rep == 0};
#else
            pg8::EpiSwiglu E{(bf16_t*)(ws + WS_R1), SS + (3 * L + 1) * T, false};
#endif
            pg8::gemm_phase(lds, g, S, E, tid);
        } break;
        case K_FDN: {
            pg8::Gemm g{(const bf16_t*)(ws + WS_R1), (const bf16_t*)(ws + WS_W2) + (size_t)L * D * FF, T, D, FF}; S.init(T, D, G, blockIdx.x);
            pg8::EpiRes<false> E{a.out, hb_cur, SS + (3 * L + 2) * T, nullptr, nullptr, a.out, hb_oth, L != 3, L == 3};
            pg8::gemm_phase(lds, g, S, E, tid);
        } break;
        case K_PP: {
            pg8::Gemm g2{(const bf16_t*)(ws + WS_PB), (const bf16_t*)(ws + WS_WPROJ) + (size_t)L * D * PLE, T, D, PLE};
            if (G == 256) { if (blockIdx.x < 128) break; S.init(T, D, 128, blockIdx.x - 128); } else S.init(T, D, G, blockIdx.x);
            pg8::EpiBf16<1> E2{(bf16_t*)(ws + WS_OG), D, nullptr, nullptr, nullptr, false};
            pg8::gemm_phase(lds, g2, S, E2, tid);
        } break;
        case K_GATE: {
            pg8::Gemm g{hb_cur, (const bf16_t*)(ws + WS_WGATE) + (size_t)L * D * D, T, D, D}; S.init(T, D, G, blockIdx.x);
            pg8::EpiRes<true> E{a.out, hb_oth, SS + (3 * L + 3) * T, SS + (3 * L + 2) * T, (const bf16_t*)(ws + WS_OG), a.out, hb_cur, L != 3, L == 0 || L >= 2};
            pg8::gemm_phase(lds, g, S, E, tid);
        } break;
        case K_SINQ: {
            pg8::Gemm g{hb_cur, sub == 0 ? (const bf16_t*)(ws + WS_WQ) + (size_t)(L - 2) * D * D : (const bf16_t*)(ws + WS_WK), T, D, D}; S.init(T, D, G, blockIdx.x);
            pg8::EpiBf16<2> E{sub == 0 ? (bf16_t*)(ws + WS_OG) : (bf16_t*)(ws + WS_KB), D, SS + 3 * L * T, nullptr, sub == 0 ? (float*)(ws + WS_SSQ) + (size_t)(L - 2) * NB * NH * SEQ : (float*)(ws + WS_SSK), sub != 0};
            pg8::gemm_phase(lds, g, S, E, tid);
        } break;
        case K_SINV: {
            pg8::Gemm g{(const bf16_t*)(ws + WS_WV), hb_cur, D, T, D}; S.init(D, T, G, blockIdx.x);
            pg8::EpiVT E{(bf16_t*)(ws + WS_VT), SS + 3 * L * T};
            pg8::gemm_phase(lds, g, S, E, tid);
        } break;
        case K_ATT: sb_attention(a, L - 2, gw, NGW, lane); break;
        }
#ifdef REP_KIND
        }
#endif
    }
}

#ifdef DBG_OFF
__global__ void dbg_dump(const unsigned* src, float* dst, int n) { for (int i = blockIdx.x * blockDim.x + threadIdx.x; i < n; i += gridDim.x * blockDim.x) dst[i] = (float)(src[i] & 0xFFFFFFu); }
#endif
extern "C" void kernel_launch(void* const* d_in, const int* in_sizes, int n_in, void* d_out, int out_size, void* d_ws, size_t ws_size, hipStream_t stream) {
    static int grid = 0;
    if (grid == 0) {
        int dev = 0, cus = 0, per_cu = 0;
        hipGetDevice(&dev); hipDeviceGetAttribute(&cus, hipDeviceAttributeMultiprocessorCount, dev);
        hipFuncSetAttribute((const void*)fwd_kernel, hipFuncAttributeMaxDynamicSharedMemorySize, LDS_BYTES);
        hipOccupancyMaxActiveBlocksPerMultiprocessor(&per_cu, (const void*)fwd_kernel, NTHR, LDS_BYTES);
        (void)hipGetLastError();
        if (per_cu < 1) fprintf(stderr, "kernel_launch: occupancy query reports %d blocks per CU\n", per_cu);
        grid = cus > 0 ? cus : 256;
        if (ws_size < WS_END) fprintf(stderr, "kernel_launch: workspace too small: %zu < %zu\n", ws_size, (size_t)WS_END);
    }
    Args a{};
    for (int i = 0; i < 21; ++i) a.in[i] = (const float*)d_in[i];
    a.out = (float*)d_out; a.ws = (unsigned char*)d_ws;
#if ONE_LAUNCH
    hipMemsetAsync((char*)d_ws + WS_BAR, 0, XCD_BAR_WORDS * 4, stream);
    a.ph_lo = 0; a.ph_hi = NPHASES; a.coop = 1;
    void* args[] = {&a};
    hipError_t e = hipLaunchCooperativeKernel((const void*)fwd_kernel, dim3(grid), dim3(NTHR), args, LDS_BYTES, stream);
    if (e != hipSuccess) fprintf(stderr, "cooperative launch failed: %s (grid %d)\n", hipGetErrorString(e), grid);
#else
    for (int ph = 0; ph < NPHASES && ph < MAXPH; ++ph) {
        a.ph_lo = ph; a.ph_hi = ph + 1; a.coop = 0;
        hipLaunchKernelGGL(fwd_kernel, dim3(grid), dim3(NTHR), LDS_BYTES, stream, a);
    }
#ifdef DBG_OFF
    hipLaunchKernelGGL(dbg_dump, dim3(1024), dim3(256), 0, stream, (const unsigned*)((const char*)d_ws + (size_t)(DBG_OFF)), (float*)d_out, out_size);
#endif
#endif
}
```

```cpp
#include <hip/hip_runtime.h>
#include <hip/hip_cooperative_groups.h>
#include <cstdio>
namespace cg = cooperative_groups;

#ifndef ONE_LAUNCH
#define ONE_LAUNCH 1
#endif
#ifndef MAXPH
#define MAXPH 1000
#endif

#define LAS __attribute__((address_space(3)))
#define GAS __attribute__((address_space(1)))
typedef const GAS char* GCP;
#define DI __device__ __forceinline__
typedef unsigned short bf16_t;
typedef short bf16x8 __attribute__((ext_vector_type(8)));
typedef float f32x4 __attribute__((ext_vector_type(4)));
typedef float f32x16 __attribute__((ext_vector_type(16)));
typedef unsigned u32x4 __attribute__((ext_vector_type(4)));
typedef unsigned u32x2 __attribute__((ext_vector_type(2)));

constexpr int T = 16384, D = 1024, SEQ = 4096, NB = 4, NH = 8, HD = 128, FF = 2816, PLE = 256;
constexpr float EPS = 1e-6f;
constexpr int NWAVES = 8, NTHR = 512;
constexpr int PLD = 4096 + 64;
constexpr int LDS_BYTES = 155648;

constexpr size_t MiB = 1u << 20;
constexpr size_t WS_SS = 0;
constexpr size_t WS_SSQ = 1 * MiB;
constexpr size_t WS_SSK = 2 * MiB;
constexpr size_t WS_GL = 2 * MiB + 512 * 1024;
constexpr size_t WS_BAR = 2 * MiB + 768 * 1024;
constexpr size_t WS_AB = 3 * MiB;
constexpr size_t WS_WIN = 4 * MiB;
constexpr size_t WS_W1 = 20 * MiB;
constexpr size_t WS_W2 = 64 * MiB;
constexpr size_t WS_WO = 86 * MiB;
constexpr size_t WS_WK = 90 * MiB;
constexpr size_t WS_WV = 92 * MiB;
constexpr size_t WS_WQ = 94 * MiB;
constexpr size_t WS_SWO = 98 * MiB;
constexpr size_t WS_WPROJ = 102 * MiB;
constexpr size_t WS_WGATE = 104 * MiB;
constexpr size_t WS_WAB = 112 * MiB;
constexpr size_t WS_R1 = 113 * MiB;
constexpr size_t WS_KB = WS_R1 + 88 * MiB;
constexpr size_t WS_VT = 4 * MiB;
constexpr size_t WS_HB0 = 243 * MiB, WS_HB1 = 275 * MiB;
constexpr size_t WS_OG = 307 * MiB;
constexpr size_t WS_PB = WS_R1 + 120 * MiB;
constexpr size_t WS_HALO = WS_OG;
constexpr size_t WS_END = 339 * MiB;

typedef __bf16 bf16v2 __attribute__((ext_vector_type(2)));
DI unsigned cvt_pk_bf16(float lo, float hi) { bf16v2 v; v[0] = (__bf16)lo; v[1] = (__bf16)hi; return __builtin_bit_cast(unsigned, v); }
DI float bf2f(unsigned short b) { return __uint_as_float(((unsigned)b) << 16); }
DI float bflo(unsigned w) { return __uint_as_float(w << 16); }
DI float bfhi(unsigned w) { return __uint_as_float(w & 0xffff0000u); }
DI float sigmoidf_(float x) { return __builtin_amdgcn_rcpf(1.0f + __expf(-x)); }
DI float siluf_(float x) { return x * __builtin_amdgcn_rcpf(1.0f + __expf(-x)); }
DI float softplusf_(float x) { return fmaxf(x, 0.f) + 0.6931471805599453f * __builtin_amdgcn_logf(1.0f + __builtin_amdgcn_exp2f(-1.4426950408889634f * fabsf(x))); }
constexpr float SS_SCALE = 2048.0f, SS_INV = 1.0f / 2048.0f, SH_SCALE = 16384.0f, SH_INV = 1.0f / 16384.0f;
DI float ss_rstd(const float* ss, int row) { return rsqrtf((float)((const unsigned*)ss)[row] * (SS_INV / 1024.0f) + 1e-6f); }
DI void ss_add(float* ss, int row, float v) { atomicAdd((unsigned*)ss + row, (unsigned)(v * SS_SCALE + 0.5f)); }
DI float wave_sum(float v) {
#pragma unroll
    for (int o = 1; o < 64; o <<= 1) v += __shfl_xor(v, o);
    return v;
}

namespace pg8 {
constexpr int BM = 256, BK = 64, HALF = 128, HTB = HALF * BK * 2, STAGE_BYTES = 8 * HTB, NXCD = 8, WGM = 8;
DI int lds_byte(int r, int c) { const int st = (r >> 4) * 2 + (c >> 5), rr = r & 15, cc = c & 31, ob = rr * 64 + cc * 2; return st * 1024 + (ob ^ (((ob >> 9) & 1) << 5)); }
DI void stage_rc(int b, int& R, int& C) { const int st = b / 1024, sb = b % 1024, swz = sb ^ (((sb >> 9) & 1) << 5); R = (st >> 1) * 16 + swz / 64; C = (st & 1) * 32 + (swz % 64) / 2; }
DI int perm32(int rho) { const int n = rho >> 4, i = rho & 15; return 8 * (i >> 2) + 4 * n + (i & 3); }
struct Unit { int pm, pn; };
struct Gemm { const bf16_t* A; const bf16_t* Bt; int M, N, K; };
struct StaticOrder {
    int nM, nN, nwg, G, c;
    DI void init(int M, int N, int G_, int c_) { nM = M / BM; nN = N / BM; nwg = nM * nN; G = G_; c = c_; }
    DI bool next(int i, Unit& u) const {
        const long L = (long)i * G + c; if (L >= nwg) return false;
        int wgid = (int)L; { const int q = nwg / NXCD, r = nwg % NXCD, xcd = wgid % NXCD, off = wgid / NXCD; wgid = (xcd < r ? xcd * (q + 1) : r * (q + 1) + (xcd - r) * q) + off; }
        const int nig = WGM * nN, gid = wgid / nig, fm = gid * WGM, gsz = (nM - fm) < WGM ? (nM - fm) : WGM;
        u.pm = fm + ((wgid % nig) % gsz); u.pn = (wgid % nig) / gsz; return true;
    }
};

template <class Epi>
DI void gemm_phase(LAS unsigned char* lds, const Gemm g, const StaticOrder& S, const Epi& E, const int tid) {
    const int wid = __builtin_amdgcn_readfirstlane(tid >> 6), lane = tid & 63, wr = wid >> 2, wc = wid & 3, fr = lane & 15, fq = lane >> 4;
    const int K = g.K, nt = K / BK;
    unsigned voffA[2], voffB[2];
#pragma unroll
    for (int i = 0; i < 2; ++i) { int R, C; stage_rc(tid * 16 + i * 8192, R, C); const int Rb = Epi::PERM ? ((R & ~31) + perm32(R & 31)) : R;
        voffA[i] = (unsigned)(R * K + C) * 2u; voffB[i] = (unsigned)(Rb * K + C) * 2u; }
    const size_t kstep = (size_t)(BK * 2);
    const size_t hstep = (size_t)HALF * K * 2;
    const size_t tstep = 2 * hstep;
    const unsigned ldsw = (unsigned)wid * 1024u;
    const int aoff = lds_byte(wr * 64 + fr, fq * 8), boff = lds_byte(wc * 32 + fr, fq * 8);
#define PG8_SA(b, h) (((b) * 2 + (h)) * HTB)
#define PG8_SB(b, h) ((4 + (b) * 2 + (h)) * HTB)
#define PG8_STAGE(bufoff, gbase, voff) do { _Pragma("unroll") for (int _i = 0; _i < 2; ++_i) \
        __builtin_amdgcn_global_load_lds((const unsigned*)((const char*)(gbase) + (voff)[_i]), (LAS unsigned*)(lds + (bufoff) + ldsw + _i * 8192), 16, 0, 0); } while (0)
#define PG8_LDA(dst, b, h) do { _Pragma("unroll") for (int m = 0; m < 4; ++m) _Pragma("unroll") for (int k = 0; k < 2; ++k) dst[m][k] = *(const LAS bf16x8*)(lds + PG8_SA(b, h) + aoff + m * 2048 + k * 1024); } while (0)
#define PG8_LDB(dst, b, h) do { _Pragma("unroll") for (int n = 0; n < 2; ++n) _Pragma("unroll") for (int k = 0; k < 2; ++k) dst[n][k] = *(const LAS bf16x8*)(lds + PG8_SB(b, h) + boff + n * 2048 + k * 1024); } while (0)
#define PG8_MMA(ai, bj, At, Bt) do { __builtin_amdgcn_s_setprio(1); _Pragma("unroll") for (int m = 0; m < 4; ++m) _Pragma("unroll") for (int n = 0; n < 2; ++n) _Pragma("unroll") for (int k = 0; k < 2; ++k) \
        acc[ai][bj][m][n] = __builtin_amdgcn_mfma_f32_16x16x32_bf16(Bt[n][k], At[m][k], acc[ai][bj][m][n], 0, 0, 0); __builtin_amdgcn_s_setprio(0); } while (0)
#define PG8_WAIT_V(n) asm volatile("s_waitcnt vmcnt(" #n ")" ::: "memory")
#define PG8_WAIT_L(n) asm volatile("s_waitcnt lgkmcnt(" #n ")" ::: "memory")
#define PG8_BAR __builtin_amdgcn_s_barrier()
#define PG8_SCHED __builtin_amdgcn_sched_barrier(0)
    Unit cur, nxt; int ui = 0;
    if (!S.next(0, cur)) return;
    f32x4 acc[2][2][4][2];
#pragma unroll
    for (int a = 0; a < 2; ++a)
#pragma unroll
        for (int b = 0; b < 2; ++b)
#pragma unroll
            for (int m = 0; m < 4; ++m)
#pragma unroll
                for (int n = 0; n < 2; ++n) acc[a][b][m][n] = (f32x4){0.f, 0.f, 0.f, 0.f};
    bf16x8 At[4][2], B0[2][2], B1[2][2];
    const char* cA = (const char*)g.A + (size_t)cur.pm * tstep; const char* cB = (const char*)g.Bt + (size_t)cur.pn * tstep;
    PG8_STAGE(PG8_SB(0, 0), cB, voffB); PG8_STAGE(PG8_SA(0, 0), cA, voffA); PG8_STAGE(PG8_SB(0, 1), cB + hstep, voffB); PG8_STAGE(PG8_SA(0, 1), cA + hstep, voffA);
    if (wr == 1) PG8_BAR;
    PG8_WAIT_V(4); PG8_BAR;
    PG8_STAGE(PG8_SB(1, 0), cB + kstep, voffB); PG8_STAGE(PG8_SA(1, 0), cA + kstep, voffA); PG8_STAGE(PG8_SB(1, 1), cB + hstep + kstep, voffB);
    PG8_WAIT_V(6); PG8_BAR;
    for (;;) {
        const bool has_next = S.next(ui + 1, nxt);
        const char* nA = has_next ? (const char*)g.A + (size_t)nxt.pm * tstep : cA; const char* nB = has_next ? (const char*)g.Bt + (size_t)nxt.pn * tstep : cB;
        for (int t = 0; t < nt; t += 2) {
            const bool last = (t == nt - 2);
            const char* a1 = cA + (size_t)(t + 1) * kstep;
            const char* a2 = last ? nA : cA + (size_t)(t + 2) * kstep; const char* b2 = last ? nB : cB + (size_t)(t + 2) * kstep;
            const char* a3 = a2 + kstep; const char* b3 = b2 + kstep;
            PG8_LDB(B0, 0, 0); PG8_SCHED; PG8_LDA(At, 0, 0); PG8_STAGE(PG8_SA(1, 1), a1 + hstep, voffA);
            PG8_WAIT_L(8); PG8_BAR; PG8_WAIT_L(0); PG8_MMA(0, 0, At, B0); PG8_BAR; PG8_SCHED;
            PG8_LDB(B1, 0, 1); PG8_STAGE(PG8_SB(0, 0), b2, voffB);
            PG8_BAR; PG8_WAIT_L(0); PG8_MMA(0, 1, At, B1); PG8_BAR;
            PG8_LDA(At, 0, 1); PG8_STAGE(PG8_SA(0, 0), a2, voffA);
            PG8_BAR; PG8_WAIT_L(0); PG8_MMA(1, 0, At, B0); PG8_BAR; PG8_SCHED;
            PG8_STAGE(PG8_SB(0, 1), b2 + hstep, voffB);
            PG8_WAIT_V(6); PG8_BAR; PG8_MMA(1, 1, At, B1); PG8_BAR;
            PG8_LDB(B0, 1, 0); PG8_SCHED; PG8_LDA(At, 1, 0); PG8_STAGE(PG8_SA(0, 1), a2 + hstep, voffA);
            PG8_WAIT_L(8); PG8_BAR; PG8_WAIT_L(0); PG8_MMA(0, 0, At, B0); PG8_BAR; PG8_SCHED;
            PG8_LDB(B1, 1, 1); PG8_STAGE(PG8_SB(1, 0), b3, voffB);
            PG8_BAR; PG8_WAIT_L(0); PG8_MMA(0, 1, At, B1); PG8_BAR;
            PG8_LDA(At, 1, 1); PG8_STAGE(PG8_SA(1, 0), a3, voffA);
            PG8_BAR; PG8_WAIT_L(0); PG8_MMA(1, 0, At, B0); PG8_BAR; PG8_SCHED;
            PG8_STAGE(PG8_SB(1, 1), b3 + hstep, voffB);
            PG8_WAIT_V(6); PG8_BAR; PG8_MMA(1, 1, At, B1); PG8_BAR;
        }
        E(acc, cur, wr, wc, fr, fq);
        if (!has_next) break;
#pragma unroll
        for (int a = 0; a < 2; ++a)
#pragma unroll
            for (int b = 0; b < 2; ++b)
#pragma unroll
                for (int m = 0; m < 4; ++m)
#pragma unroll
                    for (int n = 0; n < 2; ++n) acc[a][b][m][n] = (f32x4){0.f, 0.f, 0.f, 0.f};
        cur = nxt; cA = nA; cB = nB; ++ui;
    }
    PG8_WAIT_V(0);
    if (wr == 0) PG8_BAR;
    PG8_BAR;
#undef PG8_SA
#undef PG8_SB
#undef PG8_STAGE
#undef PG8_LDA
#undef PG8_LDB
#undef PG8_MMA
#undef PG8_WAIT_V
#undef PG8_WAIT_L
#undef PG8_BAR
#undef PG8_SCHED
}

typedef const f32x4 (&AccT)[2][2][4][2];

template <int MODE> struct EpiBf16 {
    static constexpr bool PERM = true;
    bf16_t* O; int ldc; const float* ss; bf16_t* halo; float* ssh; bool kfrag;
    DI void operator()(AccT acc, const Unit& u, int wr, int wc, int fr, int fq) const {
        const int row0 = u.pm * BM + wr * 64 + fr, col0 = u.pn * BM + wc * 32 + 8 * fq;
        float rs[8];
#pragma unroll
        for (int i = 0; i < 8; ++i) rs[i] = (MODE == 1) ? 1.0f : ss_rstd(ss, row0 + (i >> 2) * HALF + (i & 3) * 16);
#pragma unroll
        for (int ai = 0; ai < 2; ++ai)
#pragma unroll
            for (int m = 0; m < 4; ++m) {
                const int row = row0 + ai * HALF + m * 16;
                const float r = rs[ai * 4 + m];
#pragma unroll
                for (int bj = 0; bj < 2; ++bj) {
                    const f32x4 v0 = acc[ai][bj][m][0] * r, v1 = acc[ai][bj][m][1] * r;
                    u32x4 w; w.x = cvt_pk_bf16(v0[0], v0[1]); w.y = cvt_pk_bf16(v0[2], v0[3]); w.z = cvt_pk_bf16(v1[0], v1[1]); w.w = cvt_pk_bf16(v1[2], v1[3]);
                    const int col = col0 + bj * HALF;
                    if (MODE == 2 && kfrag) { const int d0 = col & 127;
                        *(u32x4*)(O + ((size_t)((((row >> 12) * NH + (col >> 7)) * (SEQ / 32) + ((row & (SEQ - 1)) >> 5)) * 8 + (d0 >> 4)) * 512) + (((d0 >> 3) & 1) * 32 + (row & 31)) * 8) = w; }
                    else *(u32x4*)(O + (size_t)row * ldc + col) = w;
                    if (MODE == 0) { if ((row & 63) >= 61 && col < 3072) *(u32x4*)(halo + ((size_t)(row >> 6) * 3 + ((row & 63) - 61)) * 3072 + col) = w; }
                    if (MODE == 2) {
                        float sq = (v0[0] * v0[0] + v0[1] * v0[1]) + (v0[2] * v0[2] + v0[3] * v0[3]) + (v1[0] * v1[0] + v1[1] * v1[1]) + (v1[2] * v1[2] + v1[3] * v1[3]);
                        sq += __shfl_xor(sq, 16); sq += __shfl_xor(sq, 32);
                        if (fq == 0) atomicAdd((unsigned*)ssh + (size_t)((row >> 12) * NH + (2 * u.pn + bj)) * SEQ + (row & (SEQ - 1)), (unsigned)(sq * SH_SCALE + 0.5f));
                    }
                }
            }
    }
};
struct EpiVT {
    static constexpr bool PERM = true;
    bf16_t* O; const float* ss;
    DI void operator()(AccT acc, const Unit& u, int wr, int wc, int fr, int fq) const {
        const int row0 = u.pm * BM + wr * 64 + fr, col0 = u.pn * BM + wc * 32 + 8 * fq;
        f32x4 rs[2][2];
#pragma unroll
        for (int bj = 0; bj < 2; ++bj)
#pragma unroll
            for (int n = 0; n < 2; ++n) { const u32x4 s4 = *(const u32x4*)(ss + col0 + bj * HALF + 4 * n);
#pragma unroll
                for (int j = 0; j < 4; ++j) rs[bj][n][j] = rsqrtf((float)s4[j] * (SS_INV / D) + EPS); }
#pragma unroll
        for (int ai = 0; ai < 2; ++ai)
#pragma unroll
            for (int m = 0; m < 4; ++m) {
                const int row = row0 + ai * HALF + m * 16;
#pragma unroll
                for (int bj = 0; bj < 2; ++bj) {
                    const f32x4 v0 = acc[ai][bj][m][0] * rs[bj][0], v1 = acc[ai][bj][m][1] * rs[bj][1];
                    u32x4 w; w.x = cvt_pk_bf16(v0[0], v0[1]); w.y = cvt_pk_bf16(v0[2], v0[3]); w.z = cvt_pk_bf16(v1[0], v1[1]); w.w = cvt_pk_bf16(v1[2], v1[3]);
                    const int tok = col0 + bj * HALF, sl_ = tok & 31;
                    bf16_t* vb_ = O + ((size_t)(((((tok >> 12) * NH + (row >> 7)) * (SEQ / 32) + ((tok & (SEQ - 1)) >> 5)) * 4 + ((row & 127) >> 5)) * 2 + ((sl_ >> 4) & 1)) * 512) + (row & 31) * 8 + ((sl_ >> 3) & 1) * 4;
                    *(u32x2*)(vb_) = (u32x2){w.x, w.y}; *(u32x2*)(vb_ + 256) = (u32x2){w.z, w.w};
                }
            }
    }
};
struct EpiSwiglu {
    static constexpr bool PERM = true;
    bf16_t* O; const float* ss; bool dry;
    DI void operator()(AccT acc, const Unit& u, int wr, int wc, int fr, int fq) const {
        if (dry) return;
        const int row0 = u.pm * BM + wr * 64 + fr, col0 = u.pn * HALF + wc * 32 + 8 * fq;
        float rs[8];
#pragma unroll
        for (int i = 0; i < 8; ++i) rs[i] = ss_rstd(ss, row0 + (i >> 2) * HALF + (i & 3) * 16);
#pragma unroll
        for (int ai = 0; ai < 2; ++ai)
#pragma unroll
            for (int m = 0; m < 4; ++m) {
                const int row = row0 + ai * HALF + m * 16;
                const float r = rs[ai * 4 + m];
                float o[8];
#pragma unroll
                for (int n = 0; n < 2; ++n)
#pragma unroll
                    for (int j = 0; j < 4; ++j) { const float gt = acc[ai][0][m][n][j] * r, up = acc[ai][1][m][n][j] * r; o[n * 4 + j] = siluf_(gt) * up; }
                u32x4 w; w.x = cvt_pk_bf16(o[0], o[1]); w.y = cvt_pk_bf16(o[2], o[3]); w.z = cvt_pk_bf16(o[4], o[5]); w.w = cvt_pk_bf16(o[6], o[7]);
                *(u32x4*)(O + (size_t)row * FF + col0) = w;
            }
    }
};
DI void swap16v(u32x4& v) { const auto r0 = __builtin_amdgcn_permlane16_swap(v.x, v.z, false, false); const auto r1 = __builtin_amdgcn_permlane16_swap(v.y, v.w, false, false); v.x = r0[0]; v.z = r0[1]; v.y = r1[0]; v.w = r1[1]; }
template <bool GATE> struct EpiRes {
    static constexpr bool PERM = false;
    float* h; bf16_t* hb; float* ss_out; const float* ss_in; const bf16_t* pp; const float* hin; const bf16_t* hres; bool res_bf16, write_f32;
    DI void operator()(AccT acc, const Unit& u, int wr, int wc, int fr, int fq) const {
        const int row0 = u.pm * BM + wr * 64 + fr, col0 = u.pn * BM + wc * 32 + 4 * fq;
        const int colw = u.pn * BM + wc * 32 + ((fq & 1) ? 12 + 4 * fq : 4 * fq);
        float rs[8];
#pragma unroll
        for (int i = 0; i < 8; ++i) rs[i] = GATE ? ss_rstd(ss_in, row0 + (i >> 2) * HALF + (i & 3) * 16) : 1.0f;
        f32x4 hv[2][4]; u32x4 hw[2][2], pw4[2][2];
#define ER_LOAD(i_, b_) do { const size_t r_ = (size_t)(row0 + ((i_) >> 2) * HALF + ((i_) & 3) * 16) * D; \
            if (res_bf16) { hw[b_][0] = *(const u32x4*)(hres + r_ + colw); hw[b_][1] = *(const u32x4*)(hres + r_ + colw + HALF); } \
            else { _Pragma("unroll") for (int q = 0; q < 4; ++q) hv[b_][q] = *(const f32x4*)(hin + r_ + col0 + (q >> 1) * HALF + (q & 1) * 16); } \
            if (GATE) { pw4[b_][0] = *(const u32x4*)(pp + r_ + colw); pw4[b_][1] = *(const u32x4*)(pp + r_ + colw + HALF); } } while (0)
        ER_LOAD(0, 0);
#pragma unroll
        for (int i = 0; i < 8; ++i) {
            const int ai = i >> 2, m = i & 3, bsel = i & 1;
            if (i + 1 < 8) { if (bsel) ER_LOAD(i + 1, 0); else ER_LOAD(i + 1, 1); }
            const int row = row0 + ai * HALF + m * 16; const float r = rs[i];
            float sq = 0.f;
#pragma unroll
            for (int bj = 0; bj < 2; ++bj) {
                u32x4 rw = hw[bsel][bj], pq = pw4[bsel][bj];
                if (res_bf16) swap16v(rw);
                if (GATE) swap16v(pq);
                u32x4 ow;
#pragma unroll
                for (int n = 0; n < 2; ++n) {
                    const size_t off = (size_t)row * D + col0 + bj * HALF + n * 16;
                    f32x4 hvv = hv[bsel][bj * 2 + n]; f32x4 a = acc[ai][bj][m][n];
                    if (res_bf16) { const unsigned t0_ = n ? rw.z : rw.x, t1_ = n ? rw.w : rw.y; hvv[0] = bflo(t0_); hvv[1] = bfhi(t0_); hvv[2] = bflo(t1_); hvv[3] = bfhi(t1_); }
                    if (GATE) { const unsigned p0_ = n ? pq.z : pq.x, p1_ = n ? pq.w : pq.y;
                        a[0] = bflo(p0_) * sigmoidf_(a[0] * r); a[1] = bfhi(p0_) * sigmoidf_(a[1] * r); a[2] = bflo(p1_) * sigmoidf_(a[2] * r); a[3] = bfhi(p1_) * sigmoidf_(a[3] * r); }
                    hvv = hvv + a;
                    if (write_f32) *(f32x4*)(h + off) = hvv;
                    if (n == 0) { ow.x = cvt_pk_bf16(hvv[0], hvv[1]); ow.y = cvt_pk_bf16(hvv[2], hvv[3]); } else { ow.z = cvt_pk_bf16(hvv[0], hvv[1]); ow.w = cvt_pk_bf16(hvv[2], hvv[3]); }
                    sq += (hvv[0] * hvv[0] + hvv[1] * hvv[1]) + (hvv[2] * hvv[2] + hvv[3] * hvv[3]);
                }
                swap16v(ow);
                *(u32x4*)(hb + (size_t)row * D + colw + bj * HALF) = ow;
            }
            sq += __shfl_xor(sq, 16); sq += __shfl_xor(sq, 32);
            if (fq == 0) ss_add(ss_out, row, sq);
        }
#undef ER_LOAD
    }
};
}

struct Args { const float* in[21]; float* out; unsigned char* ws; int ph_lo, ph_hi, coop, pad; };
enum { I_X = 0, I_P, I_LNMIX, I_LNFFN, I_LNPLE, I_GWIN, I_GCONV, I_GALOG, I_GDT, I_GNORM, I_GWOUT, I_KVNORM, I_WKV, I_KNORM, I_SWQ, I_SQNORM, I_SWOUT, I_FWIN, I_FWOUT, I_PPROJ, I_PGATE };

DI void transpose_item(const float* W, int ldw, int col0, int K, const float* gain, bf16_t* WT, int dst_row0, int k0, int n0, LAS float* scr, int lane) {
    float v[32];
    const float* wp = W + (size_t)(k0 + (lane >> 5)) * ldw + col0 + n0 + (lane & 31);
#pragma unroll
    for (int i = 0; i < 32; ++i) v[i] = wp[(size_t)(2 * i) * ldw];
    const int c = lane & 7;
    f32x4 g0 = (f32x4){1.f, 1.f, 1.f, 1.f}, g1 = g0;
    if (gain) { g0 = *(const f32x4*)(gain + k0 + 8 * c); g1 = *(const f32x4*)(gain + k0 + 8 * c + 4); }
#pragma unroll
    for (int i = 0; i < 32; ++i) scr[(2 * i + (lane >> 5)) * 33 + (lane & 31)] = v[i];
    asm volatile("s_waitcnt lgkmcnt(0)" ::: "memory");
#pragma unroll
    for (int j = 0; j < 4; ++j) { const int n = (lane >> 3) + 8 * j; const LAS float* sp = scr + (8 * c) * 33 + n;
        u32x4 o; o.x = cvt_pk_bf16(sp[0 * 33] * g0[0], sp[1 * 33] * g0[1]); o.y = cvt_pk_bf16(sp[2 * 33] * g0[2], sp[3 * 33] * g0[3]); o.z = cvt_pk_bf16(sp[4 * 33] * g1[0], sp[5 * 33] * g1[1]); o.w = cvt_pk_bf16(sp[6 * 33] * g1[2], sp[7 * 33] * g1[3]);
        *(u32x4*)(WT + (size_t)(dst_row0 + n) * K + k0 + 8 * c) = o; }
    asm volatile("s_waitcnt lgkmcnt(0)" ::: "memory");
}
struct TJob { const float* W; int ldw, col0, K, ncols; const float* gain; bf16_t* WT; int mode; };
DI TJob get_job(int j, const Args& a) {
    TJob t; t.mode = 0; t.gain = nullptr; t.col0 = 0;
    unsigned char* ws = a.ws;
    if (j < 2) { t.W = a.in[I_GWIN] + (size_t)j * D * 4112; t.ldw = 4112; t.K = D; t.ncols = 4096; t.gain = a.in[I_LNMIX] + j * D; t.WT = (bf16_t*)(ws + WS_WIN) + (size_t)j * 4096 * D; return t; } j -= 2;
    if (j < 4) { t.W = a.in[I_FWIN] + (size_t)j * D * 5632; t.ldw = 5632; t.K = D; t.ncols = 5632; t.gain = a.in[I_LNFFN] + j * D; t.WT = (bf16_t*)(ws + WS_W1) + (size_t)j * 5632 * D; t.mode = 1; return t; } j -= 4;
    if (j < 4) { t.W = a.in[I_FWOUT] + (size_t)j * FF * D; t.ldw = D; t.K = FF; t.ncols = D; t.WT = (bf16_t*)(ws + WS_W2) + (size_t)j * D * FF; return t; } j -= 4;
    if (j < 2) { t.W = a.in[I_GWOUT] + (size_t)j * D * D; t.ldw = D; t.K = D; t.ncols = D; t.WT = (bf16_t*)(ws + WS_WO) + (size_t)j * D * D; return t; } j -= 2;
    if (j < 2) { t.W = a.in[I_WKV]; t.ldw = 2048; t.col0 = j * 1024; t.K = D; t.ncols = D; t.gain = a.in[I_KVNORM]; t.WT = (bf16_t*)(ws + (j ? WS_WV : WS_WK)); return t; } j -= 2;
    if (j < 2) { t.W = a.in[I_SWQ] + (size_t)j * D * D; t.ldw = D; t.K = D; t.ncols = D; t.gain = a.in[I_LNMIX] + (2 + j) * D; t.WT = (bf16_t*)(ws + WS_WQ) + (size_t)j * D * D; return t; } j -= 2;
    if (j < 2) { t.W = a.in[I_SWOUT] + (size_t)j * D * D; t.ldw = D; t.K = D; t.ncols = D; t.WT = (bf16_t*)(ws + WS_SWO) + (size_t)j * D * D; return t; } j -= 2;
    if (j < 4) { t.W = a.in[I_PPROJ] + (size_t)j * PLE * D; t.ldw = D; t.K = PLE; t.ncols = D; t.WT = (bf16_t*)(ws + WS_WPROJ) + (size_t)j * D * PLE; return t; } j -= 4;
    t.W = a.in[I_PGATE] + (size_t)j * D * D; t.ldw = D; t.K = D; t.ncols = D; t.gain = a.in[I_LNPLE] + j * D; t.WT = (bf16_t*)(ws + WS_WGATE) + (size_t)j * D * D; return t;
}
constexpr int NJOBS = 26;

struct TItem { const float* wp; const float* gp; bf16_t* wt; int ldw, K, valid; };
DI TItem decode_titem(int g, const Args& a, int lane) {
    TItem r; r.wp = nullptr; r.gp = nullptr; r.wt = nullptr; r.ldw = 0; r.K = 0; r.valid = 0;
    for (int j = 0; j < NJOBS; ++j) {
        const TJob t = get_job(j, a);
        const int nblk = t.ncols / 32, nitems = (t.K / 64) * nblk;
        if (g < nitems) {
            const int kb = g / nblk, nb = g % nblk, n0 = nb * 32, k0 = kb * 64;
            int drow = n0;
            if (t.mode == 1) { drow = (n0 < FF) ? ((n0 / 128) * 256 + (n0 % 128)) : (((n0 - FF) / 128) * 256 + 128 + ((n0 - FF) % 128)); }
            r.wp = t.W + (size_t)(k0 + (lane >> 5)) * t.ldw + t.col0 + n0 + (lane & 31);
            r.gp = t.gain ? t.gain + k0 + 8 * (lane & 7) : nullptr;
            r.wt = t.WT + (size_t)(drow + (lane >> 3)) * t.K + k0 + 8 * (lane & 7);
            r.ldw = t.ldw; r.K = t.K; r.valid = 1; return r;
        }
        g -= nitems;
    }
    return r;
}
constexpr int TR_TOTAL = 2 * 2048 + 4 * 2816 + 4 * 1408 + 2 * 512 + 2 * 512 + 2 * 512 + 2 * 512 + 4 * 128 + 4 * 512;
DI void phase_prep(const Args& a, LAS unsigned char* lds, int gw, int NGW, int wave, int lane) {
    LAS float* scr = (LAS float*)(lds + wave * 16384);
    {
        float v[32]; f32x4 g0 = (f32x4){1.f, 1.f, 1.f, 1.f}, g1 = g0;
        TItem cur = decode_titem(gw, a, lane);
        if (cur.valid) {
#pragma unroll
            for (int i = 0; i < 32; ++i) v[i] = cur.wp[(size_t)(2 * i) * cur.ldw];
            if (cur.gp) { g0 = *(const f32x4*)(cur.gp); g1 = *(const f32x4*)(cur.gp + 4); }
        }
        for (int g = gw; g < TR_TOTAL; g += NGW) {
#pragma unroll
            for (int i = 0; i < 32; ++i) scr[(2 * i + (lane >> 5)) * 33 + (lane & 31)] = v[i];
            const f32x4 h0 = g0, h1 = g1; bf16_t* wt = cur.wt; const int K = cur.K;
            cur = decode_titem(g + NGW, a, lane);
            g0 = (f32x4){1.f, 1.f, 1.f, 1.f}; g1 = g0;
            if (cur.valid) {
#pragma unroll
                for (int i = 0; i < 32; ++i) v[i] = cur.wp[(size_t)(2 * i) * cur.ldw];
                if (cur.gp) { g0 = *(const f32x4*)(cur.gp); g1 = *(const f32x4*)(cur.gp + 4); }
            }
            asm volatile("s_waitcnt lgkmcnt(0)" ::: "memory");
            const int c = lane & 7;
#pragma unroll
            for (int j = 0; j < 4; ++j) { const int n = (lane >> 3) + 8 * j; const LAS float* sp = scr + (8 * c) * 33 + n;
                u32x4 o; o.x = cvt_pk_bf16(sp[0 * 33] * h0[0], sp[1 * 33] * h0[1]); o.y = cvt_pk_bf16(sp[2 * 33] * h0[2], sp[3 * 33] * h0[3]); o.z = cvt_pk_bf16(sp[4 * 33] * h1[0], sp[5 * 33] * h1[1]); o.w = cvt_pk_bf16(sp[6 * 33] * h1[2], sp[7 * 33] * h1[3]);
                *(u32x4*)(wt + (size_t)(8 * j) * K) = o; }
            asm volatile("s_waitcnt lgkmcnt(0)" ::: "memory");
        }
    }
    const int gt = gw * 64 + lane, NGT = NGW * 64;
    for (int i = gt; i < 2 * 16 * D; i += NGT) { const int l = i / (16 * D), n = (i / D) % 16, k = i % D;
        const float v = a.in[I_GWIN][(size_t)l * D * 4112 + (size_t)k * 4112 + 4096 + n] * a.in[I_LNMIX][l * D + k];
        ((bf16_t*)(a.ws + WS_WAB))[i] = (bf16_t)(cvt_pk_bf16(v, 0.f) & 0xffffu); }
    { float* z = (float*)(a.ws + WS_SS) + T; for (int i = gt; i < 12 * T; i += NGT) z[i] = 0.f;
      float* z2 = (float*)(a.ws + WS_SSQ); for (int i = gt; i < (int)((WS_GL - WS_SSQ) / 4); i += NGT) z2[i] = 0.f; }
    float* ss0 = (float*)(a.ws + WS_SS); bf16_t* hb0 = (bf16_t*)(a.ws + WS_HB0);
    for (int m = gw; m < T; m += NGW) {
        const f32x4* xr = (const f32x4*)(a.in[I_X] + (size_t)m * D) + lane; u32x2* hbr = (u32x2*)(hb0 + (size_t)m * D) + lane;
        float s = 0.f;
#pragma unroll
        for (int j = 0; j < 4; ++j) { const f32x4 v = xr[64 * j]; u32x2 w; w.x = cvt_pk_bf16(v[0], v[1]); w.y = cvt_pk_bf16(v[2], v[3]); hbr[64 * j] = w; s += (v[0] * v[0] + v[1] * v[1]) + (v[2] * v[2] + v[3] * v[3]); }
        s = wave_sum(s);
        if (lane == 0) ((unsigned*)ss0)[m] = (unsigned)(s * SS_SCALE + 0.5f);
    }
}

DI void convert_p(const Args& a, int L, int gt, int NGT) {
    const f32x4* src = (const f32x4*)(a.in[I_P] + (size_t)L * T * PLE); u32x4* dst = (u32x4*)(a.ws + WS_PB);
    for (int i = gt; i < T * PLE / 8; i += NGT) { const f32x4 v0 = src[2 * i], v1 = src[2 * i + 1];
        u32x4 w; w.x = cvt_pk_bf16(v0[0], v0[1]); w.y = cvt_pk_bf16(v0[2], v0[3]); w.z = cvt_pk_bf16(v1[0], v1[1]); w.w = cvt_pk_bf16(v1[2], v1[3]); dst[i] = w; }
}

DI void ab_gemm(const bf16_t* hb, const bf16_t* wab, const float* ss, float* AB, int gw, int NGW, int lane) {
    const int fr = lane & 15, fq = lane >> 4;
    for (int tile = gw; tile < T / 16; tile += NGW) {
        f32x4 acc = (f32x4){0.f, 0.f, 0.f, 0.f};
        const bf16_t* ap = hb + (size_t)(tile * 16 + fr) * D + 8 * fq; const bf16_t* bp = wab + (size_t)fr * D + 8 * fq;
#pragma unroll 1
        for (int k8 = 0; k8 < D / 256; ++k8) {
            bf16x8 av[8], bv[8];
#pragma unroll
            for (int j = 0; j < 8; ++j) { av[j] = *(const bf16x8*)(ap + 256 * k8 + 32 * j); bv[j] = *(const bf16x8*)(bp + 256 * k8 + 32 * j); }
            asm volatile("" : "+v"(av[0]), "+v"(av[1]), "+v"(av[2]), "+v"(av[3]), "+v"(av[4]), "+v"(av[5]), "+v"(av[6]), "+v"(av[7]),
                              "+v"(bv[0]), "+v"(bv[1]), "+v"(bv[2]), "+v"(bv[3]), "+v"(bv[4]), "+v"(bv[5]), "+v"(bv[6]), "+v"(bv[7]));
#pragma unroll
            for (int j = 0; j < 8; ++j) acc = __builtin_amdgcn_mfma_f32_16x16x32_bf16(av[j], bv[j], acc, 0, 0, 0);
        }
#pragma unroll
        for (int r = 0; r < 4; ++r) { const int row = tile * 16 + 4 * fq + r; AB[(size_t)row * 16 + fr] = acc[r] * ss_rstd(ss, row); }
    }
}

constexpr int SA_QS = 0, SA_KS = 32768, SA_VS = 65536, SA_STG = 98304, SA_A = SA_STG, SA_KB = SA_A + 16384, SA_QB = SA_KB + 64 * 136 * 2, SA_BETA = SA_STG + 67 * 384 * 2, SA_G = SA_BETA + 256, SA_RQ = SA_G + 256, SA_RK = SA_RQ + 256;
static_assert(SA_QB + 64 * 136 * 2 <= SA_BETA && SA_RK + 256 <= LDS_BYTES - 16, "stage A LDS");

DI void gdn_stage_a(const Args& a, int L, LAS unsigned char* lds, int tid, int wave, int lane, const bool dry) {
    const int l = L;
    bf16_t* proj = (bf16_t*)(a.ws + WS_R1);
    const bf16_t* halo = (const bf16_t*)(a.ws + WS_HALO);
    bf16_t* wbuf = (bf16_t*)(a.ws + ((L & 1) ? WS_HB1 : WS_HB0));
    bf16_t* qkd = (bf16_t*)(a.ws + ((L & 1) ? WS_HB0 : WS_HB1));
    float* GL = (float*)(a.ws + WS_GL);
    const float* AB = (const float*)(a.ws + WS_AB);
    const float* convw = a.in[I_GCONV] + (size_t)l * 4 * 3072;
    LAS float* qs = (LAS float*)(lds + SA_QS); LAS float* ks = (LAS float*)(lds + SA_KS); LAS float* vs = (LAS float*)(lds + SA_VS); LAS float* Am = (LAS float*)(lds + SA_A); LAS bf16_t* stg = (LAS bf16_t*)(lds + SA_STG);
    LAS bf16_t* kb = (LAS bf16_t*)(lds + SA_KB); LAS bf16_t* qb = (LAS bf16_t*)(lds + SA_QB);
    LAS float* sbeta = (LAS float*)(lds + SA_BETA); LAS float* sG = (LAS float*)(lds + SA_G); LAS float* srq = (LAS float*)(lds + SA_RQ); LAS float* srk = (LAS float*)(lds + SA_RK);

    for (int item = blockIdx.x; item < NB * NH * 64; item += gridDim.x) {
        const int n = item & 63, bh = item >> 6, h = bh & 7, b = bh >> 3;
        const int t0 = b * SEQ + n * 64;
        int tidv = tid; asm volatile("" : "+v"(tidv));
        {
            u32x4 rv[7];
#pragma unroll
            for (int i = 0; i < 7; ++i) { const int id = tidv + i * NTHR; rv[i] = (u32x4){0u, 0u, 0u, 0u};
                if (id < 67 * 48) { const int row = id / 48, cc = id % 48, seg = cc >> 4, off = (cc & 15) * 8, rr = row - 3;
                    if (rr >= 0) rv[i] = *(const u32x4*)(proj + (size_t)(t0 + rr) * PLD + seg * 1024 + h * 128 + off);
                    else if (n > 0) rv[i] = *(const u32x4*)(halo + ((size_t)(b * 64 + n - 1) * 3 + row) * 3072 + seg * 1024 + h * 128 + off); } }
#pragma unroll
            for (int i = 0; i < 7; ++i) { const int id = tidv + i * NTHR;
                if (id < 67 * 48) { const int row = id / 48, cc = id % 48; *(LAS u32x4*)(stg + row * 384 + cc * 8) = rv[i]; } }
            if (tidv >= 448) {
                const int r = tidv - 448;
                const float ain = AB[(size_t)(t0 + r) * 16 + h], bin = AB[(size_t)(t0 + r) * 16 + 8 + h];
                float g = -__expf(a.in[I_GALOG][l * NH + h]) * softplusf_(ain + a.in[I_GDT][l * NH + h]);
#pragma unroll
                for (int o = 1; o < 64; o <<= 1) { const float t_ = __shfl_up(g, o); if (r >= o) g += t_; }
                sbeta[r] = sigmoidf_(bin); sG[r] = g;
                if (r == 63) GL[bh * 64 + n] = __expf(g);
            }
        }
        __syncthreads();
#pragma unroll 1
        for (int task = tidv; task < 384 * 4; task += NTHR) {
            const int col = task % 384, r0 = (task / 384) * 16, seg = col >> 7, c = col & 127, ch = seg * 1024 + h * 128 + c;
            const float w0 = convw[ch], w1 = convw[3072 + ch], w2 = convw[2 * 3072 + ch], w3 = convw[3 * 3072 + ch];
            LAS float* dst = (seg == 0 ? qs : seg == 1 ? ks : vs) + c;
            const LAS bf16_t* sp = stg + r0 * 384 + col;
            float x0 = bf2f(sp[0]), x1 = bf2f(sp[384]), x2 = bf2f(sp[2 * 384]);
#pragma unroll
            for (int r = 0; r < 16; ++r) { const float x3 = bf2f(sp[(r + 3) * 384]); dst[(r0 + r) * 128] = siluf_(w0 * x0 + w1 * x1 + w2 * x2 + w3 * x3); x0 = x1; x1 = x2; x2 = x3; }
        }
        __syncthreads();
        { const int r = tidv >> 3, l8 = tidv & 7; float sq = 0.f, sk = 0.f;
#pragma unroll
            for (int j = 0; j < 4; ++j) { const f32x4 qv = *(LAS f32x4*)(qs + r * 128 + 32 * j + 4 * l8), kv = *(LAS f32x4*)(ks + r * 128 + 32 * j + 4 * l8);
                sq += (qv[0] * qv[0] + qv[1] * qv[1]) + (qv[2] * qv[2] + qv[3] * qv[3]); sk += (kv[0] * kv[0] + kv[1] * kv[1]) + (kv[2] * kv[2] + kv[3] * kv[3]); }
            sq += __shfl_xor(sq, 1); sk += __shfl_xor(sk, 1); sq += __shfl_xor(sq, 2); sk += __shfl_xor(sk, 2); sq += __shfl_xor(sq, 4); sk += __shfl_xor(sk, 4);
            if (l8 == 0) { srq[r] = rsqrtf(sq + EPS) * 0.08838834764831845f; srk[r] = rsqrtf(sk + EPS); } }
        __syncthreads();
#pragma unroll 1
        for (int i = tidv; i < 64 * 32; i += NTHR) { const int r = i >> 5, c4 = (i & 31) * 4;
            f32x4 qv = *(LAS f32x4*)(qs + r * 128 + c4) * srq[r], kv = *(LAS f32x4*)(ks + r * 128 + c4) * srk[r];
            *(LAS f32x4*)(qs + r * 128 + c4) = qv; *(LAS f32x4*)(ks + r * 128 + c4) = kv;
            u32x2 wq, wk; wq.x = cvt_pk_bf16(qv[0], qv[1]); wq.y = cvt_pk_bf16(qv[2], qv[3]); wk.x = cvt_pk_bf16(kv[0], kv[1]); wk.y = cvt_pk_bf16(kv[2], kv[3]);
            *(LAS u32x2*)(qb + r * 136 + c4) = wq; *(LAS u32x2*)(kb + r * 136 + c4) = wk; }
        __syncthreads();
        {
            const int fr = lane & 15, fq = lane >> 4;
#pragma unroll
            for (int tt = 0; tt < 2; ++tt) { const int tile = wave * 2 + tt, rt = tile >> 2, ct = tile & 3;
                f32x4 acc = (f32x4){0.f, 0.f, 0.f, 0.f};
#pragma unroll
                for (int kk = 0; kk < 4; ++kk) { const bf16x8 av = *(LAS bf16x8*)(kb + (16 * rt + fr) * 136 + 32 * kk + 8 * fq), bv = *(LAS bf16x8*)(kb + (16 * ct + fr) * 136 + 32 * kk + 8 * fq);
                    acc = __builtin_amdgcn_mfma_f32_16x16x32_bf16(av, bv, acc, 0, 0, 0); }
                const int s = 16 * ct + fr; const float Gs = sG[s];
#pragma unroll
                for (int rg = 0; rg < 4; ++rg) { const int r = 16 * rt + 4 * fq + rg; const float v = (s < r) ? sbeta[r] * acc[rg] * __expf(sG[r] - Gs) : 0.f; Am[r * 64 + s] = v; } }
        }
        __syncthreads();
        if (tid < 256) {
            int lz; asm volatile("v_mov_b32 %0, 0" : "=v"(lz));
            LAS float* sbeta_v = sbeta + lz; LAS float* sG_v = sG + lz; LAS float* Am_v = Am + lz;
            float X[64];
            if (tid < 128) {
#pragma unroll
                for (int r = 0; r < 64; ++r) X[r] = vs[r * 128 + tid] * sbeta_v[r];
            } else {
#pragma unroll
                for (int r = 0; r < 64; ++r) X[r] = ks[r * 128 + (tid - 128)] * sbeta_v[r] * __expf(sG_v[r]);
            }
#pragma unroll
            for (int r = 1; r < 64; ++r) {
                float a0 = 0.f, a1 = 0.f, a2 = 0.f, a3 = 0.f;
#pragma unroll
                for (int s4 = 0; s4 < (r + 3) / 4; ++s4) { const f32x4 av = *(LAS f32x4*)(Am_v + r * 64 + 4 * s4);
                    a0 += av[0] * X[4 * s4]; a1 += av[1] * X[4 * s4 + 1]; a2 += av[2] * X[4 * s4 + 2]; a3 += av[3] * X[4 * s4 + 3]; }
                X[r] -= (a0 + a1) + (a2 + a3);
            }
            if (tid < 128) {
                bf16_t* vs_ = proj + (size_t)t0 * PLD + 2048 + h * 128 + (size_t)((tid >> 4) * 8) * PLD + (tid & 15) * 4;
#pragma unroll
                for (int rp = 0; rp < 8; ++rp) {
#pragma unroll
                    for (int hf = 0; hf < 2; ++hf) { const int c0 = 16 * (rp >> 1) + 4 * (2 * (rp & 1) + hf); u32x2 w; w.x = cvt_pk_bf16(X[c0], X[c0 + 1]); w.y = cvt_pk_bf16(X[c0 + 2], X[c0 + 3]);
                        if (!dry) *(u32x2*)(vs_ + hf * 64) = w; }
                    vs_ += PLD; asm volatile("" : "+v"(vs_)); }
            } else {
                const int c_ = tid - 128;
                bf16_t* wp = wbuf + (size_t)t0 * D + h * 128 + (size_t)((c_ >> 5) * 4 + ((c_ >> 3) & 3)) * D + (c_ & 7);
#pragma unroll
                for (int rt_ = 0; rt_ < 4; ++rt_) {
#pragma unroll
                    for (int fr_ = 0; fr_ < 16; ++fr_) wp[fr_ * 8] = (bf16_t)(cvt_pk_bf16(X[16 * rt_ + fr_], 0.f) & 0xffffu);
                    wp += 16 * D; asm volatile("" : "+v"(wp)); }
            }
        } else {
            const int w4 = wave - 4, fr = lane & 15, fq = lane >> 4, tt = tid - 256;
            bf16_t* qk_o = qkd + (size_t)item * 4096;
#pragma unroll
            for (int ct = 0; ct < 4; ++ct) {
                f32x4 acc = (f32x4){0.f, 0.f, 0.f, 0.f};
#pragma unroll
                for (int kk = 0; kk < 4; ++kk) { const bf16x8 av = *(LAS bf16x8*)(qb + (16 * w4 + fr) * 136 + 32 * kk + 8 * fq), bv = *(LAS bf16x8*)(kb + (16 * ct + fr) * 136 + 32 * kk + 8 * fq);
                    acc = __builtin_amdgcn_mfma_f32_16x16x32_bf16(av, bv, acc, 0, 0, 0); }
                const int s = 16 * ct + fr; const float Gs = sG[s];
#pragma unroll
                for (int rg = 0; rg < 4; ++rg) { const int r = 16 * w4 + 4 * fq + rg; const float v = (s <= r) ? acc[rg] * __expf(sG[r] - Gs) : 0.f;
                    qk_o[((r >> 4) * 2 + (s >> 5)) * 512 + (((s >> 3) & 3) * 16 + (r & 15)) * 8 + (s & 7)] = (bf16_t)(cvt_pk_bf16(v, 0.f) & 0xffffu); }
            }
#pragma unroll 1
            for (int i = tt; i < 64 * 16; i += 256) { const int blk_ = i >> 6, ln_ = i & 63, r = 16 * (blk_ >> 2) + (ln_ & 15), c8 = 32 * (blk_ & 3) + 8 * (ln_ >> 4); const float e = __expf(sG[r]);
                const f32x4 v0 = *(LAS f32x4*)(qs + r * 128 + c8) * e, v1 = *(LAS f32x4*)(qs + r * 128 + c8 + 4) * e;
                u32x4 w; w.x = cvt_pk_bf16(v0[0], v0[1]); w.y = cvt_pk_bf16(v0[2], v0[3]); w.z = cvt_pk_bf16(v1[0], v1[1]); w.w = cvt_pk_bf16(v1[2], v1[3]);
                if (!dry) *(u32x4*)(proj + (size_t)t0 * PLD + h * 128 + (size_t)((((r >> 4) * 4 + (c8 >> 5)) * 4) + ((c8 >> 3) & 3)) * PLD + (r & 15) * 8) = w; }
            const float Glast = sG[63];
#pragma unroll 1
            for (int i = tt; i < 128 * 8; i += 256) { const int blk_ = i >> 6, ln_ = i & 63, dk = 16 * (blk_ >> 1) + (ln_ & 15), c8 = 32 * (blk_ & 1) + 8 * (ln_ >> 4); float v[8];
#pragma unroll
                for (int j = 0; j < 8; ++j) v[j] = ks[(c8 + j) * 128 + dk] * __expf(Glast - sG[c8 + j]);
                u32x4 w; w.x = cvt_pk_bf16(v[0], v[1]); w.y = cvt_pk_bf16(v[2], v[3]); w.z = cvt_pk_bf16(v[4], v[5]); w.w = cvt_pk_bf16(v[6], v[7]);
                if (!dry) *(u32x4*)(proj + (size_t)t0 * PLD + 1024 + h * 128 + (size_t)((((dk >> 4) * 2 + (c8 >> 5)) * 4) + ((c8 >> 3) & 3)) * PLD + (dk & 15) * 8) = w; }
        }
        __syncthreads();
    }
}

constexpr int SB_ST = 0, SB_VT = 16 * 136 * 2;
DI void gdn_stage_b(const Args& a, int L, LAS unsigned char* lds, int wave, int lane) {
    const bf16_t* proj = (const bf16_t*)(a.ws + WS_R1);
    const bf16_t* wbuf = (const bf16_t*)(a.ws + ((L & 1) ? WS_HB1 : WS_HB0));
    const bf16_t* qkd = (const bf16_t*)(a.ws + ((L & 1) ? WS_HB0 : WS_HB1));
    const float* GL = (const float*)(a.ws + WS_GL);
    bf16_t* og = (bf16_t*)(a.ws + WS_OG);
    LAS bf16_t* sT = (LAS bf16_t*)(lds + SB_ST); LAS bf16_t* vT = (LAS bf16_t*)(lds + SB_VT);
    const int fr = lane & 15, fq = lane >> 4, rt = wave & 3;
    for (int item = blockIdx.x; item < NB * NH * 8; item += gridDim.x) {
        const int xcd_ = item & 7, idx_ = item >> 3;
        const int sl = idx_ & 7, bh = xcd_ * 4 + (idx_ >> 3), h = bh & 7, b = bh >> 3, dv0 = sl * 16;
        f32x4 Sacc = (f32x4){0.f, 0.f, 0.f, 0.f};
        __syncthreads();
        { unsigned zz; asm volatile("v_mov_b32 %0, 0" : "=v"(zz)); u32x2 z2; z2.x = zz; z2.y = zz; *(LAS u32x2*)(sT + fr * 136 + 16 * wave + 4 * fq) = z2; }
        __syncthreads();
        const size_t strideA = (wave < 4) ? (size_t)128 * D * 2 : (size_t)128 * PLD * 2, strideX = (wave < 4) ? (size_t)128 * PLD * 2 : (size_t)2 * 8192, stepA = strideA / 2, stepX = strideX / 2;
        const size_t kstepA = (wave < 4) ? (size_t)4 * D * 2 : (size_t)4 * PLD * 2;
        GCP pa0 = (wave < 4) ? (GCP)wbuf + ((size_t)(b * SEQ + 16 * rt + fq) * D + h * 128 + 8 * fr) * 2 : (GCP)proj + ((size_t)(b * SEQ + 16 * rt + fq) * PLD + h * 128 + 8 * fr) * 2;
        GCP pk0 = (GCP)proj + ((size_t)(b * SEQ) * PLD + 1024 + h * 128 + (size_t)(8 * wave + fq) * PLD + 8 * fr) * 2;
        GCP px0 = (wave < 4) ? (GCP)proj + ((size_t)(b * SEQ) * PLD + 2048 + h * 128 + (size_t)((sl * 4 + rt) * 2 + (lane >> 5)) * PLD + (lane & 31) * 4) * 2
                                     : (GCP)qkd + ((size_t)(bh * 64) * 4096 + rt * 1024 + lane * 8) * 2;
        const size_t kstepX = (wave < 4) ? (size_t)16 : (size_t)1024;
        GCP paA = pa0, paB = pa0 + stepA, paC = pa0 + 2 * stepA, paD = pa0 + 3 * stepA;
        GCP pkA = pk0, pkB = pk0 + (size_t)64 * PLD * 2, pkC = pk0 + 2 * 524288, pkD = pk0 + 3 * 524288;
        GCP pxA = px0, pxB = px0 + stepX, pxC = px0 + 2 * stepX, pxD = px0 + 3 * stepX;
#define SB_LOAD(n_, PA, PK, PX, AF, UW, QF, KF, GLV) do { \
            _Pragma("unroll") for (int kk = 0; kk < 4; ++kk) AF[kk] = *(GAS const bf16x8*)(PA + kk * kstepA); \
            KF[0] = *(GAS const bf16x8*)(PK); KF[1] = *(GAS const bf16x8*)(PK + (size_t)4 * PLD * 2); \
            QF[0] = *(GAS const bf16x8*)(PX); QF[1] = *(GAS const bf16x8*)(PX + kstepX);     \
            GLV = GL[bh * 64 + (n_)]; \
            PA += strideA; PK += (size_t)128 * PLD * 2; PX += strideX; asm volatile("" : "+v"(PA), "+v"(PK), "+v"(PX)); } while (0)
#define SB_BODY(n_, AF, UW, QF, KF, GLV) do { const int t0_ = b * SEQ + (n_) * 64; \
            f32x4 acc = (f32x4){0.f, 0.f, 0.f, 0.f}; \
            _Pragma("unroll") for (int kk = 0; kk < 4; ++kk) { const bf16x8 bv = *(LAS bf16x8*)(sT + fr * 136 + 32 * kk + 8 * fq); acc = __builtin_amdgcn_mfma_f32_16x16x32_bf16(AF[kk], bv, acc, 0, 0, 0); } \
            if (wave < 4) { \
                const u32x4 uq_ = __builtin_bit_cast(u32x4, QF[0]); f32x4 vn; vn[0] = bflo(uq_.x) - acc[0]; vn[1] = bfhi(uq_.x) - acc[1]; vn[2] = bflo(uq_.y) - acc[2]; vn[3] = bfhi(uq_.y) - acc[3]; \
                u32x2 w_; w_.x = cvt_pk_bf16(vn[0], vn[1]); w_.y = cvt_pk_bf16(vn[2], vn[3]); \
                *(LAS u32x2*)(vT + fr * 72 + 16 * rt + 4 * fq) = w_; } \
            __syncthreads(); \
            const bf16x8 vb0 = *(LAS bf16x8*)(vT + fr * 72 + 8 * fq), vb1 = *(LAS bf16x8*)(vT + fr * 72 + 32 + 8 * fq); \
            if (wave >= 4) { \
                acc = __builtin_amdgcn_mfma_f32_16x16x32_bf16(QF[0], vb0, acc, 0, 0, 0); \
                acc = __builtin_amdgcn_mfma_f32_16x16x32_bf16(QF[1], vb1, acc, 0, 0, 0); \
                bf16_t* op = og + (size_t)(t0_ + 16 * rt + 4 * fq) * D + h * 128 + dv0 + fr; \
                _Pragma("unroll") for (int rg = 0; rg < 4; ++rg) op[(size_t)rg * D] = (bf16_t)(cvt_pk_bf16(acc[rg], 0.f) & 0xffffu); } \
            Sacc = Sacc * GLV; \
            Sacc = __builtin_amdgcn_mfma_f32_16x16x32_bf16(KF[0], vb0, Sacc, 0, 0, 0); \
            Sacc = __builtin_amdgcn_mfma_f32_16x16x32_bf16(KF[1], vb1, Sacc, 0, 0, 0); \
            { u32x2 w_; w_.x = cvt_pk_bf16(Sacc[0], Sacc[1]); w_.y = cvt_pk_bf16(Sacc[2], Sacc[3]); *(LAS u32x2*)(sT + fr * 136 + 16 * wave + 4 * fq) = w_; } \
            __syncthreads(); } while (0)
        bf16x8 afA[4], afB[4], qfA[2], qfB[2], kfA[2], kfB[2]; u32x2 uwA = (u32x2){0u, 0u}, uwB = uwA; float glA, glB;
        (void)uwA; (void)uwB; (void)paC; (void)paD; (void)pkC; (void)pkD; (void)pxC; (void)pxD;
        SB_LOAD(0, paA, pkA, pxA, afA, uwA, qfA, kfA, glA);
        for (int n = 0; n < 64; n += 2) {
            SB_LOAD(n + 1, paB, pkB, pxB, afB, uwB, qfB, kfB, glB);
            SB_BODY(n, afA, uwA, qfA, kfA, glA);
            if (n + 2 < 64) SB_LOAD(n + 2, paA, pkA, pxA, afA, uwA, qfA, kfA, glA);
            SB_BODY(n + 1, afB, uwB, qfB, kfB, glB);
        }
#undef SB_LOAD
#undef SB_BODY
    }
}

DI void gdn_stage_c(const Args& a, int L, int gw, int NGW, int lane) {
    bf16_t* og = (bf16_t*)(a.ws + WS_OG); const bf16_t* proj = (const bf16_t*)(a.ws + WS_R1);
    const float* ng = a.in[I_GNORM] + L * HD + (lane & 7) * 16;
    float gn[16];
#pragma unroll
    for (int j = 0; j < 16; ++j) gn[j] = ng[j];
    for (int m = gw; m < T; m += NGW) {
        u32x4* op = (u32x4*)(og + (size_t)m * D + lane * 16); const u32x4* gp = (const u32x4*)(proj + (size_t)m * PLD + 3072 + lane * 16);
        const u32x4 o0 = op[0], o1 = op[1], g0 = gp[0], g1 = gp[1];
        float o[16], g[16];
#pragma unroll
        for (int j = 0; j < 4; ++j) { o[2 * j] = bflo(o0[j]); o[2 * j + 1] = bfhi(o0[j]); o[8 + 2 * j] = bflo(o1[j]); o[8 + 2 * j + 1] = bfhi(o1[j]);
            g[2 * j] = bflo(g0[j]); g[2 * j + 1] = bfhi(g0[j]); g[8 + 2 * j] = bflo(g1[j]); g[8 + 2 * j + 1] = bfhi(g1[j]); }
        float s = 0.f;
#pragma unroll
        for (int j = 0; j < 16; ++j) s += o[j] * o[j];
        s += __shfl_xor(s, 1); s += __shfl_xor(s, 2); s += __shfl_xor(s, 4);
        const float r = rsqrtf(s * (1.0f / HD) + EPS);
        float y[16];
#pragma unroll
        for (int j = 0; j < 16; ++j) y[j] = o[j] * r * gn[j] * siluf_(g[j]);
        u32x4 w0, w1;
#pragma unroll
        for (int j = 0; j < 4; ++j) { w0[j] = cvt_pk_bf16(y[2 * j], y[2 * j + 1]); w1[j] = cvt_pk_bf16(y[8 + 2 * j], y[8 + 2 * j + 1]); }
        op[0] = w0; op[1] = w1;
    }
}

DI void sb_attention(const Args& a, int j2, int gw, int NGW, int lane) {
    const bf16_t* qo = (const bf16_t*)(a.ws + WS_OG); bf16_t* ob = (bf16_t*)(a.ws + WS_R1); const bf16_t* kbuf = (const bf16_t*)(a.ws + WS_KB); const bf16_t* vt = (const bf16_t*)(a.ws + WS_VT);
    const float* ssq = (const float*)(a.ws + WS_SSQ) + (size_t)j2 * NB * NH * SEQ; const float* ssk = (const float*)(a.ws + WS_SSK);
    const float* qn = a.in[I_SQNORM] + j2 * HD; const float* kn = a.in[I_KNORM];
    const int tl = lane & 31, hh = lane >> 5;
    for (int item = gw; item < NB * NH * (SEQ / 32); item += NGW) {
        const int qt = (SEQ / 32 - 1) - (item & 127), bh = item >> 7, h = bh & 7, b = bh >> 3, t0 = qt * 32;
        const size_t qrow = (size_t)(b * SEQ + t0 + tl) * D + h * 128;
        bf16x8 qf[8];
        {
            const float rq = rsqrtf((float)((const unsigned*)ssq)[(size_t)bh * SEQ + t0 + tl] * (SH_INV / HD) + EPS) * 0.08838834764831845f;
#pragma unroll
            for (int ks = 0; ks < 8; ++ks) { const u32x4 raw = *(const u32x4*)(qo + qrow + 16 * ks + 8 * hh);
                const f32x4 g0 = *(const f32x4*)(qn + 16 * ks + 8 * hh) * *(const f32x4*)(kn + 16 * ks + 8 * hh), g1 = *(const f32x4*)(qn + 16 * ks + 8 * hh + 4) * *(const f32x4*)(kn + 16 * ks + 8 * hh + 4);
                u32x4 w; w.x = cvt_pk_bf16(bflo(raw.x) * rq * g0[0], bfhi(raw.x) * rq * g0[1]); w.y = cvt_pk_bf16(bflo(raw.y) * rq * g0[2], bfhi(raw.y) * rq * g0[3]);
                w.z = cvt_pk_bf16(bflo(raw.z) * rq * g1[0], bfhi(raw.z) * rq * g1[1]); w.w = cvt_pk_bf16(bflo(raw.w) * rq * g1[2], bfhi(raw.w) * rq * g1[3]);
                qf[ks] = __builtin_bit_cast(bf16x8, w); }
        }
        f32x16 o[4];
#pragma unroll
        for (int dt = 0; dt < 4; ++dt)
#pragma unroll
            for (int i = 0; i < 16; ++i) o[dt][i] = 0.f;
        float carry = 0.f;
        bf16x8 kf[8];
        { const bf16_t* kp = kbuf + ((size_t)(bh * (SEQ / 32) + qt) * 8) * 512 + lane * 8;
#pragma unroll
          for (int ks = 0; ks < 8; ++ks) kf[ks] = *(const bf16x8*)(kp + 512 * ks); }
        for (int kt = qt; kt >= 0; --kt) {
            const int s0 = kt * 32;
            f32x16 z;
#pragma unroll
            for (int i = 0; i < 16; ++i) z[i] = 0.f;
#pragma unroll
            for (int ks = 0; ks < 8; ++ks) z = __builtin_amdgcn_mfma_f32_32x32x16_bf16(kf[ks], qf[ks], z, 0, 0, 0);
            if (kt > 0) {
                const bf16_t* kp = kbuf + ((size_t)(bh * (SEQ / 32) + kt - 1) * 8) * 512 + lane * 8;
#pragma unroll
                for (int ks = 0; ks < 8; ++ks) kf[ks] = *(const bf16x8*)(kp + 512 * ks);
            }
            bf16x8 vf[4][2];
            const bf16_t* vp = vt + ((size_t)(bh * (SEQ / 32) + kt) * 8) * 512 + lane * 8;
#define ATT_VLOAD(dt) do { _Pragma("unroll") for (int kv = 0; kv < 2; ++kv) vf[dt][kv] = *(const bf16x8*)(vp + ((dt) * 2 + kv) * 512); } while (0)
            ATT_VLOAD(0); ATT_VLOAD(1);
            u32x4 kst[4];
#pragma unroll
            for (int g = 0; g < 4; ++g) kst[g] = *(const u32x4*)(ssk + (size_t)bh * SEQ + s0 + 8 * g + 4 * hh);
            float ln[16], zz[16];
            const bool diag = (kt == qt);
#pragma unroll
            for (int g = 0; g < 4; ++g) { const u32x4 k4 = kst[g];
#pragma unroll
                for (int i = 0; i < 4; ++i) { const float rk = rsqrtf((float)k4[i] * (SH_INV / HD) + EPS); const float zv = z[4 * g + i] * rk;
                    const bool valid = !diag || (8 * g + 4 * hh + i < tl);
                    zz[4 * g + i] = zv; ln[4 * g + i] = valid ? -softplusf_(zv) : 0.f; } }
            float gs[4], og_[4];
#pragma unroll
            for (int g = 0; g < 4; ++g) { gs[g] = (ln[4 * g] + ln[4 * g + 1]) + (ln[4 * g + 2] + ln[4 * g + 3]); og_[g] = __shfl_xor(gs[g], 32); }
            float after[4]; float run = carry;
#pragma unroll
            for (int g = 3; g >= 0; --g) { after[g] = run + (hh == 0 ? og_[g] : 0.f); run += gs[g] + og_[g]; }
            float wv[16];
#pragma unroll
            for (int g = 0; g < 4; ++g) { float suf = after[g];
#pragma unroll
                for (int i = 3; i >= 0; --i) { const int e = 4 * g + i; const bool valid = !diag || (8 * g + 4 * hh + i < tl);
                    wv[e] = valid ? __expf(zz[e] + ln[e] + suf) : 0.f; suf += ln[e]; } }
            carry = run;
            ATT_VLOAD(2); ATT_VLOAD(3);
#undef ATT_VLOAD
#pragma unroll
            for (int kv = 0; kv < 2; ++kv) { u32x4 p; p.x = cvt_pk_bf16(wv[8 * kv], wv[8 * kv + 1]); p.y = cvt_pk_bf16(wv[8 * kv + 2], wv[8 * kv + 3]); p.z = cvt_pk_bf16(wv[8 * kv + 4], wv[8 * kv + 5]); p.w = cvt_pk_bf16(wv[8 * kv + 6], wv[8 * kv + 7]);
                const bf16x8 pb = __builtin_bit_cast(bf16x8, p);
#pragma unroll
                for (int dt = 0; dt < 4; ++dt) o[dt] = __builtin_amdgcn_mfma_f32_32x32x16_bf16(vf[dt][kv], pb, o[dt], 0, 0, 0); }
            if (__ballot(carry >= -110.0f) == 0ull) break;
        }
#pragma unroll
        for (int dt = 0; dt < 4; ++dt)
#pragma unroll
            for (int g = 0; g < 4; ++g) { u32x2 w; w.x = cvt_pk_bf16(o[dt][4 * g], o[dt][4 * g + 1]); w.y = cvt_pk_bf16(o[dt][4 * g + 2], o[dt][4 * g + 3]);
                *(u32x2*)(ob + qrow + 32 * dt + 8 * g + 4 * hh) = w; }
    }
}

#define XB_TMO      128
#define XB_XCNT(j)  (256  + 64 * (j))
#define XB_XSUB(j)  (1280 + 64 * (j))
#define XB_XGEN(j)  (2304 + 64 * (j))
#define XB_TOP      3328
#define XB_TOPGEN   3392
#define XCD_BAR_WORDS 3456
#define XB_SPIN_CAP (1u << 18)
DI unsigned xb_ld(unsigned* p)              { return __hip_atomic_load(p, __ATOMIC_RELAXED, __HIP_MEMORY_SCOPE_AGENT); }
DI unsigned xb_add(unsigned* p, unsigned v) { return __hip_atomic_fetch_add(p, v, __ATOMIC_RELAXED, __HIP_MEMORY_SCOPE_AGENT); }
DI unsigned xb_xcc_id() { return (unsigned)__builtin_amdgcn_s_getreg((3 << 11) | 20) & 0xFu; }
#define XB_SPIN(cond, bar) do { unsigned _sp = 0; while (cond) { __builtin_amdgcn_s_sleep(1); \
    if ((++_sp & 255u) == 0u) { if (xb_ld(&(bar)[XB_TMO])) break; if (_sp > XB_SPIN_CAP) { atomicAdd(&(bar)[XB_TMO], 1u); break; } } } } while (0)
struct XcdBarrier { unsigned* bar; unsigned x; volatile LAS unsigned* st; };
DI XcdBarrier xcd_barrier_post(unsigned* bar, volatile LAS unsigned* st) {
    XcdBarrier b; b.bar = bar; b.x = xb_xcc_id(); b.st = st;
    if (threadIdx.x == 0) (void)xb_add(&bar[XB_XCNT(b.x)], 1u);
    return b;
}
DI void xcd_barrier_complete(unsigned* bar, unsigned x, unsigned& nloc, unsigned& nx) {
    const unsigned G = gridDim.x * gridDim.y * gridDim.z;
    unsigned sum, cnt, mine, sp = 0u;
    for (;;) {
        sum = 0u; cnt = 0u; mine = 0u;
#pragma unroll
        for (unsigned j = 0; j < 16; ++j) { const unsigned c = xb_ld(&bar[XB_XCNT(j)]); sum += c; cnt += (c > 0u) ? 1u : 0u; mine = (j == x) ? c : mine; }
        if (sum == G) break;
        __builtin_amdgcn_s_sleep(1);
        if ((++sp & 255u) == 0u) { if (xb_ld(&bar[XB_TMO])) break; if (sp > XB_SPIN_CAP) { atomicAdd(&bar[XB_TMO], 1u); break; } }
    }
    nloc = mine > 0u ? mine : 1u; nx = cnt > 0u ? cnt : 1u;
}
DI void xcd_barrier(const XcdBarrier& b) {
    asm volatile("s_waitcnt vmcnt(0)" ::: "memory");
    __syncthreads();
    if (threadIdx.x == 0) {
        unsigned* bar = b.bar;
        __builtin_amdgcn_s_waitcnt(0);
        unsigned nloc = b.st[0], nx = b.st[1];
        if (nloc == 0u) { xcd_barrier_complete(bar, b.x, nloc, nx); b.st[0] = nloc; b.st[1] = nx; }
        const unsigned old = xb_add(&bar[XB_XSUB(b.x)], 1u);
        const unsigned gen = old / nloc;
        if (old + 1u == (gen + 1u) * nloc) {
            __builtin_amdgcn_fence(__ATOMIC_RELEASE, "agent");
            asm volatile("s_waitcnt vmcnt(0)" ::: "memory");
            const unsigned og = xb_add(&bar[XB_TOP], 1u);
            const unsigned tg = og / nx;
            if (og + 1u == (tg + 1u) * nx) xb_add(&bar[XB_TOPGEN], 1u);
            else XB_SPIN(xb_ld(&bar[XB_TOPGEN]) == tg, bar);
            __builtin_amdgcn_fence(__ATOMIC_ACQUIRE, "agent");
            xb_add(&bar[XB_XGEN(b.x)], 1u);
            asm volatile("s_waitcnt vmcnt(0)" ::: "memory");
        } else {
            XB_SPIN(xb_ld(&bar[XB_XGEN(b.x)]) == gen, bar);
            __builtin_amdgcn_fence(__ATOMIC_ACQUIRE, "agent");
            asm volatile("s_waitcnt vmcnt(0)" ::: "memory");
        }
    }
    __syncthreads();
}

enum Kind { K_PREP = 0, K_GIN, K_STA, K_STB, K_STC, K_OUT, K_FUP, K_FDN, K_PP, K_GATE, K_SINQ, K_SINV, K_ATT };
constexpr int NPHASES = 1 + 9 * 2 + 9 + 7;
DI void decode_phase(int ph, int& L, int& kind, int& sub, int& sync) {
    sub = 0; sync = 1;
    if (ph == 0) { L = 0; kind = K_PREP; sync = 0; return; }
    ph -= 1;
    if (ph < 18) { L = ph / 9; const int st = ph % 9;
        kind = st == 0 ? K_GIN : st == 1 ? K_STA : st == 2 ? K_STB : st == 3 ? K_STC : st == 4 ? K_OUT : st == 5 ? K_PP : st == 6 ? K_FUP : st == 7 ? K_FDN : K_GATE;
        if (st == 6) sync = 0; return; }
    ph -= 18;
    int st;
    if (ph < 9) { L = 2; st = ph; if (st == 1) { kind = K_SINQ; sub = 1; sync = 0; return; } if (st == 2) { kind = K_SINV; sync = 0; return; } if (st > 2) st -= 2; }
    else { L = 3; st = ph - 9; }
    kind = st == 0 ? K_SINQ : st == 1 ? K_ATT : st == 2 ? K_OUT : st == 3 ? K_PP : st == 4 ? K_FUP : st == 5 ? K_FDN : K_GATE;
    if (st == 4) sync = 0;
}

__global__ void __launch_bounds__(NTHR, 2) fwd_kernel(Args a0) {
    extern __shared__ __attribute__((aligned(16))) unsigned char lds_raw[];
    LAS unsigned char* lds = (LAS unsigned char*)lds_raw;
    XcdBarrier bar; bar.bar = (unsigned*)(a0.ws + WS_BAR); bar.x = 0; bar.st = (volatile LAS unsigned*)(lds + LDS_BYTES - 16);
    if (a0.coop) {
        if (threadIdx.x < 4) ((LAS unsigned*)(lds + LDS_BYTES - 16))[threadIdx.x] = 0u;
        __syncthreads();
        bar = xcd_barrier_post((unsigned*)(a0.ws + WS_BAR), (volatile LAS unsigned*)(lds + LDS_BYTES - 16));
    }
    for (int ph = a0.ph_lo; ph < a0.ph_hi; ++ph) {
        int L, kind, sub, sync; decode_phase(ph, L, kind, sub, sync);
        if (ph > a0.ph_lo && a0.coop && sync) { if (a0.coop == 2) cg::this_grid().sync(); else xcd_barrier(bar); }
#ifdef XSYNC
        if (ph == 1) { for (int i = 0; i < XSYNC; ++i) xcd_barrier(bar); }
#endif
#ifdef REP_KIND
        for (int rep = 0; rep < ((kind == REP_KIND) ? 2 : 1); ++rep) {
        if (rep) xcd_barrier(bar);
#endif
#ifdef ONLY_KIND
        if (kind != ONLY_KIND) continue;
#endif
        size_t zo; asm volatile("s_mov_b64 %0, 0" : "=s"(zo));
        int tid = threadIdx.x; asm volatile("" : "+v"(tid));
        const int lane = tid & 63, wave = __builtin_amdgcn_readfirstlane(tid >> 6);
        const int G = gridDim.x, gw = blockIdx.x * NWAVES + wave, NGW = G * NWAVES, gt = gw * 64 + lane, NGT = NGW * 64;
        Args a;
#pragma unroll
        for (int i = 0; i < 21; ++i) a.in[i] = a0.in[i] + zo;
        a.out = a0.out + zo; a.ws = a0.ws + zo; a.ph_lo = 0; a.ph_hi = 0; a.coop = 0; a.pad = 0;
        unsigned char* ws = a.ws;
        float* SS = (float*)(ws + WS_SS);
        bf16_t* hb_cur = (bf16_t*)(ws + ((L & 1) ? WS_HB1 : WS_HB0)); bf16_t* hb_oth = (bf16_t*)(ws + ((L & 1) ? WS_HB0 : WS_HB1));
        pg8::StaticOrder S;
        switch (kind) {
        case K_PREP: phase_prep(a, lds, gw, NGW, wave, lane); break;
        case K_GIN: {
            pg8::Gemm g{hb_cur, (const bf16_t*)(ws + WS_WIN) + (size_t)L * 4096 * D, T, 4096, D}; S.init(T, 4096, G, blockIdx.x);
            pg8::EpiBf16<0> E{(bf16_t*)(ws + WS_R1), PLD, SS + 3 * L * T, (bf16_t*)(ws + WS_HALO), nullptr, false};
            pg8::gemm_phase(lds, g, S, E, tid);
            ab_gemm(hb_cur, (const bf16_t*)(ws + WS_WAB) + (size_t)L * 16 * D, SS + 3 * L * T, (float*)(ws + WS_AB), gw, NGW, lane);
        } break;
#if defined(REP_KIND)
        case K_STA: gdn_stage_a(a, L, lds, tid, wave, lane, (REP_KIND == K_STA) && rep == 0); break;
#else
        case K_STA: gdn_stage_a(a, L, lds, tid, wave, lane, false); break;
#endif
        case K_STB: gdn_stage_b(a, L, lds, wave, lane); break;
        case K_STC: gdn_stage_c(a, L, gw, NGW, lane); break;
        case K_OUT: {
            const bf16_t* W = (L < 2) ? (const bf16_t*)(ws + WS_WO) + (size_t)L * D * D : (const bf16_t*)(ws + WS_SWO) + (size_t)(L - 2) * D * D;
            pg8::Gemm g{(const bf16_t*)(ws + (L < 2 ? WS_OG : WS_R1)), W, T, D, D}; S.init(T, D, G, blockIdx.x);
            pg8::EpiRes<false> E{a.out, hb_oth, SS + (3 * L + 1) * T, nullptr, nullptr, L == 0 ? a.in[I_X] : a.out, hb_cur, L == 2, L == 3};
            pg8::gemm_phase(lds, g, S, E, tid);
            convert_p(a, L, gt, NGT);
        } break;
        case K_FUP: {
            pg8::Gemm g{hb_oth, (const bf16_t*)(ws + WS_W1) + (size_t)L * 5632 * D, T, 5632, D}; S.init(T, 5632, G, blockIdx.x);
#if defined(REP_KIND)
            pg8::EpiSwiglu E{(bf16_t*)(ws + WS_R1), SS + (3 * L + 1) * T, (REP_KIND == K_FUP) && rep == 0};
#else
            pg8::EpiSwiglu E{(bf16_t*)(ws + WS_R1), SS + (3 * L + 1) * T, false};
#endif
            pg8::gemm_phase(lds, g, S, E, tid);
        } break;
        case K_FDN: {
            pg8::Gemm g{(const bf16_t*)(ws + WS_R1), (const bf16_t*)(ws + WS_W2) + (size_t)L * D * FF, T, D, FF}; S.init(T, D, G, blockIdx.x);
            pg8::EpiRes<false> E{a.out, hb_cur, SS + (3 * L + 2) * T, nullptr, nullptr, a.out, hb_oth, L != 3, L == 3};
            pg8::gemm_phase(lds, g, S, E, tid);
        } break;
        case K_PP: {
            pg8::Gemm g2{(const bf16_t*)(ws + WS_PB), (const bf16_t*)(ws + WS_WPROJ) + (size_t)L * D * PLE, T, D, PLE};
            if (G == 256) { if (blockIdx.x < 128) break; S.init(T, D, 128, blockIdx.x - 128); } else S.init(T, D, G, blockIdx.x);
            pg8::EpiBf16<1> E2{(bf16_t*)(ws + WS_OG), D, nullptr, nullptr, nullptr, false};
            pg8::gemm_phase(lds, g2, S, E2, tid);
        } break;
        case K_GATE: {
            pg8::Gemm g{hb_cur, (const bf16_t*)(ws + WS_WGATE) + (size_t)L * D * D, T, D, D}; S.init(T, D, G, blockIdx.x);
            pg8::EpiRes<true> E{a.out, hb_oth, SS + (3 * L + 3) * T, SS + (3 * L + 2) * T, (const bf16_t*)(ws + WS_OG), a.out, hb_cur, L != 3, L == 0 || L >= 2};
            pg8::gemm_phase(lds, g, S, E, tid);
        } break;
        case K_SINQ: {
            pg8::Gemm g{hb_cur, sub == 0 ? (const bf16_t*)(ws + WS_WQ) + (size_t)(L - 2) * D * D : (const bf16_t*)(ws + WS_WK), T, D, D}; S.init(T, D, G, blockIdx.x);
            pg8::EpiBf16<2> E{sub == 0 ? (bf16_t*)(ws + WS_OG) : (bf16_t*)(ws + WS_KB), D, SS + 3 * L * T, nullptr, sub == 0 ? (float*)(ws + WS_SSQ) + (size_t)(L - 2) * NB * NH * SEQ : (float*)(ws + WS_SSK), sub != 0};
            pg8::gemm_phase(lds, g, S, E, tid);
        } break;
        case K_SINV: {
            pg8::Gemm g{(const bf16_t*)(ws + WS_WV), hb_cur, D, T, D}; S.init(D, T, G, blockIdx.x);
            pg8::EpiVT E{(bf16_t*)(ws + WS_VT), SS + 3 * L * T};
            pg8::gemm_phase(lds, g, S, E, tid);
        } break;
        case K_ATT: sb_attention(a, L - 2, gw, NGW, lane); break;
        }
#ifdef REP_KIND
        }
#endif
    }
}

#ifdef DBG_OFF
__global__ void dbg_dump(const unsigned* src, float* dst, int n) { for (int i = blockIdx.x * blockDim.x + threadIdx.x; i < n; i += gridDim.x * blockDim.x) dst[i] = (float)(src[i] & 0xFFFFFFu); }
#endif
extern "C" void kernel_launch(void* const* d_in, const int* in_sizes, int n_in, void* d_out, int out_size, void* d_ws, size_t ws_size, hipStream_t stream) {
    static int grid = 0;
    if (grid == 0) {
        int dev = 0, cus = 0, per_cu = 0;
        hipGetDevice(&dev); hipDeviceGetAttribute(&cus, hipDeviceAttributeMultiprocessorCount, dev);
        hipFuncSetAttribute((const void*)fwd_kernel, hipFuncAttributeMaxDynamicSharedMemorySize, LDS_BYTES);
        hipOccupancyMaxActiveBlocksPerMultiprocessor(&per_cu, (const void*)fwd_kernel, NTHR, LDS_BYTES);
        (void)hipGetLastError();
        if (per_cu < 1) fprintf(stderr, "kernel_launch: occupancy query reports %d blocks per CU\n", per_cu);
        grid = cus > 0 ? cus : 256;
        if (ws_size < WS_END) fprintf(stderr, "kernel_launch: workspace too small: %zu < %zu\n", ws_size, (size_t)WS_END);
    }
    Args a{};
    for (int i = 0; i < 21; ++i) a.in[i] = (const float*)d_in[i];
    a.out = (float*)d_out; a.ws = (unsigned char*)d_ws;
#if ONE_LAUNCH
    hipMemsetAsync((char*)d_ws + WS_BAR, 0, XCD_BAR_WORDS * 4, stream);
    a.ph_lo = 0; a.ph_hi = NPHASES; a.coop = 1;
    void* args[] = {&a};
    hipError_t e = hipLaunchCooperativeKernel((const void*)fwd_kernel, dim3(grid), dim3(NTHR), args, LDS_BYTES, stream);
    if (e != hipSuccess) fprintf(stderr, "cooperative launch failed: %s (grid %d)\n", hipGetErrorString(e), grid);
#else
    for (int ph = 0; ph < NPHASES && ph < MAXPH; ++ph) {
        a.ph_lo = ph; a.ph_hi = ph + 1; a.coop = 0;
        hipLaunchKernelGGL(fwd_kernel, dim3(grid), dim3(NTHR), LDS_BYTES, stream, a);
    }
#ifdef DBG_OFF
    hipLaunchKernelGGL(dbg_dump, dim3(1024), dim3(256), 0, stream, (const unsigned*)((const char*)d_ws + (size_t)(DBG_OFF)), (float*)d_out, out_size);
#endif
#endif
}
```
